# Optimizing an MI355X kernel written in HIP

```python
import math
import jax, jax.numpy as jnp
from jax import lax
import numpy as np

D_MODEL = 1024
BATCH = 8
SEQ = 2048
DEPTH = 2

GRID_W = 64
CTX_LEN = 256

D_MIX = D_MODEL
D_CONV = D_MODEL // 4
D_CONF = D_MODEL // 4
NA_HEAD_DIM = 64
D_NA = D_MIX - D_CONV - D_CONF
N_NA_HEADS = D_NA // NA_HEAD_DIM
SHORT_CONV_W = 3
CONF_CONV_W = 31
NA_WIN_ROWS_MAX = 8
NA_WIN_COLS = 16
N_EXPERTS = 16
EC_CAPACITY_FACTOR = 2
D_EXPERT = 1024
LN_EPS = 1e-5
DEEPNORM_ALPHA = (2.0 * DEPTH) ** 0.25
DEEPNORM_BETA = (8.0 * DEPTH) ** -0.25
NEG_INF = -1e30

OFF_A = 0
OFF_B = OFF_A + 3 * D_CONV
OFF_Q = OFF_B + 2 * D_CONF
OFF_K = OFF_Q + D_NA
OFF_V = OFF_K + D_NA
D_IN = OFF_V + D_NA

kernel_name = "hybrid_conv_conformer_natten_ecmoe_deepnorm"


def layer_norm(x, gain=None, bias=None):
    xf = x.astype(jnp.float32)
    mu = jnp.mean(xf, axis=-1, keepdims=True)
    var = jnp.mean(jnp.square(xf - mu), axis=-1, keepdims=True)
    y = (xf - mu) * lax.rsqrt(var + LN_EPS)
    if gain is not None:
        y = y * gain.astype(jnp.float32) + bias.astype(jnp.float32)
    return y.astype(x.dtype)


def modulation(cond, w_mod, b_mod):
    m = jax.nn.silu(cond) @ w_mod + b_mod
    return jnp.split(m, 6, axis=-1)


def modulate(h, shift, scale):
    return h * (1 + scale) + shift


def depthwise_conv(x, w):
    pad = w.shape[0] // 2
    return lax.conv_general_dilated(
        x, w[:, None, :].astype(x.dtype), window_strides=(1,), padding=[(pad, pad)],
        dimension_numbers=('NWC', 'WIO', 'NWC'), feature_group_count=x.shape[-1])


def short_conv_mixer(u, w_short):
    bg, cg, xv = jnp.split(u, 3, axis=-1)
    return bg * depthwise_conv(cg * xv, w_short)


def conformer_conv_mixer(u, w_dw, b_dw, g_ln, b_ln):
    a, g = jnp.split(u, 2, axis=-1)
    h = a * jax.nn.sigmoid(g)
    h = depthwise_conv(h, w_dw) + b_dw
    return jax.nn.silu(layer_norm(h, g_ln, b_ln))


def split_heads(t):
    return t.reshape(*t.shape[:-1], N_NA_HEADS, NA_HEAD_DIM)


def na_tables(rows):
    wr = min(NA_WIN_ROWS_MAX, rows)
    r = np.arange(rows)
    row_start = np.clip(r - wr // 2, 0, rows - wr)
    row_idx = row_start[:, None] + np.arange(wr)[None, :]
    d_row = row_idx - r[:, None] + (NA_WIN_ROWS_MAX - 1)
    j = np.arange(GRID_W)
    col_start = np.clip(j - NA_WIN_COLS // 2, 0, GRID_W - NA_WIN_COLS)
    col_in = (j[None, :] >= col_start[:, None]) & (j[None, :] < col_start[:, None] + NA_WIN_COLS)
    d_col = np.clip(j[None, :] - j[:, None] + NA_WIN_COLS - 1, 0, 2 * NA_WIN_COLS - 2)
    return wr, row_idx, d_row, col_in, d_col


def neighbourhood_attention(q, k, v, k_ctx, v_ctx, rpb, tables):
    wr, row_idx, d_row, col_in, d_col = tables
    bsz, seq = q.shape[0], q.shape[1]
    rows = seq // GRID_W
    grid = lambda t: t.reshape(bsz, rows, GRID_W, N_NA_HEADS, NA_HEAD_DIM)
    qg, kg, vg = grid(q), grid(k), grid(v)
    k_band = kg[:, row_idx]
    v_band = vg[:, row_idx]
    s_band = jnp.einsum('brqhd,brwkhd->bhrqwk', qg, k_band).astype(jnp.float32)
    bias = rpb.astype(jnp.float32)[:, d_row[:, None, :, None], d_col[None, :, None, :]]
    bias = jnp.where(col_in[None, None, :, None, :], bias, NEG_INF)
    s_band = (s_band + bias[None]).reshape(bsz, N_NA_HEADS, rows, GRID_W, wr * GRID_W)
    s_ctx = jnp.einsum('brqhd,bchd->bhrqc', qg, k_ctx).astype(jnp.float32)
    p = jax.nn.softmax(jnp.concatenate([s_band, s_ctx], axis=-1), axis=-1).astype(v.dtype)
    p_band = p[..., :wr * GRID_W].reshape(bsz, N_NA_HEADS, rows, GRID_W, wr, GRID_W)
    p_ctx = p[..., wr * GRID_W:]
    o = (jnp.einsum('bhrqwk,brwkhd->brqhd', p_band, v_band)
         + jnp.einsum('bhrqc,bchd->brqhd', p_ctx, v_ctx))
    return o.reshape(bsz, seq, D_NA)


def context_attention(q, k, v):
    s = jnp.einsum('bqhd,bkhd->bhqk', q, k).astype(jnp.float32)
    p = jax.nn.softmax(s, axis=-1).astype(v.dtype)
    o = jnp.einsum('bhqk,bkhd->bqhd', p, v)
    return o.reshape(q.shape[0], q.shape[1], D_NA)


def expert_choice_ffn(h, w_router, w_gate, w_up, w_down):
    bsz, n_tok, d = h.shape
    cap = EC_CAPACITY_FACTOR * n_tok // N_EXPERTS
    aff = jax.nn.softmax((h @ w_router).astype(jnp.float32), axis=-1)
    g, idx = lax.top_k(jnp.swapaxes(aff, 1, 2), cap)
    b_idx = jnp.arange(bsz)[:, None, None]
    xs = h[b_idx, idx]
    a = jnp.einsum('becd,edf->becf', xs, w_gate)
    u = jnp.einsum('becd,edf->becf', xs, w_up)
    y = jnp.einsum('becf,efd->becd', jax.nn.silu(a) * u, w_down)
    y = y * g[..., None].astype(y.dtype)
    flat = (b_idx * n_tok + idx).reshape(-1)
    out = jax.ops.segment_sum(y.reshape(-1, d), flat, num_segments=bsz * n_tok)
    return out.reshape(bsz, n_tok, d)


def post_norm(x, y, gate, g, b):
    return layer_norm(DEEPNORM_ALPHA * x + (1 + gate) * y, g, b)


def setup_inputs(seed: int = 0) -> dict:
    key = jax.random.key(seed)
    ks = jax.random.split(key, 32)
    f32 = jnp.float32
    L = DEPTH

    def nrm(k, shape, s):
        return jax.random.normal(k, shape, f32) * s

    return {
        "x": nrm(ks[0], (BATCH, SEQ, D_MODEL), 1.0),
        "c": nrm(ks[1], (BATCH, D_MODEL), 1.0),
        "ctx": nrm(ks[2], (BATCH, CTX_LEN, D_MODEL), 1.0),
        "c_ctx": nrm(ks[3], (D_MODEL,), 1.0),
        "w_mod": nrm(ks[4], (L, D_MODEL, 6 * D_MODEL), 0.1 * D_MODEL ** -0.5),
        "b_mod": nrm(ks[5], (L, 6 * D_MODEL), 0.01),
        "w_in": nrm(ks[6], (L, D_MODEL, D_IN), D_MODEL ** -0.5),
        "b_in": nrm(ks[7], (L, D_IN), 0.01),
        "w_short": nrm(ks[8], (L, SHORT_CONV_W, D_CONV), SHORT_CONV_W ** -0.5),
        "w_conf_dw": nrm(ks[9], (L, CONF_CONV_W, D_CONF), CONF_CONV_W ** -0.5),
        "b_conf_dw": nrm(ks[10], (L, D_CONF), 0.01),
        "g_conf_ln": 1.0 + nrm(ks[11], (L, D_CONF), 0.01),
        "b_conf_ln": nrm(ks[12], (L, D_CONF), 0.01),
        "na_rpb": nrm(ks[13], (L, N_NA_HEADS, 2 * NA_WIN_ROWS_MAX - 1, 2 * NA_WIN_COLS - 1), 0.1),
        "w_out": nrm(ks[14], (L, D_MIX, D_MODEL), DEEPNORM_BETA * D_MIX ** -0.5),
        "b_out": nrm(ks[15], (L, D_MODEL), 0.01),
        "g_post1": 1.0 + nrm(ks[16], (L, D_MODEL), 0.01),
        "b_post1": nrm(ks[17], (L, D_MODEL), 0.01),
        "w_router": nrm(ks[18], (L, D_MODEL, N_EXPERTS), D_MODEL ** -0.5),
        "w_gate": nrm(ks[19], (L, N_EXPERTS, D_MODEL, D_EXPERT), D_MODEL ** -0.5),
        "w_up": nrm(ks[20], (L, N_EXPERTS, D_MODEL, D_EXPERT), D_MODEL ** -0.5),
        "w_down": nrm(ks[21], (L, N_EXPERTS, D_EXPERT, D_MODEL), DEEPNORM_BETA * D_EXPERT ** -0.5),
        "g_post2": 1.0 + nrm(ks[22], (L, D_MODEL), 0.01),
        "b_post2": nrm(ks[23], (L, D_MODEL), 0.01),
    }


def reference(x, c, ctx, c_ctx, w_mod, b_mod, w_in, b_in, w_short, w_conf_dw, b_conf_dw, g_conf_ln, b_conf_ln,
              na_rpb, w_out, b_out, g_post1, b_post1, w_router, w_gate, w_up, w_down, g_post2, b_post2):
    rows = x.shape[1] // GRID_W
    tables = na_tables(rows)
    q_scale = NA_HEAD_DIM ** -0.5
    xc = ctx
    for l in range(DEPTH):
        last = l == DEPTH - 1
        sh1, sc1, gt1, sh2, sc2, gt2 = [m[:, None, :] for m in modulation(c, w_mod[l], b_mod[l])]
        csh1, csc1, cgt1, csh2, csc2, cgt2 = modulation(c_ctx, w_mod[l], b_mod[l])

        h = modulate(layer_norm(x), sh1, sc1)
        hc = modulate(layer_norm(xc), csh1, csc1)
        u = h @ w_in[l] + b_in[l]
        if last:
            uc_kv = hc @ w_in[l][:, OFF_K:] + b_in[l][OFF_K:]
            k_c, v_c = split_heads(uc_kv[..., :D_NA]), split_heads(uc_kv[..., D_NA:])
        else:
            uc = hc @ w_in[l] + b_in[l]
            k_c, v_c = split_heads(uc[..., OFF_K:OFF_V]), split_heads(uc[..., OFF_V:])

        ya = short_conv_mixer(u[..., OFF_A:OFF_B], w_short[l])
        yb = conformer_conv_mixer(u[..., OFF_B:OFF_Q], w_conf_dw[l], b_conf_dw[l], g_conf_ln[l], b_conf_ln[l])
        yc = neighbourhood_attention(split_heads(u[..., OFF_Q:OFF_K]) * q_scale, split_heads(u[..., OFF_K:OFF_V]),
                                     split_heads(u[..., OFF_V:]), k_c, v_c, na_rpb[l], tables)
        y = jnp.concatenate([ya, yb, yc], axis=-1) @ w_out[l] + b_out[l]
        x_mid = post_norm(x, y, gt1, g_post1[l], b_post1[l])

        if not last:
            yac = short_conv_mixer(uc[..., OFF_A:OFF_B], w_short[l])
            ybc = conformer_conv_mixer(uc[..., OFF_B:OFF_Q], w_conf_dw[l], b_conf_dw[l], g_conf_ln[l], b_conf_ln[l])
            ycc = context_attention(split_heads(uc[..., OFF_Q:OFF_K]) * q_scale, k_c, v_c)
            yctx = jnp.concatenate([yac, ybc, ycc], axis=-1) @ w_out[l] + b_out[l]
            xc_mid = post_norm(xc, yctx, cgt1, g_post1[l], b_post1[l])

        hm = modulate(layer_norm(x_mid), sh2, sc2)
        ym = expert_choice_ffn(hm, w_router[l], w_gate[l], w_up[l], w_down[l])
        x = post_norm(x_mid, ym, gt2, g_post2[l], b_post2[l])

        if not last:
            hmc = modulate(layer_norm(xc_mid), csh2, csc2)
            ymc = expert_choice_ffn(hmc, w_router[l], w_gate[l], w_up[l], w_down[l])
            xc = post_norm(xc_mid, ymc, cgt2, g_post2[l], b_post2[l])
    return x
```

```cpp
#include <hip/hip_runtime.h>
#include <hip/hip_cooperative_groups.h>
#include <cstdio>
#include <cstdint>
namespace cg = cooperative_groups;

#ifndef MULTI
#define MULTI 1
#endif

#define LAS __attribute__((address_space(3)))
#define PG8_LAS __attribute__((address_space(3)))
typedef unsigned short bf16_t;
typedef short bf16x8 __attribute__((ext_vector_type(8)));
typedef short s16x4 __attribute__((ext_vector_type(4)));
typedef float f32x4 __attribute__((ext_vector_type(4)));
typedef unsigned u32x4 __attribute__((ext_vector_type(4)));
typedef unsigned u32x2 __attribute__((ext_vector_type(2)));

constexpr int DM = 1024, NB = 8, SEQ = 2048, CTXL = 256, NL = 2;
constexpr int T_LAT = NB * SEQ, T_CTX = NB * CTXL, T_ALL = T_LAT + T_CTX;
constexpr int D_IN = 2816, OFF_A = 0, OFF_B = 768, OFF_Q = 1280, OFF_K = 1792, OFF_V = 2304;
constexpr int NE = 16, CAP_L = 256, CAP_C = 32, ROWS_E = NB * CAP_L + NB * CAP_C;
constexpr float LN_EPS = 1e-5f;
constexpr float ALPHA = 1.4142135623730951f;
constexpr float LOG2E = 1.4426950408889634f;
constexpr int NTHR = 512, NWAVE = 8;
constexpr int LDS_BYTES = 147456;

constexpr size_t SZ_WIN = (size_t)NL * D_IN * DM * 2, SZ_WOUT = (size_t)NL * DM * DM * 2, SZ_WGU = (size_t)NL * NE * 2048 * DM * 2, SZ_WD = (size_t)NL * NE * DM * DM * 2;
constexpr size_t SZ_MOD = (size_t)NL * 9 * 6144 * 4, SZ_AFF = (size_t)T_ALL * 16 * 4;
constexpr size_t SZ_R3 = (size_t)T_ALL * DM * 2, SZ_R1 = (size_t)T_ALL * D_IN * 2, SZ_R2 = (size_t)T_ALL * DM * 4, SZ_XB = (size_t)T_ALL * DM * 4;
constexpr size_t WS_WIN = 0, WS_WOUT = WS_WIN + SZ_WIN, WS_WGU = WS_WOUT + SZ_WOUT, WS_WD = WS_WGU + SZ_WGU, WS_MOD = WS_WD + SZ_WD;
constexpr size_t WS_AFF = WS_MOD + SZ_MOD, WS_SLOT = WS_AFF + SZ_AFF, WS_R3 = WS_SLOT + SZ_AFF, WS_R1 = WS_R3 + SZ_R3, WS_R2 = WS_R1 + SZ_R1, WS_XB = WS_R2 + SZ_R2, WS_END = WS_XB + SZ_XB;
static_assert(WS_END <= (size_t)536870912, "workspace map exceeds 512 MiB");
static_assert((size_t)NE * ROWS_E * DM * 2 <= SZ_R1 && (size_t)NE * ROWS_E * DM * 2 <= SZ_R2, "MoE buffers fit their overlays");

struct Params {
    const float *x, *c, *ctx, *c_ctx, *w_mod, *b_mod, *w_in, *b_in, *w_short, *w_conf_dw, *b_conf_dw, *g_conf_ln, *b_conf_ln, *na_rpb, *w_out, *b_out,
                *g_post1, *b_post1, *w_router, *w_gate, *w_up, *w_down, *g_post2, *b_post2;
    float* out; unsigned char* ws; int ph_lo, ph_hi;
};

__device__ __forceinline__ unsigned cvt_pk_bf16(float lo, float hi) { unsigned r; asm volatile("v_cvt_pk_bf16_f32 %0, %1, %2" : "=v"(r) : "v"(lo), "v"(hi)); return r; }
__device__ __forceinline__ float bflo(unsigned u) { return __builtin_bit_cast(float, u << 16); }
__device__ __forceinline__ float bfhi(unsigned u) { return __builtin_bit_cast(float, u & 0xffff0000u); }
__device__ __forceinline__ float wave_sum(float v) {
#pragma unroll
    for (int o = 1; o < 64; o <<= 1) v += __shfl_xor(v, o);
    return v;
}
__device__ __forceinline__ float sigmoid_f(float x) { return 1.f / (1.f + __expf(-x)); }
__device__ __forceinline__ void ln16(f32x4 (&v)[4]) {
    float s = 0.f;
#pragma unroll
    for (int j = 0; j < 4; ++j) s += (v[j].x + v[j].y) + (v[j].z + v[j].w);
    const float mean = wave_sum(s) * (1.f / DM); float s2 = 0.f;
#pragma unroll
    for (int j = 0; j < 4; ++j) { v[j] = v[j] - mean; s2 += (v[j].x * v[j].x + v[j].y * v[j].y) + (v[j].z * v[j].z + v[j].w * v[j].w); }
    const float rstd = 1.f / sqrtf(wave_sum(s2) * (1.f / DM) + LN_EPS);
#pragma unroll
    for (int j = 0; j < 4; ++j) v[j] = v[j] * rstd;
}
__device__ __forceinline__ void ld_row(f32x4 (&v)[4], const float* row, int lane) {
#pragma unroll
    for (int j = 0; j < 4; ++j) v[j] = *(const f32x4*)(row + 256 * j + 4 * lane);
}
__device__ __forceinline__ void st_row(float* row, const f32x4 (&v)[4], int lane) {
#pragma unroll
    for (int j = 0; j < 4; ++j) *(f32x4*)(row + 256 * j + 4 * lane) = v[j];
}
__device__ __forceinline__ void st_row_bf16(bf16_t* row, const f32x4 (&v)[4], int lane) {
#pragma unroll
    for (int j = 0; j < 4; ++j) { u32x2 w; w.x = cvt_pk_bf16(v[j].x, v[j].y); w.y = cvt_pk_bf16(v[j].z, v[j].w); *(u32x2*)(row + 256 * j + 4 * lane) = w; }
}
__device__ __forceinline__ int mod_row_of(int row) { return row < T_LAT ? (row >> 11) : 8; }

namespace pg8 {
constexpr int BM = 256, BK = 64, HALF = 128, HTB = HALF * BK * 2, NXCD = 8, WGM = 8;
__host__ __device__ __forceinline__ int lds_byte(int r, int c) { const int st = (r >> 4) * 2 + (c >> 5), rr = r & 15, cc = c & 31, ob = rr * 64 + cc * 2; return st * 1024 + (ob ^ (((ob >> 9) & 1) << 5)); }
__host__ __device__ __forceinline__ void stage_rc(int b, int& R, int& C) { const int st = b / 1024, sb = b % 1024, swz = sb ^ (((sb >> 9) & 1) << 5); R = (st >> 1) * 16 + swz / 64; C = (st & 1) * 32 + (swz % 64) / 2; }
__host__ __device__ __forceinline__ int perm32(int rho) { const int n = rho >> 4, i = rho & 15; return 8 * (i >> 2) + 4 * n + (i & 3); }

struct Unit { int pm, pn, ex; };
struct Gemm { const bf16_t* A; const bf16_t* Bt; int K; };

struct Sched {
    int ngrp, nM, nN, aM, aN, tailM0, tailN0, tailNn, ntail, G, c;
    __device__ __forceinline__ bool next(int i, Unit& u) const {
        const int nmain = ngrp * nM * nN; const long L = (long)i * G + c; if (L >= nmain + ntail) return false;
        if (L >= nmain) { const int t = (int)L - nmain; u.pm = tailM0 + t / tailNn; u.pn = tailN0 + t % tailNn; u.ex = u.pn; return true; }
        int wg = (int)L; { const int q = nmain / NXCD, r = nmain % NXCD, xcd = wg % NXCD, off = wg / NXCD; wg = (xcd < r ? xcd * (q + 1) : r * (q + 1) + (xcd - r) * q) + off; }
        const int per = nM * nN, grp = wg / per, w2 = wg % per;
        const int nig = WGM * nN, gid = w2 / nig, fm = gid * WGM, gsz = (nM - fm) < WGM ? (nM - fm) : WGM;
        const int pml = fm + ((w2 % nig) % gsz), pnl = (w2 % nig) / gsz;
        u.pm = grp * aM + pml; u.pn = grp * aN + pnl; u.ex = pnl; return true;
    }
    __device__ __forceinline__ void a_ready(const Unit&) const {}
    __device__ __forceinline__ void done(const Unit&) const {}
};

struct EpiBf16 {
    static constexpr bool PERM = true, AFTER_DRAIN = false;
    bf16_t* O; int ldc; const float* bias; int q_lo, q_hi;
    __device__ __forceinline__ void operator()(const f32x4 (&acc)[2][2][4][2], const Unit& u, int wr, int wc, int fr, int fq) const {
        const int row0 = u.pm * BM + wr * 64 + fr; const int col0 = u.ex * BM + wc * 32 + 8 * fq;
        const float sc = (u.ex >= q_lo && u.ex < q_hi) ? 0.125f : 1.f;
        f32x4 bv[2][2];
#pragma unroll
        for (int bj = 0; bj < 2; ++bj)
#pragma unroll
            for (int n = 0; n < 2; ++n) bv[bj][n] = bias ? *(const f32x4*)(bias + col0 + bj * HALF + 4 * n) : (f32x4){0.f, 0.f, 0.f, 0.f};
#pragma unroll
        for (int ai = 0; ai < 2; ++ai)
#pragma unroll
            for (int m = 0; m < 4; ++m) { bf16_t* rowp = O + (size_t)(row0 + ai * HALF + m * 16) * ldc + col0;
#pragma unroll
                for (int bj = 0; bj < 2; ++bj) { f32x4 v0 = (acc[ai][bj][m][0] + bv[bj][0]) * sc, v1 = (acc[ai][bj][m][1] + bv[bj][1]) * sc;
                    u32x4 w; w.x = cvt_pk_bf16(v0[0], v0[1]); w.y = cvt_pk_bf16(v0[2], v0[3]); w.z = cvt_pk_bf16(v1[0], v1[1]); w.w = cvt_pk_bf16(v1[2], v1[3]);
                    *(u32x4*)(rowp + bj * HALF) = w; } }
    }
};
struct EpiF32 {
    static constexpr bool PERM = true, AFTER_DRAIN = false;
    float* O; int ldc; const float* bias;
    __device__ __forceinline__ void operator()(const f32x4 (&acc)[2][2][4][2], const Unit& u, int wr, int wc, int fr, int fq) const {
        const int row0 = u.pm * BM + wr * 64 + fr; const int col0 = u.ex * BM + wc * 32 + 8 * fq;
        f32x4 bv[2][2];
#pragma unroll
        for (int bj = 0; bj < 2; ++bj)
#pragma unroll
            for (int n = 0; n < 2; ++n) bv[bj][n] = *(const f32x4*)(bias + col0 + bj * HALF + 4 * n);
#pragma unroll
        for (int ai = 0; ai < 2; ++ai)
#pragma unroll
            for (int m = 0; m < 4; ++m) { float* rowp = O + (size_t)(row0 + ai * HALF + m * 16) * ldc + col0;
#pragma unroll
                for (int bj = 0; bj < 2; ++bj) { *(f32x4*)(rowp + bj * HALF) = acc[ai][bj][m][0] + bv[bj][0]; *(f32x4*)(rowp + bj * HALF + 4) = acc[ai][bj][m][1] + bv[bj][1]; } }
    }
};
struct EpiSwiglu {
    static constexpr bool PERM = true, AFTER_DRAIN = false;
    bf16_t* O; int ldc;
    __device__ __forceinline__ void operator()(const f32x4 (&acc)[2][2][4][2], const Unit& u, int wr, int wc, int fr, int fq) const {
        const int row0 = u.pm * BM + wr * 64 + fr; const int col0 = u.ex * HALF + wc * 32 + 8 * fq;
#pragma unroll
        for (int ai = 0; ai < 2; ++ai)
#pragma unroll
            for (int m = 0; m < 4; ++m) { bf16_t* rowp = O + (size_t)(row0 + ai * HALF + m * 16) * ldc + col0;
                float r[8];
#pragma unroll
                for (int n = 0; n < 2; ++n)
#pragma unroll
                    for (int j = 0; j < 4; ++j) { const float a = acc[ai][0][m][n][j], b = acc[ai][1][m][n][j]; r[4 * n + j] = a / (1.f + __expf(-a)) * b; }
                u32x4 w; w.x = cvt_pk_bf16(r[0], r[1]); w.y = cvt_pk_bf16(r[2], r[3]); w.z = cvt_pk_bf16(r[4], r[5]); w.w = cvt_pk_bf16(r[6], r[7]);
                *(u32x4*)rowp = w; }
    }
};

template <class Epi, class Sched, bool ALIGN_EPI = false, bool SP2 = false>
__device__ __forceinline__ void gemm_phase(PG8_LAS unsigned char* lds, const Gemm g, const Sched& S, const Epi& E, const int tid) {
    const int wid = __builtin_amdgcn_readfirstlane(tid >> 6), lane = tid & 63, wr = wid >> 2, wc = wid & 3, fr = lane & 15, fq = lane >> 4;
    const int K = g.K, nt = K / BK;
    unsigned voffA[2], voffB[2];
#pragma unroll
    for (int i = 0; i < 2; ++i) { int R, C; stage_rc(tid * 16 + i * 8192, R, C); const int Rb = Epi::PERM ? ((R & ~31) + perm32(R & 31)) : R;
        voffA[i] = (unsigned)(R * K + C) * 2u; voffB[i] = (unsigned)(Rb * K + C) * 2u; }
    const size_t kstep = (size_t)(BK * 2);
    const size_t hstep = (size_t)HALF * K * 2;
    const size_t tstep = 2 * hstep;
    const unsigned ldsw = (unsigned)wid * 1024u;
    const int aoff = lds_byte(wr * 64 + fr, fq * 8), boff = lds_byte(wc * 32 + fr, fq * 8);
#define PG8_SA(b, h) (((b) * 2 + (h)) * HTB)
#define PG8_SB(b, h) ((4 + (b) * 2 + (h)) * HTB)
#define PG8_STAGE(bufoff, gbase, voff) do { _Pragma("unroll") for (int _i = 0; _i < 2; ++_i) \
        __builtin_amdgcn_global_load_lds((const unsigned*)((const char*)(gbase) + (voff)[_i]), (PG8_LAS unsigned*)(lds + (bufoff) + ldsw + _i * 8192), 16, 0, 0); } while (0)
#define PG8_LDA(dst, b, h) do { _Pragma("unroll") for (int m = 0; m < 4; ++m) _Pragma("unroll") for (int k = 0; k < 2; ++k) dst[m][k] = *(const PG8_LAS bf16x8*)(lds + PG8_SA(b, h) + aoff + m * 2048 + k * 1024); } while (0)
#define PG8_LDB(dst, b, h) do { _Pragma("unroll") for (int n = 0; n < 2; ++n) _Pragma("unroll") for (int k = 0; k < 2; ++k) dst[n][k] = *(const PG8_LAS bf16x8*)(lds + PG8_SB(b, h) + boff + n * 2048 + k * 1024); } while (0)
#define PG8_MMA(ai, bj, At, Bt) do { __builtin_amdgcn_s_setprio(1); _Pragma("unroll") for (int m = 0; m < 4; ++m) _Pragma("unroll") for (int n = 0; n < 2; ++n) _Pragma("unroll") for (int k = 0; k < 2; ++k) \
        acc[ai][bj][m][n] = __builtin_amdgcn_mfma_f32_16x16x32_bf16(Bt[n][k], At[m][k], acc[ai][bj][m][n], 0, 0, 0); __builtin_amdgcn_s_setprio(0); } while (0)
#define PG8_WAIT_V(n) asm volatile("s_waitcnt vmcnt(" #n ")" ::: "memory")
#define PG8_WAIT_L(n) asm volatile("s_waitcnt lgkmcnt(" #n ")" ::: "memory")
#define PG8_BAR __builtin_amdgcn_s_barrier()
#define PG8_SCHED __builtin_amdgcn_sched_barrier(0)
    Unit cur, nxt; int ui = 0;
    if (!S.next(0, cur)) return;
    f32x4 acc[2][2][4][2];
#pragma unroll
    for (int a = 0; a < 2; ++a)
#pragma unroll
        for (int b = 0; b < 2; ++b)
#pragma unroll
            for (int m = 0; m < 4; ++m)
#pragma unroll
                for (int n = 0; n < 2; ++n) acc[a][b][m][n] = (f32x4){0.f, 0.f, 0.f, 0.f};
    bf16x8 At[4][2], B0[2][2], B1[2][2];
    const char* cA = (const char*)g.A + (size_t)cur.pm * tstep; const char* cB = (const char*)g.Bt + (size_t)cur.pn * tstep;
    S.a_ready(cur);
    if constexpr (SP2) {
        PG8_STAGE(PG8_SB(0, 0), cB, voffB); PG8_STAGE(PG8_SB(0, 1), cB + hstep, voffB); PG8_STAGE(PG8_SA(0, 0), cA, voffA); PG8_STAGE(PG8_SA(0, 1), cA + hstep, voffA);
        if (wr == 1) PG8_BAR;
        PG8_WAIT_V(2); PG8_BAR;
        PG8_STAGE(PG8_SB(1, 0), cB + kstep, voffB); PG8_STAGE(PG8_SA(1, 0), cA + kstep, voffA); PG8_STAGE(PG8_SB(1, 1), cB + hstep + kstep, voffB);
        PG8_WAIT_V(6); PG8_BAR;
    } else {
        PG8_STAGE(PG8_SB(0, 0), cB, voffB); PG8_STAGE(PG8_SA(0, 0), cA, voffA); PG8_STAGE(PG8_SB(0, 1), cB + hstep, voffB); PG8_STAGE(PG8_SA(0, 1), cA + hstep, voffA);
        if (wr == 1) PG8_BAR;
        PG8_WAIT_V(4); PG8_BAR;
        PG8_STAGE(PG8_SB(1, 0), cB + kstep, voffB); PG8_STAGE(PG8_SA(1, 0), cA + kstep, voffA); PG8_STAGE(PG8_SB(1, 1), cB + hstep + kstep, voffB);
        PG8_WAIT_V(6); PG8_BAR;
    }
    for (;;) {
        const bool has_next = S.next(ui + 1, nxt);
        const char* nA = has_next ? (const char*)g.A + (size_t)nxt.pm * tstep : cA; const char* nB = has_next ? (const char*)g.Bt + (size_t)nxt.pn * tstep : cB;
        for (int t = 0; t < nt; t += 2) {
            const bool last = (t == nt - 2);
            const char* a1 = cA + (size_t)(t + 1) * kstep;
            const char* a2 = last ? nA : cA + (size_t)(t + 2) * kstep; const char* b2 = last ? nB : cB + (size_t)(t + 2) * kstep;
            const char* a3 = a2 + kstep; const char* b3 = b2 + kstep;
            if (last && has_next) S.a_ready(nxt);
            if constexpr (SP2) {
            PG8_LDB(B0, 0, 0); PG8_LDB(B1, 0, 1); PG8_SCHED; PG8_LDA(At, 0, 0); PG8_STAGE(PG8_SA(1, 1), a1 + hstep, voffA);
            PG8_WAIT_V(8); PG8_WAIT_L(0); PG8_BAR; PG8_MMA(0, 0, At, B0); PG8_MMA(0, 1, At, B1); PG8_BAR; PG8_SCHED;
            PG8_LDA(At, 0, 1); PG8_STAGE(PG8_SB(0, 0), b2, voffB); PG8_STAGE(PG8_SB(0, 1), b2 + hstep, voffB); PG8_STAGE(PG8_SA(0, 0), a2, voffA);
            PG8_WAIT_V(8); PG8_WAIT_L(0); PG8_BAR; PG8_MMA(1, 0, At, B0); PG8_MMA(1, 1, At, B1); PG8_BAR; PG8_SCHED;
            PG8_LDB(B0, 1, 0); PG8_LDB(B1, 1, 1); PG8_SCHED; PG8_LDA(At, 1, 0); PG8_STAGE(PG8_SA(0, 1), a2 + hstep, voffA);
            PG8_WAIT_V(8); PG8_WAIT_L(0); PG8_BAR; PG8_MMA(0, 0, At, B0); PG8_MMA(0, 1, At, B1); PG8_BAR; PG8_SCHED;
            PG8_LDA(At, 1, 1); PG8_STAGE(PG8_SB(1, 0), b3, voffB); PG8_STAGE(PG8_SB(1, 1), b3 + hstep, voffB); PG8_STAGE(PG8_SA(1, 0), a3, voffA);
            PG8_WAIT_V(8); PG8_WAIT_L(0); PG8_BAR; PG8_MMA(1, 0, At, B0); PG8_MMA(1, 1, At, B1); PG8_BAR; PG8_SCHED;
            } else {
            PG8_LDB(B0, 0, 0); PG8_SCHED; PG8_LDA(At, 0, 0); PG8_STAGE(PG8_SA(1, 1), a1 + hstep, voffA);
            PG8_WAIT_L(8); PG8_BAR; PG8_WAIT_L(0); PG8_MMA(0, 0, At, B0); PG8_BAR; PG8_SCHED;
            PG8_LDB(B1, 0, 1); PG8_STAGE(PG8_SB(0, 0), b2, voffB);
            PG8_BAR; PG8_WAIT_L(0); PG8_MMA(0, 1, At, B1); PG8_BAR;
            PG8_LDA(At, 0, 1); PG8_STAGE(PG8_SA(0, 0), a2, voffA);
            PG8_BAR; PG8_WAIT_L(0); PG8_MMA(1, 0, At, B0); PG8_BAR; PG8_SCHED;
            PG8_STAGE(PG8_SB(0, 1), b2 + hstep, voffB);
            PG8_WAIT_V(6); PG8_BAR; PG8_MMA(1, 1, At, B1); PG8_BAR;
            PG8_LDB(B0, 1, 0); PG8_SCHED; PG8_LDA(At, 1, 0); PG8_STAGE(PG8_SA(0, 1), a2 + hstep, voffA);
            PG8_WAIT_L(8); PG8_BAR; PG8_WAIT_L(0); PG8_MMA(0, 0, At, B0); PG8_BAR; PG8_SCHED;
            PG8_LDB(B1, 1, 1); PG8_STAGE(PG8_SB(1, 0), b3, voffB);
            PG8_BAR; PG8_WAIT_L(0); PG8_MMA(0, 1, At, B1); PG8_BAR;
            PG8_LDA(At, 1, 1); PG8_STAGE(PG8_SA(1, 0), a3, voffA);
            PG8_BAR; PG8_WAIT_L(0); PG8_MMA(1, 0, At, B0); PG8_BAR; PG8_SCHED;
            PG8_STAGE(PG8_SB(1, 1), b3 + hstep, voffB);
            PG8_WAIT_V(6); PG8_BAR; PG8_MMA(1, 1, At, B1); PG8_BAR;
            }
        }
        if constexpr (ALIGN_EPI) { if (wr == 0) PG8_BAR; }
        if constexpr (!Epi::AFTER_DRAIN) { E(acc, cur, wr, wc, fr, fq); S.done(cur); }
        if (!has_next) break;
#pragma unroll
        for (int a = 0; a < 2; ++a)
#pragma unroll
            for (int b = 0; b < 2; ++b)
#pragma unroll
                for (int m = 0; m < 4; ++m)
#pragma unroll
                    for (int n = 0; n < 2; ++n) acc[a][b][m][n] = (f32x4){0.f, 0.f, 0.f, 0.f};
        cur = nxt; cA = nA; cB = nB; ++ui;
        if constexpr (ALIGN_EPI) { if (wr == 1) PG8_BAR; }
    }
    PG8_WAIT_V(0);
    if constexpr (!ALIGN_EPI) { if (wr == 0) PG8_BAR; }
    PG8_BAR;
    if constexpr (Epi::AFTER_DRAIN) { E.fused(acc, cur, wr, wc, fr, fq, lds, wid, lane); S.done(cur); }
#undef PG8_SA
#undef PG8_SB
#undef PG8_STAGE
#undef PG8_LDA
#undef PG8_LDB
#undef PG8_MMA
#undef PG8_WAIT_V
#undef PG8_WAIT_L
#undef PG8_BAR
#undef PG8_SCHED
}
}

__device__ __forceinline__ void mod_item(const Params& p, int item, LAS float* sc, LAS float* red, int tid) {
    const int l = item / 192, n0 = (item % 192) * 32, col = tid & 31, kg = tid >> 5;
    const float* W = p.w_mod + (size_t)l * DM * 6144 + n0 + col;
    float acc[9];
#pragma unroll
    for (int r = 0; r < 9; ++r) acc[r] = 0.f;
#pragma unroll 8
    for (int kk = 0; kk < 64; ++kk) { const int k = kg * 64 + kk; const float w = W[(size_t)k * 6144];
#pragma unroll
        for (int r = 0; r < 9; ++r) acc[r] += sc[r * DM + k] * w; }
#pragma unroll
    for (int r = 0; r < 9; ++r) red[(kg * 9 + r) * 32 + col] = acc[r];
    __syncthreads();
    if (tid < 288) { const int r = tid >> 5; float s = p.b_mod[l * 6144 + n0 + col];
#pragma unroll
        for (int g = 0; g < 16; ++g) s += red[(g * 9 + r) * 32 + col];
        ((float*)(p.ws + WS_MOD))[((size_t)l * 9 + r) * 6144 + n0 + col] = s; }
    __syncthreads();
}
__device__ __forceinline__ void transpose_tile(const float* W, int N, int k0, int n0, bf16_t* dst0  , LAS float* scr, int lane) {
    const float* src = W + (size_t)k0 * N + n0 + 4 * (lane & 15);
    f32x4 v[16];
#pragma unroll
    for (int i = 0; i < 16; ++i) v[i] = *(const f32x4*)(src + (size_t)(4 * i + (lane >> 4)) * N);
#pragma unroll
    for (int i = 0; i < 16; ++i) { LAS float* d = scr + (4 * i + (lane >> 4)) * 65 + 4 * (lane & 15); d[0] = v[i].x; d[1] = v[i].y; d[2] = v[i].z; d[3] = v[i].w; }
    asm volatile("s_waitcnt lgkmcnt(0)" ::: "memory");
    const int c = lane & 7;
#pragma unroll
    for (int j = 0; j < 8; ++j) { const int n = (lane >> 3) + 8 * j; const LAS float* s = scr + (8 * c) * 65 + n;
        u32x4 o; o.x = cvt_pk_bf16(s[0], s[65]); o.y = cvt_pk_bf16(s[130], s[195]); o.z = cvt_pk_bf16(s[260], s[325]); o.w = cvt_pk_bf16(s[390], s[455]);
        *(u32x4*)(dst0 + (size_t)n * DM + k0 + 8 * c) = o; }
    asm volatile("s_waitcnt lgkmcnt(0)" ::: "memory");
}
__device__ __forceinline__ void phase0(const Params& p, LAS unsigned char* lds, int bid, int G, int tid) {
    const int lane = tid & 63, wave = tid >> 6;
    {
        LAS float* sc = (LAS float*)lds; LAS float* red = (LAS float*)(lds + 9 * DM * 4);
        if (bid < 384) {
            for (int i = tid; i < 9 * DM; i += NTHR) { const int r = i >> 10, k = i & 1023; const float v = r < 8 ? p.c[r * DM + k] : p.c_ctx[k]; sc[i] = v / (1.f + __expf(-v)); }
            __syncthreads();
            for (int it = bid; it < 384; it += G) mod_item(p, it, sc, red, tid);
        }
        __syncthreads();
    }
    LAS float* scr = (LAS float*)(lds + wave * 16640);
    constexpr int I_IN = 16 * 44, I_OUT = 256, I_E = 48 * 256, I_L = I_IN + I_OUT + I_E;
    const int gw = bid * NWAVE + wave, NGW = G * NWAVE;
    for (int it = gw; it < NL * I_L; it += NGW) {
        const int l = it / I_L; int r = it % I_L;
        if (r < I_IN) { const int kt = r / 44, nt = r % 44;
            transpose_tile(p.w_in + (size_t)l * DM * D_IN, D_IN, kt * 64, nt * 64, (bf16_t*)(p.ws + WS_WIN) + ((size_t)l * D_IN + nt * 64) * DM, scr, lane); continue; }
        r -= I_IN;
        if (r < I_OUT) { const int kt = r / 16, nt = r % 16;
            transpose_tile(p.w_out + (size_t)l * DM * DM, DM, kt * 64, nt * 64, (bf16_t*)(p.ws + WS_WOUT) + ((size_t)l * DM + nt * 64) * DM, scr, lane); continue; }
        r -= I_OUT;
        const int mtx = r >> 8, t = r & 255, e = mtx / 3, which = mtx % 3, kt = t >> 4, nt = t & 15, n0 = nt * 64;
        const size_t eo = ((size_t)l * NE + e) * DM * DM;
        if (which == 2) transpose_tile(p.w_down + eo, DM, kt * 64, n0, (bf16_t*)(p.ws + WS_WD) + eo + (size_t)n0 * DM, scr, lane);
        else { const int row = (n0 >> 7) * 256 + (n0 & 127) + which * 128;
            transpose_tile((which == 0 ? p.w_gate : p.w_up) + eo, DM, kt * 64, n0, (bf16_t*)(p.ws + WS_WGU) + 2 * eo + (size_t)row * DM, scr, lane); }
    }
}

__device__ __forceinline__ void phaseA(const Params& p, int bid, int G, int tid) {
    const int lane = tid & 63, gw = bid * NWAVE + (tid >> 6), NGW = G * NWAVE;
    const float* MOD = (const float*)(p.ws + WS_MOD); bf16_t* H = (bf16_t*)(p.ws + WS_R3);
    for (int row = gw; row < T_ALL; row += NGW) {
        const float* xr = row < T_LAT ? p.x + (size_t)row * DM : p.ctx + (size_t)(row - T_LAT) * DM;
        const float* md = MOD + (size_t)mod_row_of(row) * 6144;
        f32x4 v[4], sh[4], sc[4]; ld_row(v, xr, lane); ld_row(sh, md, lane); ld_row(sc, md + DM, lane);
        ln16(v);
#pragma unroll
        for (int j = 0; j < 4; ++j) v[j] = v[j] * (sc[j] + 1.f) + sh[j];
        st_row_bf16(H + (size_t)row * DM, v, lane);
    }
}

constexpr int KRS = 144, VRS = 160;
constexpr int LDS_RPB = 768 * KRS, LDS_MRG = 768 * VRS;
static_assert(LDS_MRG + 4 * 64 * 18 * 4 <= LDS_BYTES && LDS_RPB + 465 * 4 <= LDS_MRG, "attention LDS map");

__device__ __forceinline__ void attn_item(const Params& p, int l, int item, bool ctxq, LAS unsigned char* lds, int tid) {
    const int lane = tid & 63, wave = tid >> 6, fr = lane & 15, g = lane >> 4;
    const bf16_t* U = (const bf16_t*)(p.ws + WS_R1); bf16_t* MIX = (bf16_t*)(p.ws + WS_R3);
    int b, h, r = 0, rs = 0, nrows, bandbase = 0, ctxbase, qtok;
    int qi = wave & 3, kh = wave >> 2, cw = 0;
    if (!ctxq) { b = item >> 8; r = (item >> 3) & 31; h = item & 7; rs = r - 4; rs = rs < 0 ? 0 : (rs > 24 ? 24 : rs); nrows = 768;
        bandbase = b * SEQ + rs * 64; ctxbase = T_LAT + b * CTXL; qtok = b * SEQ + r * 64 + 16 * qi + fr;
        cw = 16 * qi - 8; cw = cw < 0 ? 0 : (cw > 32 ? 32 : cw); }
    else { b = item >> 4; h = (item >> 1) & 7; const int half = item & 1; nrows = 256; ctxbase = T_LAT + b * CTXL; qtok = ctxbase + half * 128 + wave * 16 + fr; }
    const bool band = (!ctxq) && kh == 0;
    const int nb_rows = ctxq ? 0 : 512;
    {
        u32x4 t[12];
        const int chunk = tid & 7, r0 = tid >> 3;
#pragma unroll
        for (int ps = 0; ps < 12; ++ps) { const int row = ps * 64 + r0; if (row < nrows) { const int tok = row < nb_rows ? bandbase + row : ctxbase + row - nb_rows;
                t[ps] = *(const u32x4*)(U + (size_t)tok * D_IN + OFF_K + h * 64 + chunk * 8); } }
#pragma unroll
        for (int ps = 0; ps < 12; ++ps) { const int row = ps * 64 + r0; if (row < nrows) *(LAS u32x4*)(lds + row * KRS + chunk * 16) = t[ps]; }
        if (tid < 465) ((LAS float*)(lds + LDS_RPB))[tid] = p.na_rpb[((size_t)l * 8 + h) * 465 + tid];
    }
    bf16x8 qf[2];
#pragma unroll
    for (int ks = 0; ks < 2; ++ks) qf[ks] = *(const bf16x8*)(U + (size_t)qtok * D_IN + OFF_Q + h * 64 + 32 * ks + 8 * g);
    __syncthreads();
    const int base0 = ctxq ? 0 : 512;
    f32x4 s[16];
#pragma unroll
    for (int t = 0; t < 16; ++t) {
        const int rb = band ? ((t >> 1) * 64 + cw + 16 * (t & 1)) : (base0 + 16 * t);
        f32x4 a = {0.f, 0.f, 0.f, 0.f};
#pragma unroll
        for (int ks = 0; ks < 2; ++ks) { const bf16x8 kf = *(const LAS bf16x8*)(lds + (rb + fr) * KRS + (32 * ks + 8 * g) * 2);
            a = __builtin_amdgcn_mfma_f32_16x16x32_bf16(kf, qf[ks], a, 0, 0, 0); }
        s[t] = a;
    }
    if (band) {
        const LAS float* rpb = (const LAS float*)(lds + LDS_RPB);
        const int qcol = 16 * qi + fr; int cs = qcol - 8; cs = cs < 0 ? 0 : (cs > 48 ? 48 : cs);
#pragma unroll
        for (int t = 0; t < 16; ++t) { const int drow = rs + (t >> 1) - r + 7;
#pragma unroll
            for (int j = 0; j < 4; ++j) { const int kcol = cw + 16 * (t & 1) + 4 * g + j; int dc = kcol - qcol + 15; dc = dc < 0 ? 0 : (dc > 30 ? 30 : dc);
                const bool ok = kcol >= cs && kcol < cs + 16; s[t][j] = ok ? s[t][j] + rpb[drow * 31 + dc] : -1e30f; } }
    }
    float m = -3e38f;
#pragma unroll
    for (int t = 0; t < 16; ++t) m = fmaxf(m, fmaxf(fmaxf(s[t][0], s[t][1]), fmaxf(s[t][2], s[t][3])));
    m = fmaxf(m, __shfl_xor(m, 16)); m = fmaxf(m, __shfl_xor(m, 32));
    float lsum = 0.f; const float mb = m * LOG2E;
    bf16x8 pf[8];
#pragma unroll
    for (int c = 0; c < 8; ++c) {
        float e[8];
#pragma unroll
        for (int j = 0; j < 4; ++j) { e[j] = __builtin_amdgcn_exp2f(s[2 * c][j] * LOG2E - mb); e[4 + j] = __builtin_amdgcn_exp2f(s[2 * c + 1][j] * LOG2E - mb); }
#pragma unroll
        for (int j = 0; j < 8; ++j) lsum += e[j];
        u32x4 w; w.x = cvt_pk_bf16(e[0], e[1]); w.y = cvt_pk_bf16(e[2], e[3]); w.z = cvt_pk_bf16(e[4], e[5]); w.w = cvt_pk_bf16(e[6], e[7]);
        pf[c] = __builtin_bit_cast(bf16x8, w);
    }
    lsum += __shfl_xor(lsum, 16); lsum += __shfl_xor(lsum, 32);
    __syncthreads();
    {
        u32x4 t[12];
        const int chunk = tid & 7, r0 = tid >> 3;
#pragma unroll
        for (int ps = 0; ps < 12; ++ps) { const int row = ps * 64 + r0; if (row < nrows) { const int tok = row < nb_rows ? bandbase + row : ctxbase + row - nb_rows;
                t[ps] = *(const u32x4*)(U + (size_t)tok * D_IN + OFF_V + h * 64 + chunk * 8); } }
#pragma unroll
        for (int ps = 0; ps < 12; ++ps) { const int row = ps * 64 + r0; if (row < nrows) *(LAS u32x4*)(lds + row * VRS + chunk * 16) = t[ps]; }
    }
    __syncthreads();
    f32x4 o[4];
#pragma unroll
    for (int nd = 0; nd < 4; ++nd) o[nd] = (f32x4){0.f, 0.f, 0.f, 0.f};
    const int qq = fr >> 2, pp = fr & 3;
#pragma unroll
    for (int c = 0; c < 8; ++c) {
        const int rb0 = band ? (c * 64 + cw) : (base0 + 32 * c);
        const int rb1 = rb0 + 16;
        const LAS unsigned char* a0 = lds + (rb0 + 4 * g + qq) * VRS + 8 * pp;
        const LAS unsigned char* a1 = lds + (rb1 + 4 * g + qq) * VRS + 8 * pp;
#pragma unroll
        for (int nd = 0; nd < 4; ++nd) {
            const s16x4 lo = __builtin_amdgcn_ds_read_tr16_b64_v4i16((LAS s16x4*)(a0 + 32 * nd));
            const s16x4 hi = __builtin_amdgcn_ds_read_tr16_b64_v4i16((LAS s16x4*)(a1 + 32 * nd));
            const bf16x8 vf = (bf16x8){lo[0], lo[1], lo[2], lo[3], hi[0], hi[1], hi[2], hi[3]};
            o[nd] = __builtin_amdgcn_mfma_f32_16x16x32_bf16(vf, pf[c], o[nd], 0, 0, 0);
        }
    }
    bf16_t* orow = MIX + (size_t)qtok * DM + 512 + h * 64 + 4 * g;
    if (ctxq) {
        const float inv = 1.f / lsum;
#pragma unroll
        for (int nd = 0; nd < 4; ++nd) { u32x2 w; w.x = cvt_pk_bf16(o[nd][0] * inv, o[nd][1] * inv); w.y = cvt_pk_bf16(o[nd][2] * inv, o[nd][3] * inv); *(u32x2*)(orow + 16 * nd) = w; }
        __syncthreads();
    } else {
        LAS float* mg = (LAS float*)(lds + LDS_MRG) + qi * (64 * 18);
        if (kh == 1) { mg[lane] = m; mg[64 + lane] = lsum;
#pragma unroll
            for (int nd = 0; nd < 4; ++nd)
#pragma unroll
                for (int j = 0; j < 4; ++j) mg[(2 + nd * 4 + j) * 64 + lane] = o[nd][j]; }
        __syncthreads();
        if (kh == 0) { const float m1 = mg[lane], l1 = mg[64 + lane]; const float mm = fmaxf(m, m1);
            const float a0 = __builtin_amdgcn_exp2f((m - mm) * LOG2E), a1 = __builtin_amdgcn_exp2f((m1 - mm) * LOG2E);
            const float inv = 1.f / (lsum * a0 + l1 * a1);
#pragma unroll
            for (int nd = 0; nd < 4; ++nd) { float r4[4];
#pragma unroll
                for (int j = 0; j < 4; ++j) r4[j] = (o[nd][j] * a0 + mg[(2 + nd * 4 + j) * 64 + lane] * a1) * inv;
                u32x2 w; w.x = cvt_pk_bf16(r4[0], r4[1]); w.y = cvt_pk_bf16(r4[2], r4[3]); *(u32x2*)(orow + 16 * nd) = w; } }
        __syncthreads();
    }
}

__device__ __forceinline__ void conv_item(const Params& p, int l, int tile, LAS unsigned char* lds, int tid) {
    const bf16_t* U = (const bf16_t*)(p.ws + WS_R1); bf16_t* MIX = (bf16_t*)(p.ws + WS_R3);
    const int t0 = tile * 64; int s0, s1;
    if (t0 < T_LAT) { s0 = t0 & ~(SEQ - 1); s1 = s0 + SEQ; } else { s0 = T_LAT + ((t0 - T_LAT) & ~(CTXL - 1)); s1 = s0 + CTXL; }
    {
        const int c8 = (tid & 31) * 8, tg = tid >> 5;
        const float* ws_ = p.w_short + (size_t)l * 3 * 256 + c8;
        float w0[8], w1[8], w2[8];
#pragma unroll
        for (int i = 0; i < 8; ++i) { w0[i] = ws_[i]; w1[i] = ws_[256 + i]; w2[i] = ws_[512 + i]; }
        float pr[6][8];
#pragma unroll
        for (int q = 0; q < 6; ++q) { const int t = t0 + tg * 4 + q - 1;
            if (t >= s0 && t < s1) { const u32x4 cgv = *(const u32x4*)(U + (size_t)t * D_IN + OFF_A + 256 + c8), xv = *(const u32x4*)(U + (size_t)t * D_IN + OFF_A + 512 + c8);
#pragma unroll
                for (int i = 0; i < 4; ++i) { pr[q][2 * i] = bflo(cgv[i]) * bflo(xv[i]); pr[q][2 * i + 1] = bfhi(cgv[i]) * bfhi(xv[i]); } }
            else {
#pragma unroll
                for (int i = 0; i < 8; ++i) pr[q][i] = 0.f; } }
#pragma unroll
        for (int q = 0; q < 4; ++q) { const int t = t0 + tg * 4 + q; const u32x4 bgv = *(const u32x4*)(U + (size_t)t * D_IN + OFF_A + c8);
            float r8[8];
#pragma unroll
            for (int i = 0; i < 4; ++i) { r8[2 * i] = bflo(bgv[i]) * (w0[2 * i] * pr[q][2 * i] + w1[2 * i] * pr[q + 1][2 * i] + w2[2 * i] * pr[q + 2][2 * i]);
                r8[2 * i + 1] = bfhi(bgv[i]) * (w0[2 * i + 1] * pr[q][2 * i + 1] + w1[2 * i + 1] * pr[q + 1][2 * i + 1] + w2[2 * i + 1] * pr[q + 2][2 * i + 1]); }
            u32x4 w; w.x = cvt_pk_bf16(r8[0], r8[1]); w.y = cvt_pk_bf16(r8[2], r8[3]); w.z = cvt_pk_bf16(r8[4], r8[5]); w.w = cvt_pk_bf16(r8[6], r8[7]);
            *(u32x4*)(MIX + (size_t)t * DM + c8) = w; }
    }
    LAS float* hs = (LAS float*)lds;
    for (int q = tid; q < 94 * 32; q += NTHR) { const int rr = q >> 5, c8 = (q & 31) * 8, t = t0 - 15 + rr;
        f32x4 lo = {0.f, 0.f, 0.f, 0.f}, hi = {0.f, 0.f, 0.f, 0.f};
        if (t >= s0 && t < s1) { const u32x4 av = *(const u32x4*)(U + (size_t)t * D_IN + OFF_B + c8), gv = *(const u32x4*)(U + (size_t)t * D_IN + OFF_B + 256 + c8);
            lo[0] = bflo(av[0]) * sigmoid_f(bflo(gv[0])); lo[1] = bfhi(av[0]) * sigmoid_f(bfhi(gv[0])); lo[2] = bflo(av[1]) * sigmoid_f(bflo(gv[1])); lo[3] = bfhi(av[1]) * sigmoid_f(bfhi(gv[1]));
            hi[0] = bflo(av[2]) * sigmoid_f(bflo(gv[2])); hi[1] = bfhi(av[2]) * sigmoid_f(bfhi(gv[2])); hi[2] = bflo(av[3]) * sigmoid_f(bflo(gv[3])); hi[3] = bfhi(av[3]) * sigmoid_f(bfhi(gv[3])); }
        *(LAS f32x4*)(hs + rr * 256 + c8) = lo; *(LAS f32x4*)(hs + rr * 256 + c8 + 4) = hi; }
    __syncthreads();
    {
        const int c = tid & 255, half = tid >> 8;
        float w[31];
#pragma unroll
        for (int j = 0; j < 31; ++j) w[j] = p.w_conf_dw[((size_t)l * 31 + j) * 256 + c];
        float acc[32]; const float bd = p.b_conf_dw[l * 256 + c];
#pragma unroll
        for (int o = 0; o < 32; ++o) acc[o] = bd;
#pragma unroll
        for (int i = 0; i < 62; ++i) { const float v = hs[(32 * half + i) * 256 + c];
#pragma unroll
            for (int o = 0; o < 32; ++o) { if (i - o >= 0 && i - o <= 30) acc[o] += w[i - o] * v; } }
        __syncthreads();
#pragma unroll
        for (int o = 0; o < 32; ++o) hs[(32 * half + o) * 256 + c] = acc[o];
    }
    __syncthreads();
    {
        const int lane = tid & 63, wave = tid >> 6;
        const f32x4 gl = *(const f32x4*)(p.g_conf_ln + l * 256 + 4 * lane), bl = *(const f32x4*)(p.b_conf_ln + l * 256 + 4 * lane);
#pragma unroll
        for (int q = 0; q < 8; ++q) { const int tt = wave * 8 + q; f32x4 v = *(const LAS f32x4*)(hs + tt * 256 + 4 * lane);
            const float mean = wave_sum((v.x + v.y) + (v.z + v.w)) * (1.f / 256.f); v = v - mean;
            const float var = wave_sum((v.x * v.x + v.y * v.y) + (v.z * v.z + v.w * v.w)) * (1.f / 256.f);
            const float rstd = 1.f / sqrtf(var + LN_EPS); v = v * rstd * gl + bl;
            u32x2 w; w.x = cvt_pk_bf16(v.x * sigmoid_f(v.x), v.y * sigmoid_f(v.y)); w.y = cvt_pk_bf16(v.z * sigmoid_f(v.z), v.w * sigmoid_f(v.w));
            *(u32x2*)(MIX + (size_t)(t0 + tt) * DM + 256 + 4 * lane) = w; }
    }
    __syncthreads();
}
__device__ __forceinline__ void phaseC(const Params& p, int l, LAS unsigned char* lds, int bid, int G, int tid) {
    const int n_att = NB * 32 * 8, n_catt = (l == 0) ? NB * 8 * 2 : 0, n_conv = (l == 0 ? T_ALL : T_LAT) / 64;
    for (int it = bid; it < n_att; it += G) attn_item(p, l, it, false, lds, tid);
    for (int it = bid; it < n_catt; it += G) attn_item(p, l, it, true, lds, tid);
    for (int it = bid; it < n_conv; it += G) conv_item(p, l, it, lds, tid);
}

__device__ __forceinline__ void phaseE(const Params& p, int l, LAS unsigned char* lds, int bid, int G, int tid) {
    const int lane = tid & 63, gw = bid * NWAVE + (tid >> 6), NGW = G * NWAVE;
    const int nrow = (l == 0) ? T_ALL : T_LAT;
    LAS float* wr = (LAS float*)lds;
    for (int q = tid; q < DM * 16; q += NTHR) { const int k = q >> 4, e = q & 15; const int j = k >> 8, ln = (k >> 2) & 63, i = k & 3;
        wr[((((j * 4 + i) * 4) + (e >> 2)) * 64 + ln) * 4 + (e & 3)] = p.w_router[(size_t)l * DM * 16 + q]; }
    __syncthreads();
    const float* MOD = (const float*)(p.ws + WS_MOD) + (size_t)l * 9 * 6144;
    const float* Y = (const float*)(p.ws + WS_R2); float* XB = (float*)(p.ws + WS_XB); bf16_t* HM = (bf16_t*)(p.ws + WS_R3); float* AFF = (float*)(p.ws + WS_AFF);
    const float* g1 = p.g_post1 + l * DM; const float* b1 = p.b_post1 + l * DM;
    for (int row = gw; row < nrow; row += NGW) {
        const float* xr = (l == 0) ? (row < T_LAT ? p.x + (size_t)row * DM : p.ctx + (size_t)(row - T_LAT) * DM) : XB + (size_t)row * DM;
        const float* md = MOD + (size_t)mod_row_of(row) * 6144;
        f32x4 v[4], y[4], t[4], u[4];
        ld_row(v, xr, lane); ld_row(y, Y + (size_t)row * DM, lane); ld_row(t, md + 2 * DM, lane);
#pragma unroll
        for (int j = 0; j < 4; ++j) v[j] = v[j] * ALPHA + (t[j] + 1.f) * y[j];
        ln16(v); ld_row(t, g1, lane); ld_row(u, b1, lane);
#pragma unroll
        for (int j = 0; j < 4; ++j) v[j] = v[j] * t[j] + u[j];
        st_row(XB + (size_t)row * DM, v, lane);
        ln16(v); ld_row(t, md + 3 * DM, lane); ld_row(u, md + 4 * DM, lane);
#pragma unroll
        for (int j = 0; j < 4; ++j) v[j] = v[j] * (u[j] + 1.f) + t[j];
        st_row_bf16(HM + (size_t)row * DM, v, lane);
        f32x4 a[4];
#pragma unroll
        for (int eq = 0; eq < 4; ++eq) a[eq] = (f32x4){0.f, 0.f, 0.f, 0.f};
#pragma unroll
        for (int j = 0; j < 4; ++j)
#pragma unroll
            for (int i = 0; i < 4; ++i) { const float hv = v[j][i];
#pragma unroll
                for (int eq = 0; eq < 4; ++eq) a[eq] += hv * *(const LAS f32x4*)(wr + (((j * 4 + i) * 4 + eq) * 64 + lane) * 4); }
        float lg[16];
#pragma unroll
        for (int eq = 0; eq < 4; ++eq)
#pragma unroll
            for (int ee = 0; ee < 4; ++ee) lg[4 * eq + ee] = wave_sum(a[eq][ee]);
        float mx = lg[0];
#pragma unroll
        for (int e = 1; e < 16; ++e) mx = fmaxf(mx, lg[e]);
        float sum = 0.f;
#pragma unroll
        for (int e = 0; e < 16; ++e) { lg[e] = __expf(lg[e] - mx); sum += lg[e]; }
        float mine = lg[0];
#pragma unroll
        for (int e = 1; e < 16; ++e) mine = (lane == e) ? lg[e] : mine;
        if (lane < 16) AFF[(size_t)row * 16 + lane] = mine / sum;
    }
    __syncthreads();
}

__device__ __forceinline__ void phaseF(const Params& p, int l, LAS unsigned char* lds, int bid, int G, int tid) {
    const float* AFF = (const float*)(p.ws + WS_AFF); int* SLOT = (int*)(p.ws + WS_SLOT);
    const bf16_t* HM = (const bf16_t*)(p.ws + WS_R3); bf16_t* XG = (bf16_t*)(p.ws + WS_R1);
    LAS unsigned long long* keys = (LAS unsigned long long*)lds;
    LAS int* cnt = (LAS int*)(lds + 16384); LAS int* list = (LAS int*)(lds + 16384 + 16);
    const int n_lat = NB * NE * 4, n_ctx = (l == 0) ? NB * NE : 0;
    const int lane = tid & 63, wave = tid >> 6;
    for (int it = bid; it < n_lat + n_ctx; it += G) {
        int b, e, ntok, cap, tokbase, part, dstbase;
        if (it < n_lat) { b = it >> 6; e = (it >> 2) & 15; part = it & 3; ntok = SEQ; cap = CAP_L; tokbase = b * SEQ; dstbase = e * ROWS_E + b * CAP_L; }
        else { const int i2 = it - n_lat; b = i2 >> 4; e = i2 & 15; part = 0; ntok = CTXL; cap = CAP_C; tokbase = T_LAT + b * CTXL; dstbase = e * ROWS_E + NB * CAP_L + b * CAP_C; }
        for (int t = tid; t < ntok; t += NTHR) keys[t] = ((unsigned long long)__builtin_bit_cast(unsigned, AFF[(size_t)(tokbase + t) * 16 + e]) << 32) | (unsigned)(0xFFFF - t);
        if (tid == 0) *cnt = 0;
        __syncthreads();
        const int myt = part * NTHR + tid;
        if (myt < ntok) {
            const unsigned long long mk = keys[myt]; int rank = 0;
            for (int t = 0; t < ntok; t += 2) { rank += (keys[t] > mk) ? 1 : 0; rank += (keys[t + 1] > mk) ? 1 : 0; }
            const bool sel = rank < cap;
            SLOT[(size_t)(tokbase + myt) * 16 + e] = sel ? rank : -1;
            if (sel) { const int k = atomicAdd((int*)cnt, 1); list[2 * k] = tokbase + myt; list[2 * k + 1] = dstbase + rank; }
        }
        __syncthreads();
        const int n = *cnt;
        for (int k = wave; k < n; k += NWAVE) { const u32x4* src = (const u32x4*)(HM + (size_t)list[2 * k] * DM); u32x4* dst = (u32x4*)(XG + (size_t)list[2 * k + 1] * DM);
            dst[lane] = src[lane]; dst[64 + lane] = src[64 + lane]; }
        __syncthreads();
    }
}

__device__ __forceinline__ void phaseI(const Params& p, int l, int bid, int G, int tid) {
    const int lane = tid & 63, gw = bid * NWAVE + (tid >> 6), NGW = G * NWAVE;
    const bool last = (l == NL - 1); const int nrow = (l == 0) ? T_ALL : T_LAT;
    const float* MOD = (const float*)(p.ws + WS_MOD) + (size_t)l * 9 * 6144;
    const float* AFF = (const float*)(p.ws + WS_AFF); const int* SLOT = (const int*)(p.ws + WS_SLOT);
    const bf16_t* YE = (const bf16_t*)(p.ws + WS_R1); float* XB = (float*)(p.ws + WS_XB); bf16_t* H = (bf16_t*)(p.ws + WS_R3);
    const float* g2 = p.g_post2 + l * DM; const float* b2 = p.b_post2 + l * DM;
    for (int row = gw; row < nrow; row += NGW) {
        const int mr = mod_row_of(row);
        const int sl = SLOT[(size_t)row * 16 + (lane & 15)]; const float af = AFF[(size_t)row * 16 + (lane & 15)];
        const int rbase = row < T_LAT ? (row >> 11) * CAP_L : NB * CAP_L + ((row - T_LAT) >> 8) * CAP_C;
        f32x4 ym[4];
#pragma unroll
        for (int j = 0; j < 4; ++j) ym[j] = (f32x4){0.f, 0.f, 0.f, 0.f};
        for (int e = 0; e < 16; ++e) { const int s = __shfl(sl, e); const float a = __shfl(af, e);
            if (s >= 0) { const bf16_t* yr = YE + ((size_t)e * ROWS_E + rbase + s) * DM + 4 * lane;
#pragma unroll
                for (int j = 0; j < 4; ++j) { const u32x2 w = *(const u32x2*)(yr + 256 * j); ym[j].x += a * bflo(w.x); ym[j].y += a * bfhi(w.x); ym[j].z += a * bflo(w.y); ym[j].w += a * bfhi(w.y); } } }
        const float* md = MOD + (size_t)mr * 6144;
        f32x4 v[4], t[4], u[4];
        ld_row(v, XB + (size_t)row * DM, lane); ld_row(t, md + 5 * DM, lane);
#pragma unroll
        for (int j = 0; j < 4; ++j) v[j] = v[j] * ALPHA + (t[j] + 1.f) * ym[j];
        ln16(v); ld_row(t, g2, lane); ld_row(u, b2, lane);
#pragma unroll
        for (int j = 0; j < 4; ++j) v[j] = v[j] * t[j] + u[j];
        if (last) { st_row(p.out + (size_t)row * DM, v, lane); }
        else { st_row(XB + (size_t)row * DM, v, lane);
            const float* md2 = md + 9 * 6144;
            ln16(v); ld_row(t, md2, lane); ld_row(u, md2 + DM, lane);
#pragma unroll
            for (int j = 0; j < 4; ++j) v[j] = v[j] * (u[j] + 1.f) + t[j];
            st_row_bf16(H + (size_t)row * DM, v, lane); }
    }
}

constexpr int N_PHASES = 2 + 8 * NL;
#ifndef PHM
#define PHM 1023
#endif
__global__ void __launch_bounds__(NTHR, 2) mega(Params p_in) {
    extern __shared__ __attribute__((aligned(16))) unsigned char lds_raw[];
    LAS unsigned char* lds = (LAS unsigned char*)lds_raw;
    cg::grid_group grid = cg::this_grid();
    const int bid = blockIdx.x, G = gridDim.x;
    const Params& p0 = p_in;
    for (int ph = p0.ph_lo; ph < p0.ph_hi; ++ph) {
        int tid = threadIdx.x; asm volatile("" : "+v"(tid));
        Params p = p0; asm volatile("" : "+s"(p.ws));
        if (ph == 0) { if (PHM & 1) phase0(p, lds, bid, G, tid); }
        else if (ph == 1) { if (PHM & 2) phaseA(p, bid, G, tid); }
        else {
            const int l = (ph - 2) >> 3, s = (ph - 2) & 7;
            if (s == 0) { if (PHM & 4) {
                pg8::Gemm g{(const bf16_t*)(p.ws + WS_R3), (const bf16_t*)(p.ws + WS_WIN) + (size_t)l * D_IN * DM, DM};
                pg8::Sched S{1, l == 0 ? 72 : 64, 11, 0, 0, 64, 7, 4, l == 0 ? 0 : 32, G, bid};
                pg8::EpiBf16 E{(bf16_t*)(p.ws + WS_R1), D_IN, p.b_in + l * D_IN, 5, 7};
                pg8::gemm_phase<pg8::EpiBf16, pg8::Sched, true, true>(lds, g, S, E, tid); }
            } else if (s == 1) { if (PHM & 8) phaseC(p, l, lds, bid, G, tid); }
            else if (s == 2) { if (PHM & 16) {
                pg8::Gemm g{(const bf16_t*)(p.ws + WS_R3), (const bf16_t*)(p.ws + WS_WOUT) + (size_t)l * DM * DM, DM};
                pg8::Sched S{1, l == 0 ? 72 : 64, 4, 0, 0, 0, 0, 1, 0, G, bid};
                pg8::EpiF32 E{(float*)(p.ws + WS_R2), DM, p.b_out + l * DM};
                pg8::gemm_phase<pg8::EpiF32, pg8::Sched, true, true>(lds, g, S, E, tid); }
            } else if (s == 3) { if (PHM & 32) phaseE(p, l, lds, bid, G, tid); }
            else if (s == 4) { if (PHM & 64) phaseF(p, l, lds, bid, G, tid); }
            else if (s == 5) { if (PHM & 128) {
                pg8::Gemm g{(const bf16_t*)(p.ws + WS_R1), (const bf16_t*)(p.ws + WS_WGU) + (size_t)l * NE * 2048 * DM, DM};
                pg8::Sched S{NE, l == 0 ? 9 : 8, 8, 9, 8, 0, 0, 1, 0, G, bid};
                pg8::EpiSwiglu E{(bf16_t*)(p.ws + WS_R2), DM};
                pg8::gemm_phase<pg8::EpiSwiglu, pg8::Sched, true, true>(lds, g, S, E, tid); }
            } else if (s == 6) { if (PHM & 256) {
                pg8::Gemm g{(const bf16_t*)(p.ws + WS_R2), (const bf16_t*)(p.ws + WS_WD) + (size_t)l * NE * DM * DM, DM};
                pg8::Sched S{NE, l == 0 ? 9 : 8, 4, 9, 4, 0, 0, 1, 0, G, bid};
                pg8::EpiBf16 E{(bf16_t*)(p.ws + WS_R1), DM, nullptr, 0, 0};
                pg8::gemm_phase<pg8::EpiBf16, pg8::Sched, true, true>(lds, g, S, E, tid); }
            } else { if (PHM & 512) phaseI(p, l, bid, G, tid); }
        }
        if (ph + 1 < p0.ph_hi) grid.sync();
    }
}

extern "C" void kernel_launch(void* const* d_in, const int* in_sizes, int n_in, void* d_out, int out_size, void* d_ws, size_t ws_size, hipStream_t stream) {
    static int grid = 0;
    if (grid == 0) {
        if (n_in != 24 || ws_size < WS_END) { fprintf(stderr, "kernel_launch: need 24 inputs and %zu bytes of workspace (got %d, %zu)\n", (size_t)WS_END, n_in, ws_size); grid = -1; return; }
        int dev = 0, cus = 0, per_cu = 0;
        hipGetDevice(&dev); hipDeviceGetAttribute(&cus, hipDeviceAttributeMultiprocessorCount, dev);
        if (hipFuncSetAttribute((const void*)mega, hipFuncAttributeMaxDynamicSharedMemorySize, LDS_BYTES) != hipSuccess) { fprintf(stderr, "kernel_launch: hipFuncSetAttribute failed\n"); grid = -1; return; }
        if (hipOccupancyMaxActiveBlocksPerMultiprocessor(&per_cu, (const void*)mega, NTHR, LDS_BYTES) != hipSuccess || per_cu < 1) { fprintf(stderr, "kernel_launch: occupancy query says %d blocks per CU\n", per_cu); per_cu = 1; }
        (void)hipGetLastError();
        grid = cus * 1;
    }
    if (grid < 0) return;
    Params p{};
    const float** f = (const float**)&p;
    for (int i = 0; i < 24; ++i) f[i] = (const float*)d_in[i];
    p.out = (float*)d_out; p.ws = (unsigned char*)d_ws;
#if MULTI
    for (int ph = 0; ph < N_PHASES; ++ph) { p.ph_lo = ph; p.ph_hi = ph + 1; hipLaunchKernelGGL(mega, dim3(grid), dim3(NTHR), LDS_BYTES, stream, p); }
#else
    p.ph_lo = 0; p.ph_hi = N_PHASES;
    void* args[] = {&p};
    hipError_t e = hipLaunchCooperativeKernel((const void*)mega, dim3(grid), dim3(NTHR), args, LDS_BYTES, stream);
    if (e != hipSuccess) fprintf(stderr, "cooperative launch failed: %s (grid %d)\n", hipGetErrorString(e), grid);
#endif
}
```

```cpp
#include <hip/hip_runtime.h>
#include <hip/hip_cooperative_groups.h>
#include <cstdio>
#include <cstdint>
namespace cg = cooperative_groups;

#ifndef MULTI
#define MULTI 0
#endif

#define LAS __attribute__((address_space(3)))
#define PG8_LAS __attribute__((address_space(3)))
typedef unsigned short bf16_t;
typedef short bf16x8 __attribute__((ext_vector_type(8)));
typedef short s16x4 __attribute__((ext_vector_type(4)));
typedef float f32x4 __attribute__((ext_vector_type(4)));
typedef unsigned u32x4 __attribute__((ext_vector_type(4)));
typedef unsigned u32x2 __attribute__((ext_vector_type(2)));

constexpr int DM = 1024, NB = 8, SEQ = 2048, CTXL = 256, NL = 2;
constexpr int T_LAT = NB * SEQ, T_CTX = NB * CTXL, T_ALL = T_LAT + T_CTX;
constexpr int D_IN = 2816, OFF_A = 0, OFF_B = 768, OFF_Q = 1280, OFF_K = 1792, OFF_V = 2304;
constexpr int NE = 16, CAP_L = 256, CAP_C = 32, ROWS_E = NB * CAP_L + NB * CAP_C;
constexpr float LN_EPS = 1e-5f;
constexpr float ALPHA = 1.4142135623730951f;
constexpr float LOG2E = 1.4426950408889634f;
constexpr int NTHR = 512, NWAVE = 8;
constexpr int LDS_BYTES = 147456;

constexpr size_t SZ_WIN = (size_t)NL * D_IN * DM * 2, SZ_WOUT = (size_t)NL * DM * DM * 2, SZ_WGU = (size_t)NL * NE * 2048 * DM * 2, SZ_WD = (size_t)NL * NE * DM * DM * 2;
constexpr size_t SZ_MOD = (size_t)NL * 9 * 6144 * 4, SZ_AFF = (size_t)T_ALL * 16 * 4;
constexpr size_t SZ_R3 = (size_t)T_ALL * DM * 2, SZ_R1 = (size_t)T_ALL * D_IN * 2, SZ_R2 = (size_t)T_ALL * DM * 4, SZ_XB = (size_t)T_ALL * DM * 4;
constexpr size_t WS_WIN = 0, WS_WOUT = WS_WIN + SZ_WIN, WS_WGU = WS_WOUT + SZ_WOUT, WS_WD = WS_WGU + SZ_WGU, WS_MOD = WS_WD + SZ_WD;
constexpr size_t WS_AFF = WS_MOD + SZ_MOD, WS_SLOT = WS_AFF + SZ_AFF, WS_R3 = WS_SLOT + SZ_AFF, WS_R1 = WS_R3 + SZ_R3, WS_R2 = WS_R1 + SZ_R1, WS_XB = WS_R2 + SZ_R2, WS_BAR = WS_XB + SZ_XB, WS_TOK = WS_BAR + 16384, WS_END = WS_TOK + (size_t)NE * ROWS_E * 4;
static_assert(WS_END <= (size_t)536870912, "workspace map exceeds 512 MiB");
static_assert((size_t)NE * ROWS_E * DM * 2 <= SZ_R1 && (size_t)NE * ROWS_E * DM * 2 <= SZ_R2, "MoE buffers fit their overlays");

struct Params {
    const float *x, *c, *ctx, *c_ctx, *w_mod, *b_mod, *w_in, *b_in, *w_short, *w_conf_dw, *b_conf_dw, *g_conf_ln, *b_conf_ln, *na_rpb, *w_out, *b_out,
                *g_post1, *b_post1, *w_router, *w_gate, *w_up, *w_down, *g_post2, *b_post2;
    float* out; unsigned char* ws; int ph_lo, ph_hi;
};

__device__ __forceinline__ unsigned cvt_pk_bf16(float lo, float hi) { unsigned r; asm volatile("v_cvt_pk_bf16_f32 %0, %1, %2" : "=v"(r) : "v"(lo), "v"(hi)); return r; }
__device__ __forceinline__ float bflo(unsigned u) { return __builtin_bit_cast(float, u << 16); }
__device__ __forceinline__ float bfhi(unsigned u) { return __builtin_bit_cast(float, u & 0xffff0000u); }
__device__ __forceinline__ float shx(float v, int o, int lane) { return __builtin_bit_cast(float, __builtin_amdgcn_ds_bpermute((lane ^ o) << 2, __builtin_bit_cast(int, v))); }
__device__ __forceinline__ float wave_sum(float v, int lane) {
#pragma unroll
    for (int o = 1; o < 64; o <<= 1) v += shx(v, o, lane);
    return v;
}
__device__ __forceinline__ float sigmoid_f(float x) { return __builtin_amdgcn_rcpf(1.f + __builtin_amdgcn_exp2f(-LOG2E * x)); }
__device__ __forceinline__ void ln16(f32x4 (&v)[4], int lane) {
    float s = 0.f;
#pragma unroll
    for (int j = 0; j < 4; ++j) s += (v[j].x + v[j].y) + (v[j].z + v[j].w);
    const float mean = wave_sum(s, lane) * (1.f / DM); float s2 = 0.f;
#pragma unroll
    for (int j = 0; j < 4; ++j) { v[j] = v[j] - mean; s2 += (v[j].x * v[j].x + v[j].y * v[j].y) + (v[j].z * v[j].z + v[j].w * v[j].w); }
    const float rstd = 1.f / sqrtf(wave_sum(s2, lane) * (1.f / DM) + LN_EPS);
#pragma unroll
    for (int j = 0; j < 4; ++j) v[j] = v[j] * rstd;
}
__device__ __forceinline__ void ld_row(f32x4 (&v)[4], const float* row, int lane) {
#pragma unroll
    for (int j = 0; j < 4; ++j) v[j] = *(const f32x4*)(row + 256 * j + 4 * lane);
}
__device__ __forceinline__ void ld_row_bf16(f32x4 (&v)[4], const bf16_t* row, int lane) {
#pragma unroll
    for (int j = 0; j < 4; ++j) { const u32x2 w = *(const u32x2*)(row + 256 * j + 4 * lane); v[j] = (f32x4){bflo(w.x), bfhi(w.x), bflo(w.y), bfhi(w.y)}; }
}
__device__ __forceinline__ void ld_row_nt(f32x4 (&v)[4], const float* row, int lane) {
#pragma unroll
    for (int j = 0; j < 4; ++j) v[j] = __builtin_nontemporal_load((const f32x4*)(row + 256 * j + 4 * lane));
}
__device__ __forceinline__ void ld_row_bf16_nt(f32x4 (&v)[4], const bf16_t* row, int lane) {
#pragma unroll
    for (int j = 0; j < 4; ++j) { const u32x2 w = __builtin_nontemporal_load((const u32x2*)(row + 256 * j + 4 * lane)); v[j] = (f32x4){bflo(w.x), bfhi(w.x), bflo(w.y), bfhi(w.y)}; }
}
__device__ __forceinline__ void st_row_nt(float* row, const f32x4 (&v)[4], int lane) {
#pragma unroll
    for (int j = 0; j < 4; ++j) __builtin_nontemporal_store(v[j], (f32x4*)(row + 256 * j + 4 * lane));
}
__device__ __forceinline__ void st_row_bf16_nt(bf16_t* row, const f32x4 (&v)[4], int lane) {
#pragma unroll
    for (int j = 0; j < 4; ++j) { u32x2 w; w.x = cvt_pk_bf16(v[j].x, v[j].y); w.y = cvt_pk_bf16(v[j].z, v[j].w); __builtin_nontemporal_store(w, (u32x2*)(row + 256 * j + 4 * lane)); }
}
__device__ __forceinline__ void st_row(float* row, const f32x4 (&v)[4], int lane) {
#pragma unroll
    for (int j = 0; j < 4; ++j) *(f32x4*)(row + 256 * j + 4 * lane) = v[j];
}
__device__ __forceinline__ void st_row_bf16(bf16_t* row, const f32x4 (&v)[4], int lane) {
#pragma unroll
    for (int j = 0; j < 4; ++j) { u32x2 w; w.x = cvt_pk_bf16(v[j].x, v[j].y); w.y = cvt_pk_bf16(v[j].z, v[j].w); *(u32x2*)(row + 256 * j + 4 * lane) = w; }
}
__device__ __forceinline__ int mod_row_of(int row) { return row < T_LAT ? (row >> 11) : 8; }

namespace pg8 {
constexpr int BM = 256, BK = 64, HALF = 128, HTB = HALF * BK * 2, NXCD = 8, WGM = 8;
__host__ __device__ __forceinline__ int lds_byte(int r, int c) { const int st = (r >> 4) * 2 + (c >> 5), rr = r & 15, cc = c & 31, ob = rr * 64 + cc * 2; return st * 1024 + (ob ^ (((ob >> 9) & 1) << 5)); }
__host__ __device__ __forceinline__ void stage_rc(int b, int& R, int& C) { const int st = b / 1024, sb = b % 1024, swz = sb ^ (((sb >> 9) & 1) << 5); R = (st >> 1) * 16 + swz / 64; C = (st & 1) * 32 + (swz % 64) / 2; }
__host__ __device__ __forceinline__ int perm32(int rho) { const int n = rho >> 4, i = rho & 15; return 8 * (i >> 2) + 4 * n + (i & 3); }

struct Unit { int pm, pn, ex; };
struct Gemm { const bf16_t* A; const bf16_t* Bt; int K; };

struct Sched {
    int ngrp, nM, nN, aM, aN, tailM0, tailN0, tailNn, ntail, G, c;
    __device__ __forceinline__ bool next(int i, Unit& u) const {
        const int nmain = ngrp * nM * nN; const long L = (long)i * G + c; if (L >= nmain + ntail) return false;
        if (L >= nmain) { const int t = (int)L - nmain; u.pm = tailM0 + t / tailNn; u.pn = tailN0 + t % tailNn; u.ex = u.pn; return true; }
        int wg = (int)L; { const int q = nmain / NXCD, r = nmain % NXCD, xcd = wg % NXCD, off = wg / NXCD; wg = (xcd < r ? xcd * (q + 1) : r * (q + 1) + (xcd - r) * q) + off; }
        const int per = nM * nN, grp = wg / per, w2 = wg % per;
        const int nig = WGM * nN, gid = w2 / nig, fm = gid * WGM, gsz = (nM - fm) < WGM ? (nM - fm) : WGM;
        const int pml = fm + ((w2 % nig) % gsz), pnl = (w2 % nig) / gsz;
        u.pm = grp * aM + pml; u.pn = grp * aN + pnl; u.ex = pnl; return true;
    }
    __device__ __forceinline__ void a_ready(const Unit&) const {}
    __device__ __forceinline__ void done(const Unit&) const {}
};

struct EpiBf16 {
    static constexpr bool PERM = true, AFTER_DRAIN = false;
    bf16_t* O; int ldc; const float* bias; int q_lo, q_hi;
    __device__ __forceinline__ void operator()(const f32x4 (&acc)[2][2][4][2], const Unit& u, int wr, int wc, int fr, int fq) const {
        const int row0 = u.pm * BM + wr * 64 + fr; const int col0 = u.ex * BM + wc * 32 + 8 * fq;
        const float sc = (u.ex >= q_lo && u.ex < q_hi) ? 0.125f : 1.f;
        f32x4 bv[2][2];
#pragma unroll
        for (int bj = 0; bj < 2; ++bj)
#pragma unroll
            for (int n = 0; n < 2; ++n) bv[bj][n] = bias ? *(const f32x4*)(bias + col0 + bj * HALF + 4 * n) : (f32x4){0.f, 0.f, 0.f, 0.f};
#pragma unroll
        for (int ai = 0; ai < 2; ++ai)
#pragma unroll
            for (int m = 0; m < 4; ++m) { bf16_t* rowp = O + (size_t)(row0 + ai * HALF + m * 16) * ldc + col0;
#pragma unroll
                for (int bj = 0; bj < 2; ++bj) { f32x4 v0 = (acc[ai][bj][m][0] + bv[bj][0]) * sc, v1 = (acc[ai][bj][m][1] + bv[bj][1]) * sc;
                    u32x4 w; w.x = cvt_pk_bf16(v0[0], v0[1]); w.y = cvt_pk_bf16(v0[2], v0[3]); w.z = cvt_pk_bf16(v1[0], v1[1]); w.w = cvt_pk_bf16(v1[2], v1[3]);
                    *(u32x4*)(rowp + bj * HALF) = w; } }
    }
};
struct EpiF32 {
    static constexpr bool PERM = true, AFTER_DRAIN = false;
    float* O; int ldc; const float* bias;
    __device__ __forceinline__ void operator()(const f32x4 (&acc)[2][2][4][2], const Unit& u, int wr, int wc, int fr, int fq) const {
        const int row0 = u.pm * BM + wr * 64 + fr; const int col0 = u.ex * BM + wc * 32 + 8 * fq;
        f32x4 bv[2][2];
#pragma unroll
        for (int bj = 0; bj < 2; ++bj)
#pragma unroll
            for (int n = 0; n < 2; ++n) bv[bj][n] = *(const f32x4*)(bias + col0 + bj * HALF + 4 * n);
#pragma unroll
        for (int ai = 0; ai < 2; ++ai)
#pragma unroll
            for (int m = 0; m < 4; ++m) { float* rowp = O + (size_t)(row0 + ai * HALF + m * 16) * ldc + col0;
#pragma unroll
                for (int bj = 0; bj < 2; ++bj) { *(f32x4*)(rowp + bj * HALF) = acc[ai][bj][m][0] + bv[bj][0]; *(f32x4*)(rowp + bj * HALF + 4) = acc[ai][bj][m][1] + bv[bj][1]; } }
    }
};
struct EpiSwiglu {
    static constexpr bool PERM = true, AFTER_DRAIN = false;
    bf16_t* O; int ldc;
    __device__ __forceinline__ void operator()(const f32x4 (&acc)[2][2][4][2], const Unit& u, int wr, int wc, int fr, int fq) const {
        const int row0 = u.pm * BM + wr * 64 + fr; const int col0 = u.ex * HALF + wc * 32 + 8 * fq;
#pragma unroll
        for (int ai = 0; ai < 2; ++ai)
#pragma unroll
            for (int m = 0; m < 4; ++m) { bf16_t* rowp = O + (size_t)(row0 + ai * HALF + m * 16) * ldc + col0;
                float r[8];
#pragma unroll
                for (int n = 0; n < 2; ++n)
#pragma unroll
                    for (int j = 0; j < 4; ++j) { const float a = acc[ai][0][m][n][j], b = acc[ai][1][m][n][j]; r[4 * n + j] = a * __builtin_amdgcn_rcpf(1.f + __builtin_amdgcn_exp2f(-1.4426950408889634f * a)) * b; }
                u32x4 w; w.x = cvt_pk_bf16(r[0], r[1]); w.y = cvt_pk_bf16(r[2], r[3]); w.z = cvt_pk_bf16(r[4], r[5]); w.w = cvt_pk_bf16(r[6], r[7]);
                *(u32x4*)rowp = w; }
    }
};

template <class Epi, class Sched, bool ALIGN_EPI = false, bool SP2 = false, bool GATHER = false>
__device__ __forceinline__ void gemm_phase(PG8_LAS unsigned char* lds, const Gemm g, const Sched& S, const Epi& E, const int tid, const int* __restrict__ rowlist = nullptr) {
    const int wid = __builtin_amdgcn_readfirstlane(tid >> 6), lane = tid & 63, wr = wid >> 2, wc = wid & 3, fr = lane & 15, fq = lane >> 4;
    const int K = g.K, nt = K / BK;
    unsigned voffA[2], voffB[2];
#pragma unroll
    for (int i = 0; i < 2; ++i) { int R, C; stage_rc(tid * 16 + i * 8192, R, C); const int Rb = Epi::PERM ? ((R & ~31) + perm32(R & 31)) : R;
        voffA[i] = (unsigned)(R * K + C) * 2u; voffB[i] = (unsigned)(Rb * K + C) * 2u; }
    const size_t kstep = (size_t)(BK * 2);
    const size_t hstep = (size_t)HALF * K * 2;
    const size_t tstep = 2 * hstep;
    const unsigned ldsw = (unsigned)wid * 1024u;
    const int aoff = lds_byte(wr * 64 + fr, fq * 8), boff = lds_byte(wc * 32 + fr, fq * 8);
#define PG8_SA(b, h) (((b) * 2 + (h)) * HTB)
#define PG8_SB(b, h) ((4 + (b) * 2 + (h)) * HTB)
#define PG8_STAGE(bufoff, gbase, voff) do { _Pragma("unroll") for (int _i = 0; _i < 2; ++_i) \
        __builtin_amdgcn_global_load_lds((const unsigned*)((const char*)(gbase) + (voff)[_i]), (PG8_LAS unsigned*)(lds + (bufoff) + ldsw + _i * 8192), 16, 0, 0); } while (0)
#define PG8_STAGE_G(bufoff, gbase, h, nx) do { _Pragma("unroll") for (int _i = 0; _i < 2; ++_i) \
        __builtin_amdgcn_global_load_lds((const unsigned*)((const char*)(gbase) + ((nx) ? vgn[h][_i] : vg[h][_i])), (PG8_LAS unsigned*)(lds + (bufoff) + ldsw + _i * 8192), 16, 0, 0); } while (0)
#define PG8_STA(bufoff, base, h, vsel) do { if constexpr (GATHER) { PG8_STAGE_G(bufoff, base, h, vsel); } else { PG8_STAGE(bufoff, (base) + (h) * hstep, voffA); } } while (0)
#define PG8_LOADVG(v, pm_) do { _Pragma("unroll") for (int _i = 0; _i < 2; ++_i) { int _R, _C; stage_rc(tid * 16 + _i * 8192, _R, _C); _Pragma("unroll") for (int _h = 0; _h < 2; ++_h) \
        (v)[_h][_i] = (unsigned)rowlist[(pm_) * BM + _h * HALF + _R] * (unsigned)(K * 2) + (unsigned)_C * 2u; } } while (0)
#define PG8_LDA(dst, b, h) do { _Pragma("unroll") for (int m = 0; m < 4; ++m) _Pragma("unroll") for (int k = 0; k < 2; ++k) dst[m][k] = *(const PG8_LAS bf16x8*)(lds + PG8_SA(b, h) + aoff + m * 2048 + k * 1024); } while (0)
#define PG8_LDB(dst, b, h) do { _Pragma("unroll") for (int n = 0; n < 2; ++n) _Pragma("unroll") for (int k = 0; k < 2; ++k) dst[n][k] = *(const PG8_LAS bf16x8*)(lds + PG8_SB(b, h) + boff + n * 2048 + k * 1024); } while (0)
#define PG8_MMA(ai, bj, At, Bt) do { __builtin_amdgcn_s_setprio(1); _Pragma("unroll") for (int m = 0; m < 4; ++m) _Pragma("unroll") for (int n = 0; n < 2; ++n) _Pragma("unroll") for (int k = 0; k < 2; ++k) \
        acc[ai][bj][m][n] = __builtin_amdgcn_mfma_f32_16x16x32_bf16(Bt[n][k], At[m][k], acc[ai][bj][m][n], 0, 0, 0); __builtin_amdgcn_s_setprio(0); } while (0)
#define PG8_WAIT_V(n) asm volatile("s_waitcnt vmcnt(" #n ")" ::: "memory")
#define PG8_WAIT_L(n) asm volatile("s_waitcnt lgkmcnt(" #n ")" ::: "memory")
#define PG8_BAR __builtin_amdgcn_s_barrier()
#define PG8_SCHED __builtin_amdgcn_sched_barrier(0)
    Unit cur, nxt; int ui = 0;
    if (!S.next(0, cur)) return;
    f32x4 acc[2][2][4][2];
#pragma unroll
    for (int a = 0; a < 2; ++a)
#pragma unroll
        for (int b = 0; b < 2; ++b)
#pragma unroll
            for (int m = 0; m < 4; ++m)
#pragma unroll
                for (int n = 0; n < 2; ++n) acc[a][b][m][n] = (f32x4){0.f, 0.f, 0.f, 0.f};
    bf16x8 At[4][2], B0[2][2], B1[2][2];
    const char* cA = (const char*)g.A + (GATHER ? (size_t)0 : (size_t)cur.pm * tstep);
    unsigned vg[2][2] = {{0u, 0u}, {0u, 0u}}, vgn[2][2] = {{0u, 0u}, {0u, 0u}}; if constexpr (GATHER) PG8_LOADVG(vg, cur.pm); const char* cB = (const char*)g.Bt + (size_t)cur.pn * tstep;
    S.a_ready(cur);
    if constexpr (SP2) {
        PG8_STAGE(PG8_SB(0, 0), cB, voffB); PG8_STAGE(PG8_SB(0, 1), cB + hstep, voffB); PG8_STA(PG8_SA(0, 0), cA, 0, false); PG8_STA(PG8_SA(0, 1), cA, 1, false);
        if (wr == 1) PG8_BAR;
        PG8_WAIT_V(2); PG8_BAR;
        PG8_STAGE(PG8_SB(1, 0), cB + kstep, voffB); PG8_STA(PG8_SA(1, 0), cA + kstep, 0, false); PG8_STAGE(PG8_SB(1, 1), cB + hstep + kstep, voffB);
        PG8_WAIT_V(6); PG8_BAR;
    } else {
        PG8_STAGE(PG8_SB(0, 0), cB, voffB); PG8_STA(PG8_SA(0, 0), cA, 0, false); PG8_STAGE(PG8_SB(0, 1), cB + hstep, voffB); PG8_STA(PG8_SA(0, 1), cA, 1, false);
        if (wr == 1) PG8_BAR;
        PG8_WAIT_V(4); PG8_BAR;
        PG8_STAGE(PG8_SB(1, 0), cB + kstep, voffB); PG8_STA(PG8_SA(1, 0), cA + kstep, 0, false); PG8_STAGE(PG8_SB(1, 1), cB + hstep + kstep, voffB);
        PG8_WAIT_V(6); PG8_BAR;
    }
    for (;;) {
        const bool has_next = S.next(ui + 1, nxt);
        const char* nA = (has_next && !GATHER) ? (const char*)g.A + (size_t)nxt.pm * tstep : cA;
        if constexpr (GATHER) { if (has_next) PG8_LOADVG(vgn, nxt.pm); else { _Pragma("unroll") for (int _h = 0; _h < 2; ++_h) _Pragma("unroll") for (int _i = 0; _i < 2; ++_i) vgn[_h][_i] = vg[_h][_i]; } } const char* nB = has_next ? (const char*)g.Bt + (size_t)nxt.pn * tstep : cB;
        for (int t = 0; t < nt; t += 2) {
            const bool last = (t == nt - 2);
            const char* a1 = cA + (size_t)(t + 1) * kstep;
            const char* a2 = last ? nA : cA + (size_t)(t + 2) * kstep; const char* b2 = last ? nB : cB + (size_t)(t + 2) * kstep;
            const char* a3 = a2 + kstep; const char* b3 = b2 + kstep;
            if (last && has_next) S.a_ready(nxt);
            if constexpr (SP2) {
            PG8_LDB(B0, 0, 0); PG8_LDB(B1, 0, 1); PG8_SCHED; PG8_LDA(At, 0, 0); PG8_STA(PG8_SA(1, 1), a1, 1, false);
            PG8_WAIT_V(8); PG8_WAIT_L(0); PG8_BAR; PG8_MMA(0, 0, At, B0); PG8_MMA(0, 1, At, B1); PG8_BAR; PG8_SCHED;
            PG8_LDA(At, 0, 1); PG8_STAGE(PG8_SB(0, 0), b2, voffB); PG8_STAGE(PG8_SB(0, 1), b2 + hstep, voffB); PG8_STA(PG8_SA(0, 0), a2, 0, last);
            PG8_WAIT_V(8); PG8_WAIT_L(0); PG8_BAR; PG8_MMA(1, 0, At, B0); PG8_MMA(1, 1, At, B1); PG8_BAR; PG8_SCHED;
            PG8_LDB(B0, 1, 0); PG8_LDB(B1, 1, 1); PG8_SCHED; PG8_LDA(At, 1, 0); PG8_STA(PG8_SA(0, 1), a2, 1, last);
            PG8_WAIT_V(8); PG8_WAIT_L(0); PG8_BAR; PG8_MMA(0, 0, At, B0); PG8_MMA(0, 1, At, B1); PG8_BAR; PG8_SCHED;
            PG8_LDA(At, 1, 1); PG8_STAGE(PG8_SB(1, 0), b3, voffB); PG8_STAGE(PG8_SB(1, 1), b3 + hstep, voffB); PG8_STA(PG8_SA(1, 0), a3, 0, last);
            PG8_WAIT_V(8); PG8_WAIT_L(0); PG8_BAR; PG8_MMA(1, 0, At, B0); PG8_MMA(1, 1, At, B1); PG8_BAR; PG8_SCHED;
            } else {
            PG8_LDB(B0, 0, 0); PG8_SCHED; PG8_LDA(At, 0, 0); PG8_STA(PG8_SA(1, 1), a1, 1, false);
            PG8_WAIT_L(8); PG8_BAR; PG8_WAIT_L(0); PG8_MMA(0, 0, At, B0); PG8_BAR; PG8_SCHED;
            PG8_LDB(B1, 0, 1); PG8_STAGE(PG8_SB(0, 0), b2, voffB);
            PG8_BAR; PG8_WAIT_L(0); PG8_MMA(0, 1, At, B1); PG8_BAR;
            PG8_LDA(At, 0, 1); PG8_STA(PG8_SA(0, 0), a2, 0, last);
            PG8_BAR; PG8_WAIT_L(0); PG8_MMA(1, 0, At, B0); PG8_BAR; PG8_SCHED;
            PG8_STAGE(PG8_SB(0, 1), b2 + hstep, voffB);
            PG8_WAIT_V(6); PG8_BAR; PG8_MMA(1, 1, At, B1); PG8_BAR;
            PG8_LDB(B0, 1, 0); PG8_SCHED; PG8_LDA(At, 1, 0); PG8_STA(PG8_SA(0, 1), a2, 1, last);
            PG8_WAIT_L(8); PG8_BAR; PG8_WAIT_L(0); PG8_MMA(0, 0, At, B0); PG8_BAR; PG8_SCHED;
            PG8_LDB(B1, 1, 1); PG8_STAGE(PG8_SB(1, 0), b3, voffB);
            PG8_BAR; PG8_WAIT_L(0); PG8_MMA(0, 1, At, B1); PG8_BAR;
            PG8_LDA(At, 1, 1); PG8_STA(PG8_SA(1, 0), a3, 0, last);
            PG8_BAR; PG8_WAIT_L(0); PG8_MMA(1, 0, At, B0); PG8_BAR; PG8_SCHED;
            PG8_STAGE(PG8_SB(1, 1), b3 + hstep, voffB);
            PG8_WAIT_V(6); PG8_BAR; PG8_MMA(1, 1, At, B1); PG8_BAR;
            }
        }
        if constexpr (ALIGN_EPI) { if (wr == 0) PG8_BAR; }
        if constexpr (!Epi::AFTER_DRAIN) { E(acc, cur, wr, wc, fr, fq); S.done(cur); }
        if (!has_next) break;
#pragma unroll
        for (int a = 0; a < 2; ++a)
#pragma unroll
            for (int b = 0; b < 2; ++b)
#pragma unroll
                for (int m = 0; m < 4; ++m)
#pragma unroll
                    for (int n = 0; n < 2; ++n) acc[a][b][m][n] = (f32x4){0.f, 0.f, 0.f, 0.f};
        cur = nxt; cA = nA; cB = nB; ++ui;
        _Pragma("unroll") for (int _h = 0; _h < 2; ++_h) _Pragma("unroll") for (int _i = 0; _i < 2; ++_i) vg[_h][_i] = vgn[_h][_i];
        if constexpr (ALIGN_EPI) { if (wr == 1) PG8_BAR; }
    }
    PG8_WAIT_V(0);
    if constexpr (!ALIGN_EPI) { if (wr == 0) PG8_BAR; }
    PG8_BAR;
    if constexpr (Epi::AFTER_DRAIN) { E.fused(acc, cur, wr, wc, fr, fq, lds, wid, lane); S.done(cur); }
#undef PG8_SA
#undef PG8_SB
#undef PG8_STAGE
#undef PG8_STA
#undef PG8_STAGE_G
#undef PG8_LOADVG
#undef PG8_LDA
#undef PG8_LDB
#undef PG8_MMA
#undef PG8_WAIT_V
#undef PG8_WAIT_L
#undef PG8_BAR
#undef PG8_SCHED
}
}

__device__ __forceinline__ void mod_item(const Params& p, int item, LAS float* sc, LAS float* red, int tid) {
    const int l = item / 192, n0 = (item % 192) * 32, col = tid & 31, kg = tid >> 5;
    const float* W = p.w_mod + (size_t)l * DM * 6144 + n0 + col;
    float acc[9];
#pragma unroll
    for (int r = 0; r < 9; ++r) acc[r] = 0.f;
    float w[64];
#pragma unroll
    for (int kk = 0; kk < 64; ++kk) w[kk] = __builtin_nontemporal_load(W + (size_t)(kg * 64 + kk) * 6144);
#pragma unroll
    for (int kk = 0; kk < 64; ++kk) { const int k = kg * 64 + kk;
#pragma unroll
        for (int r = 0; r < 9; ++r) acc[r] += sc[r * DM + k] * w[kk]; }
#pragma unroll
    for (int r = 0; r < 9; ++r) red[(kg * 9 + r) * 32 + col] = acc[r];
    __syncthreads();
    if (tid < 288) { const int r = tid >> 5; float s = p.b_mod[l * 6144 + n0 + col];
#pragma unroll
        for (int g = 0; g < 16; ++g) s += red[(g * 9 + r) * 32 + col];
        ((float*)(p.ws + WS_MOD))[((size_t)l * 9 + r) * 6144 + n0 + col] = s; }
    __syncthreads();
}
__device__ __forceinline__ void transpose_tile(const float* W, int N, int k0, int n0, bf16_t* dst0  , LAS float* scr, int lane) {
    const float* src = W + (size_t)k0 * N + n0 + 4 * (lane & 15);
    f32x4 v[16];
#pragma unroll
    for (int i = 0; i < 16; ++i) v[i] = __builtin_nontemporal_load((const f32x4*)(src + (size_t)(4 * i + (lane >> 4)) * N));
#pragma unroll
    for (int i = 0; i < 16; ++i) { LAS float* d = scr + (4 * i + (lane >> 4)) * 65 + 4 * (lane & 15); d[0] = v[i].x; d[1] = v[i].y; d[2] = v[i].z; d[3] = v[i].w; }
    asm volatile("s_waitcnt lgkmcnt(0)" ::: "memory");
    const int c = lane & 7;
#pragma unroll
    for (int j = 0; j < 8; ++j) { const int n = (lane >> 3) + 8 * j; const LAS float* s = scr + (8 * c) * 65 + n;
        u32x4 o; o.x = cvt_pk_bf16(s[0], s[65]); o.y = cvt_pk_bf16(s[130], s[195]); o.z = cvt_pk_bf16(s[260], s[325]); o.w = cvt_pk_bf16(s[390], s[455]);
        __builtin_nontemporal_store(o, (u32x4*)(dst0 + (size_t)n * DM + k0 + 8 * c)); }
    asm volatile("s_waitcnt lgkmcnt(0)" ::: "memory");
}
constexpr int CV_IN = 16 * 44, CV_OUT = 256, CV_E = 48 * 256, CV_IL = CV_IN + CV_OUT + CV_E;
constexpr int CV_PER = 4;
constexpr int CV_SLOTS = (256 - 792 % 256) + (256 - 288 % 256) + (256 - 1152 % 256) + (256 - 576 % 256);
static_assert(2 * (16 * 44 + 256 + 48 * 256) - CV_SLOTS * 8 * CV_PER + ((256 - 792 % 256) + (256 - 288 % 256)) * 8 * CV_PER >= (16 * 44 + 256 + 48 * 256) && 2 * (16 * 44 + 256 + 48 * 256) - CV_SLOTS * 8 * CV_PER >= 16 * 44 + 256, "deferred conversion must not postpone weights that layer 0 needs");
__host__ __device__ __forceinline__ int cv_deferred(int G) { return G == 256 ? ((256 - 792 % 256) + (256 - 288 % 256) + (256 - 1152 % 256) + (256 - 576 % 256)) * NWAVE * CV_PER : 0; }
__device__ __forceinline__ void convert_item(const Params& p, int it, LAS float* scr, int lane) {
    const int l = it / CV_IL; int r = it % CV_IL;
    if (r < CV_IN) { const int kt = r / 44, nt = r % 44;
        transpose_tile(p.w_in + (size_t)l * DM * D_IN, D_IN, kt * 64, nt * 64, (bf16_t*)(p.ws + WS_WIN) + ((size_t)l * D_IN + nt * 64) * DM, scr, lane); return; }
    r -= CV_IN;
    if (r < CV_OUT) { const int kt = r / 16, nt = r % 16;
        transpose_tile(p.w_out + (size_t)l * DM * DM, DM, kt * 64, nt * 64, (bf16_t*)(p.ws + WS_WOUT) + ((size_t)l * DM + nt * 64) * DM, scr, lane); return; }
    r -= CV_OUT;
    const int mtx = r >> 8, t = r & 255, e = mtx / 3, which = mtx % 3, kt = t >> 4, nt = t & 15, n0 = nt * 64;
    const size_t eo = ((size_t)l * NE + e) * DM * DM;
    if (which == 2) transpose_tile(p.w_down + eo, DM, kt * 64, n0, (bf16_t*)(p.ws + WS_WD) + eo + (size_t)n0 * DM, scr, lane);
    else { const int row = (n0 >> 7) * 256 + (n0 & 127) + which * 128;
        transpose_tile((which == 0 ? p.w_gate : p.w_up) + eo, DM, kt * 64, n0, (bf16_t*)(p.ws + WS_WGU) + 2 * eo + (size_t)row * DM, scr, lane); }
}
__device__ __forceinline__ void phase0(const Params& p, LAS unsigned char* lds, int bid, int G, int tid) {
    const int lane = tid & 63, wave = __builtin_amdgcn_readfirstlane(tid >> 6);
    {
        LAS float* sc = (LAS float*)lds; LAS float* red = (LAS float*)(lds + 9 * DM * 4);
        if (bid < 384) {
            for (int i = tid; i < 9 * DM; i += NTHR) { const int r = i >> 10, k = i & 1023; const float v = r < 8 ? p.c[r * DM + k] : p.c_ctx[k]; sc[i] = v / (1.f + __expf(-v)); }
            __syncthreads();
            for (int it = bid; it < 384; it += G) mod_item(p, it, sc, red, tid);
        }
        __syncthreads();
    }
    LAS float* scr = (LAS float*)(lds + wave * 16640);
    const int gw = bid * NWAVE + wave, NGW = G * NWAVE;
    const int n_now = NL * CV_IL - cv_deferred(G);
    for (int it = gw; it < n_now; it += NGW) convert_item(p, it, scr, lane);
}
__device__ __forceinline__ void convert_deferred(const Params& p, LAS unsigned char* lds, int slot, int nunits, int bid, int G, int tid) {
    if (G != 256) return;
    const int lane = tid & 63, wave = __builtin_amdgcn_readfirstlane(tid >> 6);
    const int nfull = nunits % G; if (bid < nfull) return;
    int base = NL * CV_IL - cv_deferred(G);
    if (slot >= 1) base += (G - 792 % 256) * NWAVE * CV_PER;
    if (slot >= 2) base += (G - 288 % 256) * NWAVE * CV_PER;
    if (slot >= 3) base += (G - 1152 % 256) * NWAVE * CV_PER;
    const int it0 = base + ((bid - nfull) * NWAVE + wave) * CV_PER;
    convert_item(p, it0, (LAS float*)(lds + wave * 16640), lane);
    __builtin_amdgcn_sched_barrier(0);
    convert_item(p, it0 + 1, (LAS float*)(lds + wave * 16640), lane);
    __builtin_amdgcn_sched_barrier(0);
    convert_item(p, it0 + 2, (LAS float*)(lds + wave * 16640), lane);
    __builtin_amdgcn_sched_barrier(0);
    convert_item(p, it0 + 3, (LAS float*)(lds + wave * 16640), lane);
}

__device__ __forceinline__ void phaseA(const Params& p, int bid, int G, int tid) {
    const int lane = tid & 63, gw = bid * NWAVE + __builtin_amdgcn_readfirstlane(tid >> 6), NGW = G * NWAVE;
    const float* MOD = (const float*)(p.ws + WS_MOD); bf16_t* H = (bf16_t*)(p.ws + WS_R3);
    for (int row = gw; row < T_ALL; row += NGW) {
        const float* xr = row < T_LAT ? p.x + (size_t)row * DM : p.ctx + (size_t)(row - T_LAT) * DM;
        const float* md = MOD + (size_t)mod_row_of(row) * 6144;
        f32x4 v[4], sh[4], sc[4]; ld_row_nt(v, xr, lane); ld_row(sh, md, lane); ld_row(sc, md + DM, lane);
        ln16(v, lane);
#pragma unroll
        for (int j = 0; j < 4; ++j) v[j] = v[j] * (sc[j] + 1.f) + sh[j];
        st_row_bf16(H + (size_t)row * DM, v, lane);
    }
}

constexpr int KRS = 144, VRS = 160;
constexpr int LDS_RPB = 768 * KRS, LDS_MRG = 768 * VRS;
static_assert(LDS_MRG + 4 * 64 * 18 * 4 <= LDS_BYTES && LDS_RPB + 465 * 4 <= LDS_MRG, "attention LDS map");

struct AttnGeo { int b, h, r, rs, bandbase, ctxbase; };
template <bool CTXQ> __device__ __forceinline__ AttnGeo attn_geo(int item) {
    AttnGeo q;
    if (!CTXQ) { q.b = item >> 8; q.r = (item >> 3) & 31; q.h = item & 7; int rs = q.r - 4; rs = rs < 0 ? 0 : (rs > 24 ? 24 : rs); q.rs = rs; q.bandbase = q.b * SEQ + rs * 64; q.ctxbase = T_LAT + q.b * CTXL; }
    else { q.b = item >> 4; q.h = (item >> 1) & 7; q.r = item & 1; q.rs = 0; q.bandbase = 0; q.ctxbase = T_LAT + q.b * CTXL; }
    return q;
}
template <bool CTXQ, int P0, int P1> __device__ __forceinline__ void attn_load_rows(u32x4 (&t)[P1 - P0], const bf16_t* U, const AttnGeo& q, int col, int tid) {
    const int chunk = tid & 7, r0 = tid >> 3;
#pragma unroll
    for (int ps = P0; ps < P1; ++ps) { const int row = ps * 64 + r0; const int tok = (!CTXQ && row < 512) ? q.bandbase + row : q.ctxbase + row - (CTXQ ? 0 : 512);
        t[ps - P0] = *(const u32x4*)(U + (size_t)tok * D_IN + col + q.h * 64 + chunk * 8); }
}
template <int RS, int P0, int P1> __device__ __forceinline__ void attn_store_rows(const u32x4 (&t)[P1 - P0], LAS unsigned char* lds, int tid) {
    const int chunk = tid & 7, r0 = tid >> 3;
#pragma unroll
    for (int ps = P0; ps < P1; ++ps) *(LAS u32x4*)(lds + (ps * 64 + r0) * RS + chunk * 16) = t[ps - P0];
}
template <bool CTXQ> __device__ __forceinline__ void attn_run(const Params& p, int l, int n_items, LAS unsigned char* lds, int bid, int G, int tid) {
    int it = bid; if (it >= n_items) return;
    const int wave = __builtin_amdgcn_readfirstlane(tid >> 6);
    const bf16_t* U = (const bf16_t*)(p.ws + WS_R1); bf16_t* MIX = (bf16_t*)(p.ws + WS_R3);
    const int qi = wave & 3, kh = wave >> 2;
    const bool band = (!CTXQ) && kh == 0;
    int cw = 16 * qi - 8; cw = cw < 0 ? 0 : (cw > 32 ? 32 : cw);
    const int base0 = CTXQ ? 0 : 512;
    AttnGeo cur = attn_geo<CTXQ>(it);
    constexpr int NR = CTXQ ? 4 : 12, NKP = CTXQ ? 4 : 8;
    u32x4 tk[NKP], tv[NR];
    attn_load_rows<CTXQ, 0, NKP>(tk, U, cur, OFF_K, tid);
    const int tid_outer = tid;
    for (;;) {
        int tid = tid_outer; asm volatile("" : "+v"(tid));
        const int lane = tid & 63, fr = lane & 15, g = lane >> 4, qq = fr >> 2, pp = fr & 3;
        const int qtok = CTXQ ? (cur.ctxbase + cur.r * 128 + wave * 16 + fr) : (cur.b * SEQ + cur.r * 64 + 16 * qi + fr);
        if constexpr (!CTXQ) { u32x4 tc[4]; attn_load_rows<CTXQ, 8, 12>(tc, U, cur, OFF_K, tid); attn_store_rows<KRS, 0, 8>(tk, lds, tid); attn_store_rows<KRS, 8, 12>(tc, lds, tid); }
        else attn_store_rows<KRS, 0, 4>(tk, lds, tid);
        if (!CTXQ && tid < 481) ((LAS float*)(lds + LDS_RPB))[tid < 465 ? (tid % 31) * 15 + tid / 31 : tid] = tid < 465 ? p.na_rpb[((size_t)l * 8 + cur.h) * 465 + tid] : -1e30f;
        attn_load_rows<CTXQ, 0, NR>(tv, U, cur, OFF_V, tid);
        bf16x8 qf[2];
#pragma unroll
        for (int ks = 0; ks < 2; ++ks) qf[ks] = *(const bf16x8*)(U + (size_t)qtok * D_IN + OFF_Q + cur.h * 64 + 32 * ks + 8 * g);
        __syncthreads();
        f32x4 s[16];
#pragma unroll
        for (int t = 0; t < 16; ++t) {
            const int rb = band ? ((t >> 1) * 64 + cw + 16 * (t & 1)) : (base0 + 16 * t);
            f32x4 a = {0.f, 0.f, 0.f, 0.f};
#pragma unroll
            for (int ks = 0; ks < 2; ++ks) { const bf16x8 kf = *(const LAS bf16x8*)(lds + (rb + fr) * KRS + (32 * ks + 8 * g) * 2);
                a = __builtin_amdgcn_mfma_f32_16x16x32_bf16(kf, qf[ks], a, 0, 0, 0); }
            s[t] = a;
            if ((t & 3) == 3) __builtin_amdgcn_sched_barrier(0);
        }
        if (band) {
            const LAS float* tab = (const LAS float*)(lds + LDS_RPB);
            const int qcol = 16 * qi + fr; int cs = qcol - 8; cs = cs < 0 ? 0 : (cs > 48 ? 48 : cs);
            const int drow0 = cur.rs - cur.r + 7;
#pragma unroll
            for (int tp = 0; tp < 2; ++tp)
#pragma unroll
                for (int j = 0; j < 4; ++j) { const int kcol = cw + 16 * tp + 4 * g + j; int dc = kcol - qcol + 15; dc = dc < 0 ? 0 : (dc > 30 ? 30 : dc);
                    const bool ok = kcol >= cs && kcol < cs + 16; const LAS float* bp = tab + (ok ? dc * 15 + drow0 : 465);
#pragma unroll
                    for (int w = 0; w < 8; ++w) s[2 * w + tp][j] += bp[w]; }
        }
        float m = -3e38f;
#pragma unroll
        for (int t = 0; t < 16; ++t) m = fmaxf(m, fmaxf(fmaxf(s[t][0], s[t][1]), fmaxf(s[t][2], s[t][3])));
        m = fmaxf(m, shx(m, 16, lane)); m = fmaxf(m, shx(m, 32, lane));
        float lsum = 0.f; const float mb = m * LOG2E;
        bf16x8 pf[8];
#pragma unroll
        for (int c = 0; c < 8; ++c) {
            float e[8];
#pragma unroll
            for (int j = 0; j < 4; ++j) { e[j] = __builtin_amdgcn_exp2f(s[2 * c][j] * LOG2E - mb); e[4 + j] = __builtin_amdgcn_exp2f(s[2 * c + 1][j] * LOG2E - mb); }
#pragma unroll
            for (int j = 0; j < 8; ++j) lsum += e[j];
            u32x4 w; w.x = cvt_pk_bf16(e[0], e[1]); w.y = cvt_pk_bf16(e[2], e[3]); w.z = cvt_pk_bf16(e[4], e[5]); w.w = cvt_pk_bf16(e[6], e[7]);
            pf[c] = __builtin_bit_cast(bf16x8, w);
        }
        lsum += shx(lsum, 16, lane); lsum += shx(lsum, 32, lane);
        __syncthreads();
        attn_store_rows<VRS, 0, NR>(tv, lds, tid);
        const int nit = it + G; const bool has_next = nit < n_items;
        AttnGeo nxt = cur;
        if (has_next) { nxt = attn_geo<CTXQ>(nit); attn_load_rows<CTXQ, 0, NKP>(tk, U, nxt, OFF_K, tid); }
        __syncthreads();
        f32x4 o[4];
#pragma unroll
        for (int nd = 0; nd < 4; ++nd) o[nd] = (f32x4){0.f, 0.f, 0.f, 0.f};
#pragma unroll
        for (int c = 0; c < 8; ++c) {
            const int rb0 = band ? (c * 64 + cw) : (base0 + 32 * c);
            const LAS unsigned char* a0 = lds + (rb0 + 4 * g + qq) * VRS + 8 * pp;
            const LAS unsigned char* a1 = a0 + 16 * VRS;
#pragma unroll
            for (int nd = 0; nd < 4; ++nd) {
                const s16x4 lo = __builtin_amdgcn_ds_read_tr16_b64_v4i16((LAS s16x4*)(a0 + 32 * nd));
                const s16x4 hi = __builtin_amdgcn_ds_read_tr16_b64_v4i16((LAS s16x4*)(a1 + 32 * nd));
                const bf16x8 vf = (bf16x8){lo[0], lo[1], lo[2], lo[3], hi[0], hi[1], hi[2], hi[3]};
                o[nd] = __builtin_amdgcn_mfma_f32_16x16x32_bf16(vf, pf[c], o[nd], 0, 0, 0);
            }
            if (c & 1) __builtin_amdgcn_sched_barrier(0);
        }
        bf16_t* orow = MIX + (size_t)qtok * DM + 512 + cur.h * 64 + 4 * g;
        if (CTXQ) {
            const float inv = 1.f / lsum;
#pragma unroll
            for (int nd = 0; nd < 4; ++nd) { u32x2 w; w.x = cvt_pk_bf16(o[nd][0] * inv, o[nd][1] * inv); w.y = cvt_pk_bf16(o[nd][2] * inv, o[nd][3] * inv); *(u32x2*)(orow + 16 * nd) = w; }
            __syncthreads();
        } else {
            LAS float* mg = (LAS float*)(lds + LDS_MRG) + qi * (64 * 18);
            if (kh == 1) { mg[lane] = m; mg[64 + lane] = lsum;
#pragma unroll
                for (int nd = 0; nd < 4; ++nd)
#pragma unroll
                    for (int j = 0; j < 4; ++j) mg[(2 + nd * 4 + j) * 64 + lane] = o[nd][j]; }
            __syncthreads();
            if (kh == 0) { const float m1 = mg[lane], l1 = mg[64 + lane]; const float mm = fmaxf(m, m1);
                const float a0 = __builtin_amdgcn_exp2f((m - mm) * LOG2E), a1 = __builtin_amdgcn_exp2f((m1 - mm) * LOG2E);
                const float inv = 1.f / (lsum * a0 + l1 * a1);
#pragma unroll
                for (int nd = 0; nd < 4; ++nd) { float r4[4];
#pragma unroll
                    for (int j = 0; j < 4; ++j) r4[j] = (o[nd][j] * a0 + mg[(2 + nd * 4 + j) * 64 + lane] * a1) * inv;
                    u32x2 w; w.x = cvt_pk_bf16(r4[0], r4[1]); w.y = cvt_pk_bf16(r4[2], r4[3]); *(u32x2*)(orow + 16 * nd) = w; } }
        }
        if (!has_next) break;
        cur = nxt; it = nit;
    }
    __syncthreads();
}

__device__ __forceinline__ void conv_item(const Params& p, int l, int tile, LAS unsigned char* lds, int tid) {
    const bf16_t* U = (const bf16_t*)(p.ws + WS_R1); bf16_t* MIX = (bf16_t*)(p.ws + WS_R3);
    const int t0 = tile * 64; int s0, s1;
    if (t0 < T_LAT) { s0 = t0 & ~(SEQ - 1); s1 = s0 + SEQ; } else { s0 = T_LAT + ((t0 - T_LAT) & ~(CTXL - 1)); s1 = s0 + CTXL; }
    {
        const int c8 = (tid & 31) * 8, tg = tid >> 5;
        const float* ws_ = p.w_short + (size_t)l * 3 * 256 + c8;
        float w0[8], w1[8], w2[8];
#pragma unroll
        for (int i = 0; i < 8; ++i) { w0[i] = ws_[i]; w1[i] = ws_[256 + i]; w2[i] = ws_[512 + i]; }
        float pr[6][8];
#pragma unroll
        for (int q = 0; q < 6; ++q) { const int t = t0 + tg * 4 + q - 1;
            if (t >= s0 && t < s1) { const u32x4 cgv = *(const u32x4*)(U + (size_t)t * D_IN + OFF_A + 256 + c8), xv = *(const u32x4*)(U + (size_t)t * D_IN + OFF_A + 512 + c8);
#pragma unroll
                for (int i = 0; i < 4; ++i) { pr[q][2 * i] = bflo(cgv[i]) * bflo(xv[i]); pr[q][2 * i + 1] = bfhi(cgv[i]) * bfhi(xv[i]); } }
            else {
#pragma unroll
                for (int i = 0; i < 8; ++i) pr[q][i] = 0.f; } }
#pragma unroll
        for (int q = 0; q < 4; ++q) { const int t = t0 + tg * 4 + q; const u32x4 bgv = *(const u32x4*)(U + (size_t)t * D_IN + OFF_A + c8);
            float r8[8];
#pragma unroll
            for (int i = 0; i < 4; ++i) { r8[2 * i] = bflo(bgv[i]) * (w0[2 * i] * pr[q][2 * i] + w1[2 * i] * pr[q + 1][2 * i] + w2[2 * i] * pr[q + 2][2 * i]);
                r8[2 * i + 1] = bfhi(bgv[i]) * (w0[2 * i + 1] * pr[q][2 * i + 1] + w1[2 * i + 1] * pr[q + 1][2 * i + 1] + w2[2 * i + 1] * pr[q + 2][2 * i + 1]); }
            u32x4 w; w.x = cvt_pk_bf16(r8[0], r8[1]); w.y = cvt_pk_bf16(r8[2], r8[3]); w.z = cvt_pk_bf16(r8[4], r8[5]); w.w = cvt_pk_bf16(r8[6], r8[7]);
            *(u32x4*)(MIX + (size_t)t * DM + c8) = w; }
    }
    LAS float* hs = (LAS float*)lds;
    {
        u32x4 av[6], gv[6];
#pragma unroll
        for (int k = 0; k < 6; ++k) { const int q = tid + k * NTHR; const int rr = q >> 5, c8 = (q & 31) * 8, t = t0 - 15 + rr;
            av[k] = (u32x4){0u, 0u, 0u, 0u}; gv[k] = (u32x4){0u, 0u, 0u, 0u};
            if (q < 94 * 32 && t >= s0 && t < s1) { av[k] = *(const u32x4*)(U + (size_t)t * D_IN + OFF_B + c8); gv[k] = *(const u32x4*)(U + (size_t)t * D_IN + OFF_B + 256 + c8); } }
#pragma unroll
        for (int k = 0; k < 6; ++k) { const int q = tid + k * NTHR; const int rr = q >> 5, c8 = (q & 31) * 8;
            if (q < 94 * 32) { f32x4 lo, hi;
                lo[0] = bflo(av[k][0]) * sigmoid_f(bflo(gv[k][0])); lo[1] = bfhi(av[k][0]) * sigmoid_f(bfhi(gv[k][0])); lo[2] = bflo(av[k][1]) * sigmoid_f(bflo(gv[k][1])); lo[3] = bfhi(av[k][1]) * sigmoid_f(bfhi(gv[k][1]));
                hi[0] = bflo(av[k][2]) * sigmoid_f(bflo(gv[k][2])); hi[1] = bfhi(av[k][2]) * sigmoid_f(bfhi(gv[k][2])); hi[2] = bflo(av[k][3]) * sigmoid_f(bflo(gv[k][3])); hi[3] = bfhi(av[k][3]) * sigmoid_f(bfhi(gv[k][3]));
                *(LAS f32x4*)(hs + rr * 256 + c8) = lo; *(LAS f32x4*)(hs + rr * 256 + c8 + 4) = hi; } }
    }
    __syncthreads();
    {
        const int c = tid & 255, half = __builtin_amdgcn_readfirstlane(tid >> 8);
        float w[31];
#pragma unroll
        for (int j = 0; j < 31; ++j) w[j] = p.w_conf_dw[((size_t)l * 31 + j) * 256 + c];
        float acc[32]; const float bd = p.b_conf_dw[l * 256 + c];
#pragma unroll
        for (int o = 0; o < 32; ++o) acc[o] = bd;
#pragma unroll
        for (int i = 0; i < 62; ++i) { const float v = hs[(32 * half + i) * 256 + c];
#pragma unroll
            for (int o = 0; o < 32; ++o) { if (i - o >= 0 && i - o <= 30) acc[o] += w[i - o] * v; } }
        __syncthreads();
#pragma unroll
        for (int o = 0; o < 32; ++o) hs[(32 * half + o) * 256 + c] = acc[o];
    }
    __syncthreads();
    {
        const int lane = tid & 63, wave = __builtin_amdgcn_readfirstlane(tid >> 6);
        const f32x4 gl = *(const f32x4*)(p.g_conf_ln + l * 256 + 4 * lane), bl = *(const f32x4*)(p.b_conf_ln + l * 256 + 4 * lane);
#pragma unroll
        for (int q = 0; q < 8; ++q) { const int tt = wave * 8 + q; f32x4 v = *(const LAS f32x4*)(hs + tt * 256 + 4 * lane);
            const float mean = wave_sum((v.x + v.y) + (v.z + v.w), lane) * (1.f / 256.f); v = v - mean;
            const float var = wave_sum((v.x * v.x + v.y * v.y) + (v.z * v.z + v.w * v.w), lane) * (1.f / 256.f);
            const float rstd = 1.f / sqrtf(var + LN_EPS); v = v * rstd * gl + bl;
            u32x2 w; w.x = cvt_pk_bf16(v.x * sigmoid_f(v.x), v.y * sigmoid_f(v.y)); w.y = cvt_pk_bf16(v.z * sigmoid_f(v.z), v.w * sigmoid_f(v.w));
            *(u32x2*)(MIX + (size_t)(t0 + tt) * DM + 256 + 4 * lane) = w; }
    }
    __syncthreads();
}
__device__ __forceinline__ void phaseC(const Params& p, int l, LAS unsigned char* lds, int bid, int G, int tid, int csel) {
    const int n_att = NB * 32 * 8, n_catt = (l == 0) ? NB * 8 * 2 : 0, n_conv = (l == 0 ? T_ALL : T_LAT) / 64;
    if (csel & 1) attn_run<false>(p, l, n_att, lds, bid, G, tid);
    if ((csel & 2) && n_catt) attn_run<true>(p, l, n_catt, lds, bid, G, tid);
    if (csel & 4) for (int it = G - 1 - bid; it < n_conv; it += G) conv_item(p, l, it, lds, tid);
}

template <bool L0> __device__ __forceinline__ void phaseE(const Params& p, int l, LAS unsigned char* lds, int bid, int G, int tid) {
    const int lane = tid & 63, gw = bid * NWAVE + __builtin_amdgcn_readfirstlane(tid >> 6), NGW = G * NWAVE;
    const int nrow = (l == 0) ? T_ALL : T_LAT;
    LAS float* wr = (LAS float*)lds;
    for (int q = tid; q < DM * 16; q += NTHR) { const int k = q >> 4, e = q & 15; const int j = k >> 8, ln = (k >> 2) & 63, i = k & 3;
        wr[((((j * 4 + i) * 4) + (e >> 2)) * 64 + ln) * 4 + (e & 3)] = p.w_router[(size_t)l * DM * 16 + q]; }
    __syncthreads();
    const float* MOD = (const float*)(p.ws + WS_MOD) + (size_t)l * 9 * 6144;
    const bf16_t* Y = (const bf16_t*)(p.ws + WS_R2); const bf16_t* XS = (const bf16_t*)(p.ws + WS_XB); bf16_t* XM = (bf16_t*)(p.ws + WS_XB + SZ_R3); bf16_t* HM = (bf16_t*)(p.ws + WS_R3); float* AFF = (float*)(p.ws + WS_AFF);
    const float* g1 = p.g_post1 + l * DM; const float* b1 = p.b_post1 + l * DM;
    f32x4 xf[2][4]; u32x2 xh[2][4], yh[2][4];
#define E_PREFETCH(R0) do { _Pragma("unroll") for (int r = 0; r < 2; ++r) { int row = (R0) + r * NGW; row = row < nrow ? row : (R0); \
        if (L0) { const float* xr = row < T_LAT ? p.x + (size_t)row * DM : p.ctx + (size_t)(row - T_LAT) * DM; _Pragma("unroll") for (int j = 0; j < 4; ++j) xf[r][j] = __builtin_nontemporal_load((const f32x4*)(xr + 256 * j + 4 * lane)); } \
        else { _Pragma("unroll") for (int j = 0; j < 4; ++j) xh[r][j] = __builtin_nontemporal_load((const u32x2*)(XS + (size_t)row * DM + 256 * j + 4 * lane)); } \
        _Pragma("unroll") for (int j = 0; j < 4; ++j) yh[r][j] = __builtin_nontemporal_load((const u32x2*)(Y + (size_t)row * DM + 256 * j + 4 * lane)); } } while (0)
    E_PREFETCH(gw);
    for (int row0 = gw; row0 < nrow; row0 += 2 * NGW) {
        int rows[2]; rows[0] = row0; rows[1] = (row0 + NGW < nrow) ? row0 + NGW : row0; asm volatile("" : "+s"(rows[1]));
        f32x4 v[2][4], y[2][4], t[2][4], u[2][4];
        const float* md[2];
#pragma unroll
        for (int r = 0; r < 2; ++r) { md[r] = MOD + (size_t)mod_row_of(rows[r]) * 6144; ld_row(t[r], md[r] + 2 * DM, lane);
#pragma unroll
            for (int j = 0; j < 4; ++j) { if (L0) v[r][j] = xf[r][j]; else v[r][j] = (f32x4){bflo(xh[r][j].x), bfhi(xh[r][j].x), bflo(xh[r][j].y), bfhi(xh[r][j].y)};
                y[r][j] = (f32x4){bflo(yh[r][j].x), bfhi(yh[r][j].x), bflo(yh[r][j].y), bfhi(yh[r][j].y)}; } }
        { const int nr0 = row0 + 2 * NGW < nrow ? row0 + 2 * NGW : row0; E_PREFETCH(nr0); }
#pragma unroll
        for (int r = 0; r < 2; ++r) {
#pragma unroll
            for (int j = 0; j < 4; ++j) v[r][j] = v[r][j] * ALPHA + (t[r][j] + 1.f) * y[r][j]; }
        ld_row(y[0], g1, lane); ld_row(y[1], b1, lane);
#pragma unroll
        for (int r = 0; r < 2; ++r) ln16(v[r], lane);
#pragma unroll
        for (int r = 0; r < 2; ++r) {
#pragma unroll
            for (int j = 0; j < 4; ++j) v[r][j] = v[r][j] * y[0][j] + y[1][j];
            st_row_bf16_nt(XM + (size_t)rows[r] * DM, v[r], lane);
            ld_row(t[r], md[r] + 3 * DM, lane); ld_row(u[r], md[r] + 4 * DM, lane); }
#pragma unroll
        for (int r = 0; r < 2; ++r) ln16(v[r], lane);
#pragma unroll
        for (int r = 0; r < 2; ++r) {
#pragma unroll
            for (int j = 0; j < 4; ++j) v[r][j] = v[r][j] * (u[r][j] + 1.f) + t[r][j];
            st_row_bf16(HM + (size_t)rows[r] * DM, v[r], lane); }
#pragma unroll
        for (int r = 0; r < 2; ++r) {
            f32x4 a[4];
#pragma unroll
            for (int eq = 0; eq < 4; ++eq) a[eq] = (f32x4){0.f, 0.f, 0.f, 0.f};
#pragma unroll
            for (int j = 0; j < 4; ++j) {
#pragma unroll
                for (int i = 0; i < 4; ++i)
#pragma unroll
                    for (int eq = 0; eq < 4; ++eq) a[eq] += v[r][j][i] * *(const LAS f32x4*)(wr + (((j * 4 + i) * 4 + eq) * 64 + lane) * 4);
                __builtin_amdgcn_sched_barrier(0); }
            float x8[8], x4[4], x2[2], x1;
            const bool b5 = (lane & 32) != 0, b4 = (lane & 16) != 0, b3 = (lane & 8) != 0, b2 = (lane & 4) != 0;
#pragma unroll
            for (int k = 0; k < 8; ++k) { const float lo = a[k >> 2][k & 3], hi = a[2 + (k >> 2)][k & 3]; x8[k] = (b5 ? hi : lo) + shx(b5 ? lo : hi, 32, lane); }
#pragma unroll
            for (int k = 0; k < 4; ++k) x4[k] = (b4 ? x8[4 + k] : x8[k]) + shx(b4 ? x8[k] : x8[4 + k], 16, lane);
#pragma unroll
            for (int k = 0; k < 2; ++k) x2[k] = (b3 ? x4[2 + k] : x4[k]) + shx(b3 ? x4[k] : x4[2 + k], 8, lane);
            x1 = (b2 ? x2[1] : x2[0]) + shx(b2 ? x2[0] : x2[1], 4, lane);
            x1 += shx(x1, 2, lane); x1 += shx(x1, 1, lane);
            float mx = x1;
            mx = fmaxf(mx, shx(mx, 4, lane)); mx = fmaxf(mx, shx(mx, 8, lane)); mx = fmaxf(mx, shx(mx, 16, lane)); mx = fmaxf(mx, shx(mx, 32, lane));
            const float ex = __expf(x1 - mx); float sum = ex;
            sum += shx(sum, 4, lane); sum += shx(sum, 8, lane); sum += shx(sum, 16, lane); sum += shx(sum, 32, lane);
            if ((lane & 3) == 0) AFF[(size_t)rows[r] * 16 + (lane >> 2)] = ex / sum;
        }
    }
    __syncthreads();
}

#undef E_PREFETCH
__device__ __forceinline__ void phaseF(const Params& p, int l, LAS unsigned char* lds, int bid, int G, int tid) {
    const float* AFF = (const float*)(p.ws + WS_AFF); int* SLOT = (int*)(p.ws + WS_SLOT);
    int* TOK = (int*)(p.ws + WS_TOK);
    LAS unsigned* red = (LAS unsigned*)lds;
    LAS unsigned* wtot = (LAS unsigned*)(lds + 64);
    const int n_lat = NB * NE, n_ctx = (l == 0) ? NB * NE : 0;
    const int lane = tid & 63, wave = __builtin_amdgcn_readfirstlane(tid >> 6);
    for (int it = bid; it < n_lat + n_ctx; it += G) {
        int b, e, ntok, cap, tokbase, dstbase;
        if (it < n_lat) { b = it >> 4; e = it & 15; ntok = SEQ; cap = CAP_L; tokbase = b * SEQ; dstbase = e * ROWS_E + b * CAP_L; }
        else { const int i2 = it - n_lat; b = i2 >> 4; e = i2 & 15; ntok = CTXL; cap = CAP_C; tokbase = T_LAT + b * CTXL; dstbase = e * ROWS_E + NB * CAP_L + b * CAP_C; }
        unsigned k[4];
#pragma unroll
        for (int i = 0; i < 4; ++i) { const int t = 4 * tid + i; k[i] = t < ntok ? __builtin_bit_cast(unsigned, AFF[(size_t)(tokbase + t) * 16 + e]) : 0u; }
        unsigned thr = 0u;
        for (int bit = 30; bit >= 0; --bit) {
            const unsigned cand = thr | (1u << bit); unsigned c = 0u;
#pragma unroll
            for (int i = 0; i < 4; ++i) c += (unsigned)__popcll(__ballot(k[i] >= cand));
            const int par = bit & 1;
            if (lane == 0) red[par * 8 + wave] = c;
            __syncthreads();
            unsigned tot = 0u;
#pragma unroll
            for (int w = 0; w < 8; ++w) tot += red[par * 8 + w];
            if (tot >= (unsigned)cap) thr = cand;
        }
        unsigned ng = 0u, ne = 0u;
#pragma unroll
        for (int i = 0; i < 4; ++i) { ng += (k[i] > thr) ? 1u : 0u; ne += (k[i] == thr) ? 1u : 0u; }
        const unsigned v = ng | (ne << 16); unsigned inc = v;
#pragma unroll
        for (int o = 1; o < 64; o <<= 1) { const unsigned u = (unsigned)__builtin_amdgcn_ds_bpermute((lane - o) << 2, (int)inc); if (lane >= o) inc += u; }
        if (lane == 63) wtot[wave] = inc;
        __syncthreads();
        unsigned off = 0u, total = 0u;
#pragma unroll
        for (int w = 0; w < 8; ++w) { const unsigned x = wtot[w]; if (w < wave) off += x; total += x; }
        const unsigned exc = off + inc - v;
        unsigned gb = exc & 0xFFFFu, eb = exc >> 16; const unsigned need = (unsigned)cap - (total & 0xFFFFu);
#pragma unroll
        for (int i = 0; i < 4; ++i) { const int t = 4 * tid + i;
            if (t < ntok) { const bool gt = k[i] > thr, eq = k[i] == thr; const bool sel = gt || (eq && eb < need);
                const unsigned slot = gb + (eb < need ? eb : need);
                SLOT[(size_t)(tokbase + t) * 16 + e] = sel ? (int)slot : -1;
                if (sel) TOK[dstbase + slot] = tokbase + t;
                gb += gt ? 1u : 0u; eb += eq ? 1u : 0u; } }
        __syncthreads();
    }
}

__device__ __forceinline__ void phaseI(const Params& p, int l, int bid, int G, int tid) {
    const int lane = tid & 63, gw = bid * NWAVE + __builtin_amdgcn_readfirstlane(tid >> 6), NGW = G * NWAVE;
    const bool last = (l == NL - 1); const int nrow = (l == 0) ? T_ALL : T_LAT;
    const float* MOD = (const float*)(p.ws + WS_MOD) + (size_t)l * 9 * 6144;
    const float* AFF = (const float*)(p.ws + WS_AFF); const int* SLOT = (const int*)(p.ws + WS_SLOT);
    const bf16_t* YE = (const bf16_t*)(p.ws + WS_R1); bf16_t* XS = (bf16_t*)(p.ws + WS_XB); const bf16_t* XM = (const bf16_t*)(p.ws + WS_XB + SZ_R3); bf16_t* H = (bf16_t*)(p.ws + WS_R3);
    const float* g2 = p.g_post2 + l * DM; const float* b2 = p.b_post2 + l * DM;
    for (int row0 = gw; row0 < nrow; row0 += 2 * NGW) {
        int rows[2]; rows[0] = row0; rows[1] = (row0 + NGW < nrow) ? row0 + NGW : row0; asm volatile("" : "+s"(rows[1]));
        int sl[2], rbase[2]; float af[2]; unsigned mask[2]; const float* md[2];
        f32x4 v[2][4], t[2][4], ym[2][4];
#pragma unroll
        for (int r = 0; r < 2; ++r) { const int row = rows[r];
            sl[r] = SLOT[(size_t)row * 16 + (lane & 15)]; af[r] = AFF[(size_t)row * 16 + (lane & 15)];
            rbase[r] = row < T_LAT ? (row >> 11) * CAP_L : NB * CAP_L + ((row - T_LAT) >> 8) * CAP_C;
            md[r] = MOD + (size_t)mod_row_of(row) * 6144;
            ld_row_bf16_nt(v[r], XM + (size_t)row * DM, lane); ld_row(t[r], md[r] + 5 * DM, lane);
#pragma unroll
            for (int j = 0; j < 4; ++j) ym[r][j] = (f32x4){0.f, 0.f, 0.f, 0.f}; }
#pragma unroll
        for (int r = 0; r < 2; ++r) mask[r] = (unsigned)(__ballot(sl[r] >= 0) & 0xFFFFull);
        while (mask[0] | mask[1]) {
            u32x2 w[2][3][4]; float aa[2][3];
#pragma unroll
            for (int r = 0; r < 2; ++r)
#pragma unroll
                for (int q = 0; q < 3; ++q) { int e = 0, s_ = 0; float a_ = 0.f;
                    if (mask[r]) { e = __builtin_ctz(mask[r]); mask[r] &= mask[r] - 1u; s_ = __builtin_amdgcn_readlane(sl[r], e); a_ = __builtin_bit_cast(float, __builtin_amdgcn_readlane(__builtin_bit_cast(int, af[r]), e)); }
                    aa[r][q] = a_; const bf16_t* yr = YE + ((size_t)e * ROWS_E + rbase[r] + s_) * DM + 4 * lane;
#pragma unroll
                    for (int j = 0; j < 4; ++j) w[r][q][j] = __builtin_nontemporal_load((const u32x2*)(yr + 256 * j)); }
#pragma unroll
            for (int r = 0; r < 2; ++r)
#pragma unroll
                for (int q = 0; q < 3; ++q)
#pragma unroll
                    for (int j = 0; j < 4; ++j) { const float a_ = aa[r][q]; const u32x2 ww = w[r][q][j];
                        ym[r][j].x += a_ * bflo(ww.x); ym[r][j].y += a_ * bfhi(ww.x); ym[r][j].z += a_ * bflo(ww.y); ym[r][j].w += a_ * bfhi(ww.y); }
        }
#pragma unroll
        for (int r = 0; r < 2; ++r) {
#pragma unroll
            for (int j = 0; j < 4; ++j) v[r][j] = v[r][j] * ALPHA + (t[r][j] + 1.f) * ym[r][j]; }
        f32x4 g4[4], b4[4]; ld_row(g4, g2, lane); ld_row(b4, b2, lane);
#pragma unroll
        for (int r = 0; r < 2; ++r) ln16(v[r], lane);
#pragma unroll
        for (int r = 0; r < 2; ++r) {
#pragma unroll
            for (int j = 0; j < 4; ++j) v[r][j] = v[r][j] * g4[j] + b4[j];
            if (last) st_row_nt(p.out + (size_t)rows[r] * DM, v[r], lane); else st_row_bf16_nt(XS + (size_t)rows[r] * DM, v[r], lane); }
        if (!last) {
#pragma unroll
            for (int r = 0; r < 2; ++r) { const float* md2 = md[r] + 9 * 6144; ld_row(t[r], md2, lane); ld_row(ym[r], md2 + DM, lane); }
#pragma unroll
            for (int r = 0; r < 2; ++r) ln16(v[r], lane);
#pragma unroll
            for (int r = 0; r < 2; ++r) {
#pragma unroll
                for (int j = 0; j < 4; ++j) v[r][j] = v[r][j] * (ym[r][j] + 1.f) + t[r][j];
                st_row_bf16(H + (size_t)rows[r] * DM, v[r], lane); }
        }
    }
}

#define XB_TMO      128
#define XB_XCNT(j)  (256  + 64 * (j))
#define XB_XSUB(j)  (1280 + 64 * (j))
#define XB_XGEN(j)  (2304 + 64 * (j))
#define XB_TOP      3328
#define XB_TOPGEN   3392
#define XCD_BAR_WORDS 3456
#define XB_SPIN_CAP (1u << 18)

__device__ __forceinline__ unsigned xb_ld(unsigned* p)              { return __hip_atomic_load(p, __ATOMIC_RELAXED, __HIP_MEMORY_SCOPE_AGENT); }
__device__ __forceinline__ unsigned xb_add(unsigned* p, unsigned v) { return __hip_atomic_fetch_add(p, v, __ATOMIC_RELAXED, __HIP_MEMORY_SCOPE_AGENT); }
__device__ __forceinline__ unsigned xb_xcc_id() { return (unsigned)__builtin_amdgcn_s_getreg((3 << 11) | 20) & 0xFu; }
#define XB_SPIN(cond, bar) do { unsigned _sp = 0; while (cond) { __builtin_amdgcn_s_sleep(1); \
    if ((++_sp & 255u) == 0u) { if (xb_ld(&(bar)[XB_TMO])) break; if (_sp > XB_SPIN_CAP) { atomicAdd(&(bar)[XB_TMO], 1u); break; } } } } while (0)

struct XcdBarrier {
    unsigned* bar; unsigned x;
    volatile LAS unsigned* st;
};

__device__ __forceinline__ XcdBarrier xcd_barrier_post(unsigned* bar, volatile LAS unsigned* st) {
    XcdBarrier b; b.bar = bar; b.x = xb_xcc_id(); b.st = st;
    if (threadIdx.x == 0) (void)xb_add(&bar[XB_XCNT(b.x)], 1u);
    return b;
}
__device__ __forceinline__ void xcd_barrier_complete(unsigned* bar, unsigned x, unsigned& nloc, unsigned& nx) {
    const unsigned G = gridDim.x * gridDim.y * gridDim.z;
    unsigned sum, cnt, mine, sp = 0u;
    for (;;) {
        sum = 0u; cnt = 0u; mine = 0u;
#pragma unroll
        for (unsigned j = 0; j < 16; ++j) { const unsigned c = xb_ld(&bar[XB_XCNT(j)]); sum += c; cnt += (c > 0u) ? 1u : 0u; mine = (j == x) ? c : mine; }
        if (sum == G) break;
        __builtin_amdgcn_s_sleep(1);
        if ((++sp & 255u) == 0u) { if (xb_ld(&bar[XB_TMO])) break; if (sp > XB_SPIN_CAP) { atomicAdd(&bar[XB_TMO], 1u); break; } }
    }
    nloc = mine > 0u ? mine : 1u; nx = cnt > 0u ? cnt : 1u;
}

__device__ __forceinline__ void xcd_barrier(const XcdBarrier& b) {
    asm volatile("s_waitcnt vmcnt(0)" ::: "memory");
    __syncthreads();
    if (threadIdx.x == 0) {
        unsigned* bar = b.bar;
        __builtin_amdgcn_s_waitcnt(0);
        unsigned nloc = b.st[0], nx = b.st[1];
        if (nloc == 0u) { xcd_barrier_complete(bar, b.x, nloc, nx); b.st[0] = nloc; b.st[1] = nx; }
        const unsigned old = xb_add(&bar[XB_XSUB(b.x)], 1u);
        const unsigned gen = old / nloc;
        if (old + 1u == (gen + 1u) * nloc) {
            __builtin_amdgcn_fence(__ATOMIC_RELEASE, "agent");
            asm volatile("s_waitcnt vmcnt(0)" ::: "memory");
            const unsigned og = xb_add(&bar[XB_TOP], 1u);
            const unsigned tg = og / nx;
            if (og + 1u == (tg + 1u) * nx) xb_add(&bar[XB_TOPGEN], 1u);
            else XB_SPIN(xb_ld(&bar[XB_TOPGEN]) == tg, bar);
            __builtin_amdgcn_fence(__ATOMIC_ACQUIRE, "agent");
            xb_add(&bar[XB_XGEN(b.x)], 1u);
            asm volatile("s_waitcnt vmcnt(0)" ::: "memory");
        } else {
            XB_SPIN(xb_ld(&bar[XB_XGEN(b.x)]) == gen, bar);
            __builtin_amdgcn_fence(__ATOMIC_ACQUIRE, "agent");
            asm volatile("s_waitcnt vmcnt(0)" ::: "memory");
        }
    }
    __syncthreads();
}

constexpr int N_PHASES = 2 + 8 * NL;
#ifndef PHM
#define PHM 1023
#endif
__global__ void __launch_bounds__(NTHR, 2) mega(Params p_in) {
    extern __shared__ __attribute__((aligned(16))) unsigned char lds_raw[];
    LAS unsigned char* lds = (LAS unsigned char*)lds_raw;
    cg::grid_group grid = cg::this_grid();
    const int bid0 = blockIdx.x, G = gridDim.x;
    const Params& p0 = p_in;
    volatile LAS unsigned* bst = (volatile LAS unsigned*)(lds + LDS_BYTES - 64);
    if (threadIdx.x < 2) bst[threadIdx.x] = 0u;
    __syncthreads();
    const XcdBarrier xbar = xcd_barrier_post((unsigned*)(p0.ws + WS_BAR), bst);
    if (p0.ph_lo < 0) grid.sync();
#ifdef DUP_T
    bool rep_done = false;
#endif
    for (int ph = p0.ph_lo; ph < p0.ph_hi;) {
        int tid = threadIdx.x; asm volatile("" : "+v"(tid));
        int bid = bid0; asm volatile("" : "+s"(bid));
        Params p = p0; { size_t zoff = 0; asm volatile("" : "+s"(zoff)); p.ws = p0.ws + zoff; }
        if (ph == 0) { if (PHM & 1) phase0(p, lds, bid, G, tid); }
        else if (ph == 1) { if (PHM & 2) phaseA(p, bid, G, tid); }
        else {
            const int l = (ph - 2) >> 3, s = (ph - 2) & 7;
            if (s == 0) { if (PHM & 4) {
                pg8::Gemm g{(const bf16_t*)(p.ws + WS_R3), (const bf16_t*)(p.ws + WS_WIN) + (size_t)l * D_IN * DM, DM};
                pg8::Sched S{1, l == 0 ? 72 : 64, 11, 0, 0, 64, 7, 4, l == 0 ? 0 : 32, G, bid};
                pg8::EpiBf16 E{(bf16_t*)(p.ws + WS_R1), D_IN, p.b_in + l * D_IN, 5, 7};
                pg8::gemm_phase<pg8::EpiBf16, pg8::Sched, true, true>(lds, g, S, E, tid);
                if (l == 0) convert_deferred(p, lds, 0, 792, bid, G, tid); }
            } else if (s == 1) { if (PHM & 8) {
#if defined(DUP_T) && defined(CSEL)
                phaseC(p, l, lds, bid, G, tid, rep_done ? CSEL : 7);
#else
                phaseC(p, l, lds, bid, G, tid, 7);
#endif
            } }
            else if (s == 2) { if (PHM & 16) {
                pg8::Gemm g{(const bf16_t*)(p.ws + WS_R3), (const bf16_t*)(p.ws + WS_WOUT) + (size_t)l * DM * DM, DM};
                pg8::Sched S{1, l == 0 ? 72 : 64, 4, 0, 0, 0, 0, 1, 0, G, bid};
                pg8::EpiBf16 E{(bf16_t*)(p.ws + WS_R2), DM, p.b_out + l * DM, 0, 0};
                pg8::gemm_phase<pg8::EpiBf16, pg8::Sched, true, true>(lds, g, S, E, tid);
                if (l == 0) convert_deferred(p, lds, 1, 288, bid, G, tid); }
            } else if (s == 3) { if (PHM & 32) { if (l == 0) phaseE<true>(p, l, lds, bid, G, tid); else phaseE<false>(p, l, lds, bid, G, tid); } }
            else if (s == 4) { if (PHM & 64) phaseF(p, l, lds, bid, G, tid); }
            else if (s == 5) { if (PHM & 128) {
                pg8::Gemm g{(const bf16_t*)(p.ws + WS_R3), (const bf16_t*)(p.ws + WS_WGU) + (size_t)l * NE * 2048 * DM, DM};
                pg8::Sched S{NE, l == 0 ? 9 : 8, 8, 9, 8, 0, 0, 1, 0, G, bid};
                pg8::EpiSwiglu E{(bf16_t*)(p.ws + WS_R2), DM};
                pg8::gemm_phase<pg8::EpiSwiglu, pg8::Sched, true, true, true>(lds, g, S, E, tid, (const int*)(p.ws + WS_TOK));
                if (l == 0) convert_deferred(p, lds, 2, 1152, bid, G, tid); }
            } else if (s == 6) { if (PHM & 256) {
                pg8::Gemm g{(const bf16_t*)(p.ws + WS_R2), (const bf16_t*)(p.ws + WS_WD) + (size_t)l * NE * DM * DM, DM};
                pg8::Sched S{NE, l == 0 ? 9 : 8, 4, 9, 4, 0, 0, 1, 0, G, bid};
                pg8::EpiBf16 E{(bf16_t*)(p.ws + WS_R1), DM, nullptr, 0, 0};
                pg8::gemm_phase<pg8::EpiBf16, pg8::Sched, true, true>(lds, g, S, E, tid);
                if (l == 0) convert_deferred(p, lds, 3, 576, bid, G, tid); }
            } else { if (PHM & 512) phaseI(p, l, bid, G, tid); }
        }
        bool advance = true;
#ifdef DUP_T
        { const int ty = ph < 2 ? ph : 2 + ((ph - 2) & 7), ly = ph < 2 ? 0 : (ph - 2) >> 3;
          if (ty == DUP_T && (DUP_L < 0 || ly == DUP_L) && !rep_done) { rep_done = true; advance = false; } else rep_done = false; }
#endif
        if (!advance || ph + 1 < p0.ph_hi) xcd_barrier(xbar);
#ifdef DUP_SYNC
        if (ph + 1 < p0.ph_hi) { xcd_barrier(xbar); xcd_barrier(xbar); }
#endif
        if (advance) ++ph;
    }
}

extern "C" void kernel_launch(void* const* d_in, const int* in_sizes, int n_in, void* d_out, int out_size, void* d_ws, size_t ws_size, hipStream_t stream) {
    static int grid = 0;
    if (grid == 0) {
        if (n_in != 24 || ws_size < WS_END) { fprintf(stderr, "kernel_launch: need 24 inputs and %zu bytes of workspace (got %d, %zu)\n", (size_t)WS_END, n_in, ws_size); grid = -1; return; }
        int dev = 0, cus = 0, per_cu = 0;
        hipGetDevice(&dev); hipDeviceGetAttribute(&cus, hipDeviceAttributeMultiprocessorCount, dev);
        if (hipFuncSetAttribute((const void*)mega, hipFuncAttributeMaxDynamicSharedMemorySize, LDS_BYTES) != hipSuccess) { fprintf(stderr, "kernel_launch: hipFuncSetAttribute failed\n"); grid = -1; return; }
        if (hipOccupancyMaxActiveBlocksPerMultiprocessor(&per_cu, (const void*)mega, NTHR, LDS_BYTES) != hipSuccess || per_cu < 1) { fprintf(stderr, "kernel_launch: occupancy query says %d blocks per CU\n", per_cu); per_cu = 1; }
        (void)hipGetLastError();
        grid = cus * 1;
    }
    if (grid < 0) return;
    Params p{};
    const float** f = (const float**)&p;
    for (int i = 0; i < 24; ++i) f[i] = (const float*)d_in[i];
    p.out = (float*)d_out; p.ws = (unsigned char*)d_ws;
    if (hipMemsetAsync((char*)d_ws + WS_BAR, 0, 16384, stream) != hipSuccess) { fprintf(stderr, "kernel_launch: memset of the barrier words failed\n"); return; }
#if MULTI
    for (int ph = 0; ph < N_PHASES; ++ph) { p.ph_lo = ph; p.ph_hi = ph + 1; hipLaunchKernelGGL(mega, dim3(grid), dim3(NTHR), LDS_BYTES, stream, p); }
#else
    p.ph_lo = 0; p.ph_hi = N_PHASES;
    void* args[] = {&p};
    hipError_t e = hipLaunchCooperativeKernel((const void*)mega, dim3(grid), dim3(NTHR), args, LDS_BYTES, stream);
    if (e != hipSuccess) fprintf(stderr, "cooperative launch failed: %s (grid %d)\n", hipGetErrorString(e), grid);
#endif
}
```

```cpp
#include <hip/hip_runtime.h>
#include <hip/hip_cooperative_groups.h>
#include <cstdio>
#include <cstdint>
namespace cg = cooperative_groups;

#ifndef MULTI
#define MULTI 0
#endif

#define LAS __attribute__((address_space(3)))
#define PG8_LAS __attribute__((address_space(3)))
typedef unsigned short bf16_t;
typedef short bf16x8 __attribute__((ext_vector_type(8)));
typedef short s16x4 __attribute__((ext_vector_type(4)));
typedef float f32x4 __attribute__((ext_vector_type(4)));
typedef unsigned u32x4 __attribute__((ext_vector_type(4)));
typedef unsigned u32x2 __attribute__((ext_vector_type(2)));

constexpr int DM = 1024, NB = 8, SEQ = 2048, CTXL = 256, NL = 2;
constexpr int T_LAT = NB * SEQ, T_CTX = NB * CTXL, T_ALL = T_LAT + T_CTX;
constexpr int D_IN = 2816, OFF_A = 0, OFF_B = 768, OFF_Q = 1280, OFF_K = 1792, OFF_V = 2304;
constexpr int NE = 16, CAP_L = 256, CAP_C = 32, ROWS_E = NB * CAP_L + NB * CAP_C;
constexpr float LN_EPS = 1e-5f;
constexpr float ALPHA = 1.4142135623730951f;
constexpr float LOG2E = 1.4426950408889634f;
constexpr int NTHR = 512, NWAVE = 8;
constexpr int LDS_BYTES = 147456;

constexpr size_t SZ_WIN = (size_t)NL * D_IN * DM * 2, SZ_WOUT = (size_t)NL * DM * DM * 2, SZ_WGU = (size_t)NL * NE * 2048 * DM * 2, SZ_WD = (size_t)NL * NE * DM * DM * 2;
constexpr size_t SZ_MOD = (size_t)NL * 9 * 6144 * 4, SZ_AFF = (size_t)T_ALL * 16 * 4;
constexpr size_t SZ_R3 = (size_t)T_ALL * DM * 2, SZ_R1 = (size_t)T_ALL * D_IN * 2, SZ_R2 = (size_t)T_ALL * DM * 4, SZ_XB = (size_t)T_ALL * DM * 4;
constexpr size_t WS_WIN = 0, WS_WOUT = WS_WIN + SZ_WIN, WS_WGU = WS_WOUT + SZ_WOUT, WS_WD = WS_WGU + SZ_WGU, WS_MOD = WS_WD + SZ_WD;
constexpr size_t WS_AFF = WS_MOD + SZ_MOD, WS_SLOT = WS_AFF + SZ_AFF, WS_R3 = WS_SLOT + SZ_AFF, WS_R1 = WS_R3 + SZ_R3, WS_R2 = WS_R1 + SZ_R1, WS_XB = WS_R2 + SZ_R2, WS_BAR = WS_XB + SZ_XB, WS_TOK = WS_BAR + 16384, WS_END = WS_TOK + (size_t)NE * ROWS_E * 4;
static_assert(WS_END <= (size_t)536870912, "workspace map exceeds 512 MiB");
static_assert((size_t)NE * ROWS_E * DM * 2 <= SZ_R1 && (size_t)NE * ROWS_E * DM * 2 <= SZ_R2, "MoE buffers fit their overlays");

struct Params {
    const float *x, *c, *ctx, *c_ctx, *w_mod, *b_mod, *w_in, *b_in, *w_short, *w_conf_dw, *b_conf_dw, *g_conf_ln, *b_conf_ln, *na_rpb, *w_out, *b_out,
                *g_post1, *b_post1, *w_router, *w_gate, *w_up, *w_down, *g_post2, *b_post2;
    float* out; unsigned char* ws; int ph_lo, ph_hi;
};

__device__ __forceinline__ unsigned cvt_pk_bf16(float lo, float hi) { unsigned r; asm volatile("v_cvt_pk_bf16_f32 %0, %1, %2" : "=v"(r) : "v"(lo), "v"(hi)); return r; }
__device__ __forceinline__ float bflo(unsigned u) { return __builtin_bit_cast(float, u << 16); }
__device__ __forceinline__ float bfhi(unsigned u) { return __builtin_bit_cast(float, u & 0xffff0000u); }
__device__ __forceinline__ float shx(float v, int o, int lane) { return __builtin_bit_cast(float, __builtin_amdgcn_ds_bpermute((lane ^ o) << 2, __builtin_bit_cast(int, v))); }
__device__ __forceinline__ float wave_sum(float v, int lane) {
#pragma unroll
    for (int o = 1; o < 64; o <<= 1) v += shx(v, o, lane);
    return v;
}
__device__ __forceinline__ float sigmoid_f(float x) { return __builtin_amdgcn_rcpf(1.f + __builtin_amdgcn_exp2f(-LOG2E * x)); }
__device__ __forceinline__ void ln16(f32x4 (&v)[4], int lane) {
    float s = 0.f;
#pragma unroll
    for (int j = 0; j < 4; ++j) s += (v[j].x + v[j].y) + (v[j].z + v[j].w);
    const float mean = wave_sum(s, lane) * (1.f / DM); float s2 = 0.f;
#pragma unroll
    for (int j = 0; j < 4; ++j) { v[j] = v[j] - mean; s2 += (v[j].x * v[j].x + v[j].y * v[j].y) + (v[j].z * v[j].z + v[j].w * v[j].w); }
    const float rstd = 1.f / sqrtf(wave_sum(s2, lane) * (1.f / DM) + LN_EPS);
#pragma unroll
    for (int j = 0; j < 4; ++j) v[j] = v[j] * rstd;
}
__device__ __forceinline__ void ld_row(f32x4 (&v)[4], const float* row, int lane) {
#pragma unroll
    for (int j = 0; j < 4; ++j) v[j] = *(const f32x4*)(row + 256 * j + 4 * lane);
}
__device__ __forceinline__ void ld_row_bf16(f32x4 (&v)[4], const bf16_t* row, int lane) {
#pragma unroll
    for (int j = 0; j < 4; ++j) { const u32x2 w = *(const u32x2*)(row + 256 * j + 4 * lane); v[j] = (f32x4){bflo(w.x), bfhi(w.x), bflo(w.y), bfhi(w.y)}; }
}
__device__ __forceinline__ void ld_row_nt(f32x4 (&v)[4], const float* row, int lane) {
#pragma unroll
    for (int j = 0; j < 4; ++j) v[j] = __builtin_nontemporal_load((const f32x4*)(row + 256 * j + 4 * lane));
}
__device__ __forceinline__ void ld_row_bf16_nt(f32x4 (&v)[4], const bf16_t* row, int lane) {
#pragma unroll
    for (int j = 0; j < 4; ++j) { const u32x2 w = __builtin_nontemporal_load((const u32x2*)(row + 256 * j + 4 * lane)); v[j] = (f32x4){bflo(w.x), bfhi(w.x), bflo(w.y), bfhi(w.y)}; }
}
__device__ __forceinline__ void st_row_nt(float* row, const f32x4 (&v)[4], int lane) {
#pragma unroll
    for (int j = 0; j < 4; ++j) __builtin_nontemporal_store(v[j], (f32x4*)(row + 256 * j + 4 * lane));
}
__device__ __forceinline__ void st_row_bf16_nt(bf16_t* row, const f32x4 (&v)[4], int lane) {
#pragma unroll
    for (int j = 0; j < 4; ++j) { u32x2 w; w.x = cvt_pk_bf16(v[j].x, v[j].y); w.y = cvt_pk_bf16(v[j].z, v[j].w); __builtin_nontemporal_store(w, (u32x2*)(row + 256 * j + 4 * lane)); }
}
__device__ __forceinline__ void st_row(float* row, const f32x4 (&v)[4], int lane) {
#pragma unroll
    for (int j = 0; j < 4; ++j) *(f32x4*)(row + 256 * j + 4 * lane) = v[j];
}
__device__ __forceinline__ void st_row_bf16(bf16_t* row, const f32x4 (&v)[4], int lane) {
#pragma unroll
    for (int j = 0; j < 4; ++j) { u32x2 w; w.x = cvt_pk_bf16(v[j].x, v[j].y); w.y = cvt_pk_bf16(v[j].z, v[j].w); *(u32x2*)(row + 256 * j + 4 * lane) = w; }
}
__device__ __forceinline__ int mod_row_of(int row) { return row < T_LAT ? (row >> 11) : 8; }

namespace pg8 {
constexpr int BM = 256, BK = 64, HALF = 128, HTB = HALF * BK * 2, NXCD = 8, WGM = 8;
__host__ __device__ __forceinline__ int lds_byte(int r, int c) { const int st = (r >> 4) * 2 + (c >> 5), rr = r & 15, cc = c & 31, ob = rr * 64 + cc * 2; return st * 1024 + (ob ^ (((ob >> 9) & 1) << 5)); }
__host__ __device__ __forceinline__ void stage_rc(int b, int& R, int& C) { const int st = b / 1024, sb = b % 1024, swz = sb ^ (((sb >> 9) & 1) << 5); R = (st >> 1) * 16 + swz / 64; C = (st & 1) * 32 + (swz % 64) / 2; }
__host__ __device__ __forceinline__ int perm32(int rho) { const int n = rho >> 4, i = rho & 15; return 8 * (i >> 2) + 4 * n + (i & 3); }

struct Unit { int pm, pn, ex; };
struct Gemm { const bf16_t* A; const bf16_t* Bt; int K; };

struct Sched {
    int ngrp, nM, nN, aM, aN, tailM0, tailN0, tailNn, ntail, G, c;
    __device__ __forceinline__ bool next(int i, Unit& u) const {
        const int nmain = ngrp * nM * nN; const long L = (long)i * G + c; if (L >= nmain + ntail) return false;
        if (L >= nmain) { const int t = (int)L - nmain; u.pm = tailM0 + t / tailNn; u.pn = tailN0 + t % tailNn; u.ex = u.pn; return true; }
        int wg = (int)L; { const int q = nmain / NXCD, r = nmain % NXCD, xcd = wg % NXCD, off = wg / NXCD; wg = (xcd < r ? xcd * (q + 1) : r * (q + 1) + (xcd - r) * q) + off; }
        const int per = nM * nN, grp = wg / per, w2 = wg % per;
        const int nig = WGM * nN, gid = w2 / nig, fm = gid * WGM, gsz = (nM - fm) < WGM ? (nM - fm) : WGM;
        const int pml = fm + ((w2 % nig) % gsz), pnl = (w2 % nig) / gsz;
        u.pm = grp * aM + pml; u.pn = grp * aN + pnl; u.ex = pnl; return true;
    }
    __device__ __forceinline__ void a_ready(const Unit&) const {}
    __device__ __forceinline__ void done(const Unit&) const {}
};

struct EpiBf16 {
    static constexpr bool PERM = true, AFTER_DRAIN = false;
    bf16_t* O; int ldc; const float* bias; int q_lo, q_hi;
    __device__ __forceinline__ void operator()(const f32x4 (&acc)[2][2][4][2], const Unit& u, int wr, int wc, int fr, int fq) const {
        const int row0 = u.pm * BM + wr * 64 + fr; const int col0 = u.ex * BM + wc * 32 + 8 * fq;
        const float sc = (u.ex >= q_lo && u.ex < q_hi) ? 0.125f : 1.f;
        f32x4 bv[2][2];
#pragma unroll
        for (int bj = 0; bj < 2; ++bj)
#pragma unroll
            for (int n = 0; n < 2; ++n) bv[bj][n] = bias ? *(const f32x4*)(bias + col0 + bj * HALF + 4 * n) : (f32x4){0.f, 0.f, 0.f, 0.f};
#pragma unroll
        for (int ai = 0; ai < 2; ++ai)
#pragma unroll
            for (int m = 0; m < 4; ++m) { bf16_t* rowp = O + (size_t)(row0 + ai * HALF + m * 16) * ldc + col0;
#pragma unroll
                for (int bj = 0; bj < 2; ++bj) { f32x4 v0 = (acc[ai][bj][m][0] + bv[bj][0]) * sc, v1 = (acc[ai][bj][m][1] + bv[bj][1]) * sc;
                    u32x4 w; w.x = cvt_pk_bf16(v0[0], v0[1]); w.y = cvt_pk_bf16(v0[2], v0[3]); w.z = cvt_pk_bf16(v1[0], v1[1]); w.w = cvt_pk_bf16(v1[2], v1[3]);
                    *(u32x4*)(rowp + bj * HALF) = w; } }
    }
};
struct EpiF32 {
    static constexpr bool PERM = true, AFTER_DRAIN = false;
    float* O; int ldc; const float* bias;
    __device__ __forceinline__ void operator()(const f32x4 (&acc)[2][2][4][2], const Unit& u, int wr, int wc, int fr, int fq) const {
        const int row0 = u.pm * BM + wr * 64 + fr; const int col0 = u.ex * BM + wc * 32 + 8 * fq;
        f32x4 bv[2][2];
#pragma unroll
        for (int bj = 0; bj < 2; ++bj)
#pragma unroll
            for (int n = 0; n < 2; ++n) bv[bj][n] = *(const f32x4*)(bias + col0 + bj * HALF + 4 * n);
#pragma unroll
        for (int ai = 0; ai < 2; ++ai)
#pragma unroll
            for (int m = 0; m < 4; ++m) { float* rowp = O + (size_t)(row0 + ai * HALF + m * 16) * ldc + col0;
#pragma unroll
                for (int bj = 0; bj < 2; ++bj) { *(f32x4*)(rowp + bj * HALF) = acc[ai][bj][m][0] + bv[bj][0]; *(f32x4*)(rowp + bj * HALF + 4) = acc[ai][bj][m][1] + bv[bj][1]; } }
    }
};
struct EpiSwiglu {
    static constexpr bool PERM = true, AFTER_DRAIN = false;
    bf16_t* O; int ldc;
    __device__ __forceinline__ void operator()(const f32x4 (&acc)[2][2][4][2], const Unit& u, int wr, int wc, int fr, int fq) const {
        const int row0 = u.pm * BM + wr * 64 + fr; const int col0 = u.ex * HALF + wc * 32 + 8 * fq;
#pragma unroll
        for (int ai = 0; ai < 2; ++ai)
#pragma unroll
            for (int m = 0; m < 4; ++m) { bf16_t* rowp = O + (size_t)(row0 + ai * HALF + m * 16) * ldc + col0;
                float r[8];
#pragma unroll
                for (int n = 0; n < 2; ++n)
#pragma unroll
                    for (int j = 0; j < 4; ++j) { const float a = acc[ai][0][m][n][j], b = acc[ai][1][m][n][j]; r[4 * n + j] = a * __builtin_amdgcn_rcpf(1.f + __builtin_amdgcn_exp2f(-1.4426950408889634f * a)) * b; }
                u32x4 w; w.x = cvt_pk_bf16(r[0], r[1]); w.y = cvt_pk_bf16(r[2], r[3]); w.z = cvt_pk_bf16(r[4], r[5]); w.w = cvt_pk_bf16(r[6], r[7]);
                *(u32x4*)rowp = w; }
    }
};

template <class Epi, class Sched, bool ALIGN_EPI = false, bool SP2 = false, bool GATHER = false>
__device__ __forceinline__ void gemm_phase(PG8_LAS unsigned char* lds, const Gemm g, const Sched& S, const Epi& E, const int tid, const int* __restrict__ rowlist = nullptr) {
    const int wid = __builtin_amdgcn_readfirstlane(tid >> 6), lane = tid & 63, wr = wid >> 2, wc = wid & 3, fr = lane & 15, fq = lane >> 4;
    const int K = g.K, nt = K / BK;
    unsigned voffA[2], voffB[2];
#pragma unroll
    for (int i = 0; i < 2; ++i) { int R, C; stage_rc(tid * 16 + i * 8192, R, C); const int Rb = Epi::PERM ? ((R & ~31) + perm32(R & 31)) : R;
        voffA[i] = (unsigned)(R * K + C) * 2u; voffB[i] = (unsigned)(Rb * K + C) * 2u; }
    const size_t kstep = (size_t)(BK * 2);
    const size_t hstep = (size_t)HALF * K * 2;
    const size_t tstep = 2 * hstep;
    const unsigned ldsw = (unsigned)wid * 1024u;
    const int aoff = lds_byte(wr * 64 + fr, fq * 8), boff = lds_byte(wc * 32 + fr, fq * 8);
#define PG8_SA(b, h) (((b) * 2 + (h)) * HTB)
#define PG8_SB(b, h) ((4 + (b) * 2 + (h)) * HTB)
#define PG8_STAGE(bufoff, gbase, voff) do { _Pragma("unroll") for (int _i = 0; _i < 2; ++_i) \
        __builtin_amdgcn_global_load_lds((const unsigned*)((const char*)(gbase) + (voff)[_i]), (PG8_LAS unsigned*)(lds + (bufoff) + ldsw + _i * 8192), 16, 0, 0); } while (0)
#define PG8_STAGE_G(bufoff, gbase, h, nx) do { _Pragma("unroll") for (int _i = 0; _i < 2; ++_i) \
        __builtin_amdgcn_global_load_lds((const unsigned*)((const char*)(gbase) + ((nx) ? vgn[h][_i] : vg[h][_i])), (PG8_LAS unsigned*)(lds + (bufoff) + ldsw + _i * 8192), 16, 0, 0); } while (0)
#define PG8_STA(bufoff, base, h, vsel) do { if constexpr (GATHER) { PG8_STAGE_G(bufoff, base, h, vsel); } else { PG8_STAGE(bufoff, (base) + (h) * hstep, voffA); } } while (0)
#define PG8_LOADVG(v, pm_) do { _Pragma("unroll") for (int _i = 0; _i < 2; ++_i) { int _R, _C; stage_rc(tid * 16 + _i * 8192, _R, _C); _Pragma("unroll") for (int _h = 0; _h < 2; ++_h) \
        (v)[_h][_i] = (unsigned)rowlist[(pm_) * BM + _h * HALF + _R] * (unsigned)(K * 2) + (unsigned)_C * 2u; } } while (0)
#define PG8_LDA(dst, b, h) do { _Pragma("unroll") for (int m = 0; m < 4; ++m) _Pragma("unroll") for (int k = 0; k < 2; ++k) dst[m][k] = *(const PG8_LAS bf16x8*)(lds + PG8_SA(b, h) + aoff + m * 2048 + k * 1024); } while (0)
#define PG8_LDB(dst, b, h) do { _Pragma("unroll") for (int n = 0; n < 2; ++n) _Pragma("unroll") for (int k = 0; k < 2; ++k) dst[n][k] = *(const PG8_LAS bf16x8*)(lds + PG8_SB(b, h) + boff + n * 2048 + k * 1024); } while (0)
#define PG8_MMA(ai, bj, At, Bt) do { __builtin_amdgcn_s_setprio(1); _Pragma("unroll") for (int m = 0; m < 4; ++m) _Pragma("unroll") for (int n = 0; n < 2; ++n) _Pragma("unroll") for (int k = 0; k < 2; ++k) \
        acc[ai][bj][m][n] = __builtin_amdgcn_mfma_f32_16x16x32_bf16(Bt[n][k], At[m][k], acc[ai][bj][m][n], 0, 0, 0); __builtin_amdgcn_s_setprio(0); } while (0)
#define PG8_WAIT_V(n) asm volatile("s_waitcnt vmcnt(" #n ")" ::: "memory")
#define PG8_WAIT_L(n) asm volatile("s_waitcnt lgkmcnt(" #n ")" ::: "memory")
#define PG8_BAR __builtin_amdgcn_s_barrier()
#define PG8_SCHED __builtin_amdgcn_sched_barrier(0)
    Unit cur, nxt; int ui = 0;
    if (!S.next(0, cur)) return;
    f32x4 acc[2][2][4][2];
#pragma unroll
    for (int a = 0; a < 2; ++a)
#pragma unroll
        for (int b = 0; b < 2; ++b)
#pragma unroll
            for (int m = 0; m < 4; ++m)
#pragma unroll
                for (int n = 0; n < 2; ++n) acc[a][b][m][n] = (f32x4){0.f, 0.f, 0.f, 0.f};
    bf16x8 At[4][2], B0[2][2], B1[2][2];
    const char* cA = (const char*)g.A + (GATHER ? (size_t)0 : (size_t)cur.pm * tstep);
    unsigned vg[2][2] = {{0u, 0u}, {0u, 0u}}, vgn[2][2] = {{0u, 0u}, {0u, 0u}}; if constexpr (GATHER) PG8_LOADVG(vg, cur.pm); const char* cB = (const char*)g.Bt + (size_t)cur.pn * tstep;
    S.a_ready(cur);
    if constexpr (SP2) {
        PG8_STAGE(PG8_SB(0, 0), cB, voffB); PG8_STAGE(PG8_SB(0, 1), cB + hstep, voffB); PG8_STA(PG8_SA(0, 0), cA, 0, false); PG8_STA(PG8_SA(0, 1), cA, 1, false);
        if (wr == 1) PG8_BAR;
        PG8_WAIT_V(2); PG8_BAR;
        PG8_STAGE(PG8_SB(1, 0), cB + kstep, voffB); PG8_STA(PG8_SA(1, 0), cA + kstep, 0, false); PG8_STAGE(PG8_SB(1, 1), cB + hstep + kstep, voffB);
        PG8_WAIT_V(6); PG8_BAR;
    } else {
        PG8_STAGE(PG8_SB(0, 0), cB, voffB); PG8_STA(PG8_SA(0, 0), cA, 0, false); PG8_STAGE(PG8_SB(0, 1), cB + hstep, voffB); PG8_STA(PG8_SA(0, 1), cA, 1, false);
        if (wr == 1) PG8_BAR;
        PG8_WAIT_V(4); PG8_BAR;
        PG8_STAGE(PG8_SB(1, 0), cB + kstep, voffB); PG8_STA(PG8_SA(1, 0), cA + kstep, 0, false); PG8_STAGE(PG8_SB(1, 1), cB + hstep + kstep, voffB);
        PG8_WAIT_V(6); PG8_BAR;
    }
    for (;;) {
        const bool has_next = S.next(ui + 1, nxt);
        const char* nA = (has_next && !GATHER) ? (const char*)g.A + (size_t)nxt.pm * tstep : cA;
        if constexpr (GATHER) { if (has_next) PG8_LOADVG(vgn, nxt.pm); else { _Pragma("unroll") for (int _h = 0; _h < 2; ++_h) _Pragma("unroll") for (int _i = 0; _i < 2; ++_i) vgn[_h][_i] = vg[_h][_i]; } } const char* nB = has_next ? (const char*)g.Bt + (size_t)nxt.pn * tstep : cB;
        for (int t = 0; t < nt; t += 2) {
            const bool last = (t == nt - 2);
            const char* a1 = cA + (size_t)(t + 1) * kstep;
            const char* a2 = last ? nA : cA + (size_t)(t + 2) * kstep; const char* b2 = last ? nB : cB + (size_t)(t + 2) * kstep;
            const char* a3 = a2 + kstep; const char* b3 = b2 + kstep;
            if (last && has_next) S.a_ready(nxt);
            if constexpr (SP2) {
            PG8_LDB(B0, 0, 0); PG8_LDB(B1, 0, 1); PG8_SCHED; PG8_LDA(At, 0, 0); PG8_STA(PG8_SA(1, 1), a1, 1, false);
            PG8_WAIT_V(8); PG8_WAIT_L(0); PG8_BAR; PG8_MMA(0, 0, At, B0); PG8_MMA(0, 1, At, B1); PG8_BAR; PG8_SCHED;
            PG8_LDA(At, 0, 1); PG8_STAGE(PG8_SB(0, 0), b2, voffB); PG8_STAGE(PG8_SB(0, 1), b2 + hstep, voffB); PG8_STA(PG8_SA(0, 0), a2, 0, last);
            PG8_WAIT_V(8); PG8_WAIT_L(0); PG8_BAR; PG8_MMA(1, 0, At, B0); PG8_MMA(1, 1, At, B1); PG8_BAR; PG8_SCHED;
            PG8_LDB(B0, 1, 0); PG8_LDB(B1, 1, 1); PG8_SCHED; PG8_LDA(At, 1, 0); PG8_STA(PG8_SA(0, 1), a2, 1, last);
            PG8_WAIT_V(8); PG8_WAIT_L(0); PG8_BAR; PG8_MMA(0, 0, At, B0); PG8_MMA(0, 1, At, B1); PG8_BAR; PG8_SCHED;
            PG8_LDA(At, 1, 1); PG8_STAGE(PG8_SB(1, 0), b3, voffB); PG8_STAGE(PG8_SB(1, 1), b3 + hstep, voffB); PG8_STA(PG8_SA(1, 0), a3, 0, last);
            PG8_WAIT_V(8); PG8_WAIT_L(0); PG8_BAR; PG8_MMA(1, 0, At, B0); PG8_MMA(1, 1, At, B1); PG8_BAR; PG8_SCHED;
            } else {
            PG8_LDB(B0, 0, 0); PG8_SCHED; PG8_LDA(At, 0, 0); PG8_STA(PG8_SA(1, 1), a1, 1, false);
            PG8_WAIT_L(8); PG8_BAR; PG8_WAIT_L(0); PG8_MMA(0, 0, At, B0); PG8_BAR; PG8_SCHED;
            PG8_LDB(B1, 0, 1); PG8_STAGE(PG8_SB(0, 0), b2, voffB);
            PG8_BAR; PG8_WAIT_L(0); PG8_MMA(0, 1, At, B1); PG8_BAR;
            PG8_LDA(At, 0, 1); PG8_STA(PG8_SA(0, 0), a2, 0, last);
            PG8_BAR; PG8_WAIT_L(0); PG8_MMA(1, 0, At, B0); PG8_BAR; PG8_SCHED;
            PG8_STAGE(PG8_SB(0, 1), b2 + hstep, voffB);
            PG8_WAIT_V(6); PG8_BAR; PG8_MMA(1, 1, At, B1); PG8_BAR;
            PG8_LDB(B0, 1, 0); PG8_SCHED; PG8_LDA(At, 1, 0); PG8_STA(PG8_SA(0, 1), a2, 1, last);
            PG8_WAIT_L(8); PG8_BAR; PG8_WAIT_L(0); PG8_MMA(0, 0, At, B0); PG8_BAR; PG8_SCHED;
            PG8_LDB(B1, 1, 1); PG8_STAGE(PG8_SB(1, 0), b3, voffB);
            PG8_BAR; PG8_WAIT_L(0); PG8_MMA(0, 1, At, B1); PG8_BAR;
            PG8_LDA(At, 1, 1); PG8_STA(PG8_SA(1, 0), a3, 0, last);
            PG8_BAR; PG8_WAIT_L(0); PG8_MMA(1, 0, At, B0); PG8_BAR; PG8_SCHED;
            PG8_STAGE(PG8_SB(1, 1), b3 + hstep, voffB);
            PG8_WAIT_V(6); PG8_BAR; PG8_MMA(1, 1, At, B1); PG8_BAR;
            }
        }
        if constexpr (ALIGN_EPI) { if (wr == 0) PG8_BAR; }
        if constexpr (!Epi::AFTER_DRAIN) { E(acc, cur, wr, wc, fr, fq); S.done(cur); }
        if (!has_next) break;
#pragma unroll
        for (int a = 0; a < 2; ++a)
#pragma unroll
            for (int b = 0; b < 2; ++b)
#pragma unroll
                for (int m = 0; m < 4; ++m)
#pragma unroll
                    for (int n = 0; n < 2; ++n) acc[a][b][m][n] = (f32x4){0.f, 0.f, 0.f, 0.f};
        cur = nxt; cA = nA; cB = nB; ++ui;
        _Pragma("unroll") for (int _h = 0; _h < 2; ++_h) _Pragma("unroll") for (int _i = 0; _i < 2; ++_i) vg[_h][_i] = vgn[_h][_i];
        if constexpr (ALIGN_EPI) { if (wr == 1) PG8_BAR; }
    }
    PG8_WAIT_V(0);
    if constexpr (!ALIGN_EPI) { if (wr == 0) PG8_BAR; }
    PG8_BAR;
    if constexpr (Epi::AFTER_DRAIN) { E.fused(acc, cur, wr, wc, fr, fq, lds, wid, lane); S.done(cur); }
#undef PG8_SA
#undef PG8_SB
#undef PG8_STAGE
#undef PG8_STA
#undef PG8_STAGE_G
#undef PG8_LOADVG
#undef PG8_LDA
#undef PG8_LDB
#undef PG8_MMA
#undef PG8_WAIT_V
#undef PG8_WAIT_L
#undef PG8_BAR
#undef PG8_SCHED
}
}

__device__ __forceinline__ void mod_item(const Params& p, int item, LAS float* sc, LAS float* red, int tid) {
    const int l = item / 192, n0 = (item % 192) * 32, col = tid & 31, kg = tid >> 5;
    const float* W = p.w_mod + (size_t)l * DM * 6144 + n0 + col;
    float acc[9];
#pragma unroll
    for (int r = 0; r < 9; ++r) acc[r] = 0.f;
    float w[64];
#pragma unroll
    for (int kk = 0; kk < 64; ++kk) w[kk] = __builtin_nontemporal_load(W + (size_t)(kg * 64 + kk) * 6144);
#pragma unroll
    for (int kk = 0; kk < 64; ++kk) { const int k = kg * 64 + kk;
#pragma unroll
        for (int r = 0; r < 9; ++r) acc[r] += sc[r * DM + k] * w[kk]; }
#pragma unroll
    for (int r = 0; r < 9; ++r) red[(kg * 9 + r) * 32 + col] = acc[r];
    __syncthreads();
    if (tid < 288) { const int r = tid >> 5; float s = p.b_mod[l * 6144 + n0 + col];
#pragma unroll
        for (int g = 0; g < 16; ++g) s += red[(g * 9 + r) * 32 + col];
        ((float*)(p.ws + WS_MOD))[((size_t)l * 9 + r) * 6144 + n0 + col] = s; }
    __syncthreads();
}
__device__ __forceinline__ void transpose_tile(const float* W, int N, int k0, int n0, bf16_t* dst0  , LAS float* scr, int lane) {
    const float* src = W + (size_t)k0 * N + n0 + 4 * (lane & 15);
    f32x4 v[16];
#pragma unroll
    for (int i = 0; i < 16; ++i) v[i] = __builtin_nontemporal_load((const f32x4*)(src + (size_t)(4 * i + (lane >> 4)) * N));
#pragma unroll
    for (int i = 0; i < 16; ++i) { LAS float* d = scr + (4 * i + (lane >> 4)) * 65 + 4 * (lane & 15); d[0] = v[i].x; d[1] = v[i].y; d[2] = v[i].z; d[3] = v[i].w; }
    asm volatile("s_waitcnt lgkmcnt(0)" ::: "memory");
    const int c = lane & 7;
#pragma unroll
    for (int j = 0; j < 8; ++j) { const int n = (lane >> 3) + 8 * j; const LAS float* s = scr + (8 * c) * 65 + n;
        u32x4 o; o.x = cvt_pk_bf16(s[0], s[65]); o.y = cvt_pk_bf16(s[130], s[195]); o.z = cvt_pk_bf16(s[260], s[325]); o.w = cvt_pk_bf16(s[390], s[455]);
        __builtin_nontemporal_store(o, (u32x4*)(dst0 + (size_t)n * DM + k0 + 8 * c)); }
    asm volatile("s_waitcnt lgkmcnt(0)" ::: "memory");
}
constexpr int CV_IN = 16 * 44, CV_OUT = 256, CV_E = 48 * 256, CV_IL = CV_IN + CV_OUT + CV_E;
constexpr int CV_PER = 4;
constexpr int CV_SLOTS = (256 - 792 % 256) + (256 - 288 % 256) + (256 - 1152 % 256) + (256 - 576 % 256);
static_assert(2 * (16 * 44 + 256 + 48 * 256) - CV_SLOTS * 8 * CV_PER + ((256 - 792 % 256) + (256 - 288 % 256)) * 8 * CV_PER >= (16 * 44 + 256 + 48 * 256) && 2 * (16 * 44 + 256 + 48 * 256) - CV_SLOTS * 8 * CV_PER >= 16 * 44 + 256, "deferred conversion must not postpone weights that layer 0 needs");
__host__ __device__ __forceinline__ int cv_deferred(int G) { return G == 256 ? ((256 - 792 % 256) + (256 - 288 % 256) + (256 - 1152 % 256) + (256 - 576 % 256)) * NWAVE * CV_PER : 0; }
__device__ __forceinline__ void convert_item(const Params& p, int it, LAS float* scr, int lane) {
    const int l = it / CV_IL; int r = it % CV_IL;
    if (r < CV_IN) { const int kt = r / 44, nt = r % 44;
        transpose_tile(p.w_in + (size_t)l * DM * D_IN, D_IN, kt * 64, nt * 64, (bf16_t*)(p.ws + WS_WIN) + ((size_t)l * D_IN + nt * 64) * DM, scr, lane); return; }
    r -= CV_IN;
    if (r < CV_OUT) { const int kt = r / 16, nt = r % 16;
        transpose_tile(p.w_out + (size_t)l * DM * DM, DM, kt * 64, nt * 64, (bf16_t*)(p.ws + WS_WOUT) + ((size_t)l * DM + nt * 64) * DM, scr, lane); return; }
    r -= CV_OUT;
    const int mtx = r >> 8, t = r & 255, e = mtx / 3, which = mtx % 3, kt = t >> 4, nt = t & 15, n0 = nt * 64;
    const size_t eo = ((size_t)l * NE + e) * DM * DM;
    if (which == 2) transpose_tile(p.w_down + eo, DM, kt * 64, n0, (bf16_t*)(p.ws + WS_WD) + eo + (size_t)n0 * DM, scr, lane);
    else { const int row = (n0 >> 7) * 256 + (n0 & 127) + which * 128;
        transpose_tile((which == 0 ? p.w_gate : p.w_up) + eo, DM, kt * 64, n0, (bf16_t*)(p.ws + WS_WGU) + 2 * eo + (size_t)row * DM, scr, lane); }
}
__device__ __forceinline__ void phase0(const Params& p, LAS unsigned char* lds, int bid, int G, int tid) {
    const int lane = tid & 63, wave = __builtin_amdgcn_readfirstlane(tid >> 6);
    {
        LAS float* sc = (LAS float*)lds; LAS float* red = (LAS float*)(lds + 9 * DM * 4);
        if (bid < 384) {
            for (int i = tid; i < 9 * DM; i += NTHR) { const int r = i >> 10, k = i & 1023; const float v = r < 8 ? p.c[r * DM + k] : p.c_ctx[k]; sc[i] = v / (1.f + __expf(-v)); }
            __syncthreads();
            for (int it = bid; it < 384; it += G) mod_item(p, it, sc, red, tid);
        }
        __syncthreads();
    }
    LAS float* scr = (LAS float*)(lds + wave * 16640);
    const int gw = bid * NWAVE + wave, NGW = G * NWAVE;
    const int n_now = NL * CV_IL - cv_deferred(G);
    for (int it = gw; it < n_now; it += NGW) convert_item(p, it, scr, lane);
}
__device__ __forceinline__ void convert_deferred(const Params& p, LAS unsigned char* lds, int slot, int nunits, int bid, int G, int tid) {
    if (G != 256) return;
    const int lane = tid & 63, wave = __builtin_amdgcn_readfirstlane(tid >> 6);
    const int nfull = nunits % G; if (bid < nfull) return;
    int base = NL * CV_IL - cv_deferred(G);
    if (slot >= 1) base += (G - 792 % 256) * NWAVE * CV_PER;
    if (slot >= 2) base += (G - 288 % 256) * NWAVE * CV_PER;
    if (slot >= 3) base += (G - 1152 % 256) * NWAVE * CV_PER;
    const int it0 = base + ((bid - nfull) * NWAVE + wave) * CV_PER;
    convert_item(p, it0, (LAS float*)(lds + wave * 16640), lane);
    __builtin_amdgcn_sched_barrier(0);
    convert_item(p, it0 + 1, (LAS float*)(lds + wave * 16640), lane);
    __builtin_amdgcn_sched_barrier(0);
    convert_item(p, it0 + 2, (LAS float*)(lds + wave * 16640), lane);
    __builtin_amdgcn_sched_barrier(0);
    convert_item(p, it0 + 3, (LAS float*)(lds + wave * 16640), lane);
}

__device__ __forceinline__ void phaseA(const Params& p, int bid, int G, int tid) {
    const int lane = tid & 63, gw = bid * NWAVE + __builtin_amdgcn_readfirstlane(tid >> 6), NGW = G * NWAVE;
    const float* MOD = (const float*)(p.ws + WS_MOD); bf16_t* H = (bf16_t*)(p.ws + WS_R3);
    for (int row = gw; row < T_ALL; row += NGW) {
        const float* xr = row < T_LAT ? p.x + (size_t)row * DM : p.ctx + (size_t)(row - T_LAT) * DM;
        const float* md = MOD + (size_t)mod_row_of(row) * 6144;
        f32x4 v[4], sh[4], sc[4]; ld_row_nt(v, xr, lane); ld_row(sh, md, lane); ld_row(sc, md + DM, lane);
        ln16(v, lane);
#pragma unroll
        for (int j = 0; j < 4; ++j) v[j] = v[j] * (sc[j] + 1.f) + sh[j];
        st_row_bf16(H + (size_t)row * DM, v, lane);
    }
}

constexpr int KRS = 144, VRS = 160;
constexpr int LDS_RPB = 768 * KRS, LDS_MRG = 768 * VRS;
static_assert(LDS_MRG + 4 * 64 * 18 * 4 <= LDS_BYTES && LDS_RPB + 465 * 4 <= LDS_MRG, "attention LDS map");

struct AttnGeo { int b, h, r, rs, bandbase, ctxbase; };
template <bool CTXQ> __device__ __forceinline__ AttnGeo attn_geo(int item) {
    AttnGeo q;
    if (!CTXQ) { q.b = item >> 8; q.r = (item >> 3) & 31; q.h = item & 7; int rs = q.r - 4; rs = rs < 0 ? 0 : (rs > 24 ? 24 : rs); q.rs = rs; q.bandbase = q.b * SEQ + rs * 64; q.ctxbase = T_LAT + q.b * CTXL; }
    else { q.b = item >> 4; q.h = (item >> 1) & 7; q.r = item & 1; q.rs = 0; q.bandbase = 0; q.ctxbase = T_LAT + q.b * CTXL; }
    return q;
}
template <bool CTXQ, int P0, int P1> __device__ __forceinline__ void attn_load_rows(u32x4 (&t)[P1 - P0], const bf16_t* U, const AttnGeo& q, int col, int tid) {
    const int chunk = tid & 7, r0 = tid >> 3;
#pragma unroll
    for (int ps = P0; ps < P1; ++ps) { const int row = ps * 64 + r0; const int tok = (!CTXQ && row < 512) ? q.bandbase + row : q.ctxbase + row - (CTXQ ? 0 : 512);
        t[ps - P0] = *(const u32x4*)(U + (size_t)tok * D_IN + col + q.h * 64 + chunk * 8); }
}
template <int RS, int P0, int P1> __device__ __forceinline__ void attn_store_rows(const u32x4 (&t)[P1 - P0], LAS unsigned char* lds, int tid) {
    const int chunk = tid & 7, r0 = tid >> 3;
#pragma unroll
    for (int ps = P0; ps < P1; ++ps) *(LAS u32x4*)(lds + (ps * 64 + r0) * RS + chunk * 16) = t[ps - P0];
}
template <bool CTXQ> __device__ __forceinline__ void attn_run(const Params& p, int l, int n_items, LAS unsigned char* lds, int bid, int G, int tid) {
    int it = bid; if (it >= n_items) return;
    const int wave = __builtin_amdgcn_readfirstlane(tid >> 6);
    const bf16_t* U = (const bf16_t*)(p.ws + WS_R1); bf16_t* MIX = (bf16_t*)(p.ws + WS_R3);
    const int qi = wave & 3, kh = wave >> 2;
    const bool band = (!CTXQ) && kh == 0;
    int cw = 16 * qi - 8; cw = cw < 0 ? 0 : (cw > 32 ? 32 : cw);
    const int base0 = CTXQ ? 0 : 512;
    AttnGeo cur = attn_geo<CTXQ>(it);
    constexpr int NR = CTXQ ? 4 : 12, NKP = CTXQ ? 4 : 8;
    u32x4 tk[NKP], tv[NR];
    attn_load_rows<CTXQ, 0, NKP>(tk, U, cur, OFF_K, tid);
    const int tid_outer = tid;
    for (;;) {
        int tid = tid_outer; asm volatile("" : "+v"(tid));
        const int lane = tid & 63, fr = lane & 15, g = lane >> 4, qq = fr >> 2, pp = fr & 3;
        const int qtok = CTXQ ? (cur.ctxbase + cur.r * 128 + wave * 16 + fr) : (cur.b * SEQ + cur.r * 64 + 16 * qi + fr);
        if constexpr (!CTXQ) { u32x4 tc[4]; attn_load_rows<CTXQ, 8, 12>(tc, U, cur, OFF_K, tid); attn_store_rows<KRS, 0, 8>(tk, lds, tid); attn_store_rows<KRS, 8, 12>(tc, lds, tid); }
        else attn_store_rows<KRS, 0, 4>(tk, lds, tid);
        if (!CTXQ && tid < 481) ((LAS float*)(lds + LDS_RPB))[tid < 465 ? (tid % 31) * 15 + tid / 31 : tid] = tid < 465 ? p.na_rpb[((size_t)l * 8 + cur.h) * 465 + tid] : -1e30f;
        attn_load_rows<CTXQ, 0, NR>(tv, U, cur, OFF_V, tid);
        bf16x8 qf[2];
#pragma unroll
        for (int ks = 0; ks < 2; ++ks) qf[ks] = *(const bf16x8*)(U + (size_t)qtok * D_IN + OFF_Q + cur.h * 64 + 32 * ks + 8 * g);
        __syncthreads();
        f32x4 s[16];
#pragma unroll
        for (int t = 0; t < 16; ++t) {
            const int rb = band ? ((t >> 1) * 64 + cw + 16 * (t & 1)) : (base0 + 16 * t);
            f32x4 a = {0.f, 0.f, 0.f, 0.f};
#pragma unroll
            for (int ks = 0; ks < 2; ++ks) { const bf16x8 kf = *(const LAS bf16x8*)(lds + (rb + fr) * KRS + (32 * ks + 8 * g) * 2);
                a = __builtin_amdgcn_mfma_f32_16x16x32_bf16(kf, qf[ks], a, 0, 0, 0); }
            s[t] = a;
            if ((t & 3) == 3) __builtin_amdgcn_sched_barrier(0);
        }
        if (band) {
            const LAS float* tab = (const LAS float*)(lds + LDS_RPB);
            const int qcol = 16 * qi + fr; int cs = qcol - 8; cs = cs < 0 ? 0 : (cs > 48 ? 48 : cs);
            const int drow0 = cur.rs - cur.r + 7;
#pragma unroll
            for (int tp = 0; tp < 2; ++tp)
#pragma unroll
                for (int j = 0; j < 4; ++j) { const int kcol = cw + 16 * tp + 4 * g + j; int dc = kcol - qcol + 15; dc = dc < 0 ? 0 : (dc > 30 ? 30 : dc);
                    const bool ok = kcol >= cs && kcol < cs + 16; const LAS float* bp = tab + (ok ? dc * 15 + drow0 : 465);
#pragma unroll
                    for (int w = 0; w < 8; ++w) s[2 * w + tp][j] += bp[w]; }
        }
        float m = -3e38f;
#pragma unroll
        for (int t = 0; t < 16; ++t) m = fmaxf(m, fmaxf(fmaxf(s[t][0], s[t][1]), fmaxf(s[t][2], s[t][3])));
        m = fmaxf(m, shx(m, 16, lane)); m = fmaxf(m, shx(m, 32, lane));
        float lsum = 0.f; const float mb = m * LOG2E;
        bf16x8 pf[8];
#pragma unroll
        for (int c = 0; c < 8; ++c) {
            float e[8];
#pragma unroll
            for (int j = 0; j < 4; ++j) { e[j] = __builtin_amdgcn_exp2f(s[2 * c][j] * LOG2E - mb); e[4 + j] = __builtin_amdgcn_exp2f(s[2 * c + 1][j] * LOG2E - mb); }
#pragma unroll
            for (int j = 0; j < 8; ++j) lsum += e[j];
            u32x4 w; w.x = cvt_pk_bf16(e[0], e[1]); w.y = cvt_pk_bf16(e[2], e[3]); w.z = cvt_pk_bf16(e[4], e[5]); w.w = cvt_pk_bf16(e[6], e[7]);
            pf[c] = __builtin_bit_cast(bf16x8, w);
        }
        lsum += shx(lsum, 16, lane); lsum += shx(lsum, 32, lane);
        __syncthreads();
        attn_store_rows<VRS, 0, NR>(tv, lds, tid);
        const int nit = it + G; const bool has_next = nit < n_items;
        AttnGeo nxt = cur;
        if (has_next) { nxt = attn_geo<CTXQ>(nit); attn_load_rows<CTXQ, 0, NKP>(tk, U, nxt, OFF_K, tid); }
        __syncthreads();
        f32x4 o[4];
#pragma unroll
        for (int nd = 0; nd < 4; ++nd) o[nd] = (f32x4){0.f, 0.f, 0.f, 0.f};
#pragma unroll
        for (int c = 0; c < 8; ++c) {
            const int rb0 = band ? (c * 64 + cw) : (base0 + 32 * c);
            const LAS unsigned char* a0 = lds + (rb0 + 4 * g + qq) * VRS + 8 * pp;
            const LAS unsigned char* a1 = a0 + 16 * VRS;
#pragma unroll
            for (int nd = 0; nd < 4; ++nd) {
                const s16x4 lo = __builtin_amdgcn_ds_read_tr16_b64_v4i16((LAS s16x4*)(a0 + 32 * nd));
                const s16x4 hi = __builtin_amdgcn_ds_read_tr16_b64_v4i16((LAS s16x4*)(a1 + 32 * nd));
                const bf16x8 vf = (bf16x8){lo[0], lo[1], lo[2], lo[3], hi[0], hi[1], hi[2], hi[3]};
                o[nd] = __builtin_amdgcn_mfma_f32_16x16x32_bf16(vf, pf[c], o[nd], 0, 0, 0);
            }
            if (c & 1) __builtin_amdgcn_sched_barrier(0);
        }
        bf16_t* orow = MIX + (size_t)qtok * DM + 512 + cur.h * 64 + 4 * g;
        if (CTXQ) {
            const float inv = 1.f / lsum;
#pragma unroll
            for (int nd = 0; nd < 4; ++nd) { u32x2 w; w.x = cvt_pk_bf16(o[nd][0] * inv, o[nd][1] * inv); w.y = cvt_pk_bf16(o[nd][2] * inv, o[nd][3] * inv); *(u32x2*)(orow + 16 * nd) = w; }
            __syncthreads();
        } else {
            LAS float* mg = (LAS float*)(lds + LDS_MRG) + qi * (64 * 18);
            if (kh == 1) { mg[lane] = m; mg[64 + lane] = lsum;
#pragma unroll
                for (int nd = 0; nd < 4; ++nd)
#pragma unroll
                    for (int j = 0; j < 4; ++j) mg[(2 + nd * 4 + j) * 64 + lane] = o[nd][j]; }
            __syncthreads();
            if (kh == 0) { const float m1 = mg[lane], l1 = mg[64 + lane]; const float mm = fmaxf(m, m1);
                const float a0 = __builtin_amdgcn_exp2f((m - mm) * LOG2E), a1 = __builtin_amdgcn_exp2f((m1 - mm) * LOG2E);
                const float inv = 1.f / (lsum * a0 + l1 * a1);
#pragma unroll
                for (int nd = 0; nd < 4; ++nd) { float r4[4];
#pragma unroll
                    for (int j = 0; j < 4; ++j) r4[j] = (o[nd][j] * a0 + mg[(2 + nd * 4 + j) * 64 + lane] * a1) * inv;
                    u32x2 w; w.x = cvt_pk_bf16(r4[0], r4[1]); w.y = cvt_pk_bf16(r4[2], r4[3]); *(u32x2*)(orow + 16 * nd) = w; } }
        }
        if (!has_next) break;
        cur = nxt; it = nit;
    }
    __syncthreads();
}

__device__ __forceinline__ void conv_item(const Params& p, int l, int tile, LAS unsigned char* lds, int tid) {
    const bf16_t* U = (const bf16_t*)(p.ws + WS_R1); bf16_t* MIX = (bf16_t*)(p.ws + WS_R3);
    const int t0 = tile * 64; int s0, s1;
    if (t0 < T_LAT) { s0 = t0 & ~(SEQ - 1); s1 = s0 + SEQ; } else { s0 = T_LAT + ((t0 - T_LAT) & ~(CTXL - 1)); s1 = s0 + CTXL; }
    {
        const int c8 = (tid & 31) * 8, tg = tid >> 5;
        const float* ws_ = p.w_short + (size_t)l * 3 * 256 + c8;
        float w0[8], w1[8], w2[8];
#pragma unroll
        for (int i = 0; i < 8; ++i) { w0[i] = ws_[i]; w1[i] = ws_[256 + i]; w2[i] = ws_[512 + i]; }
        float pr[6][8];
#pragma unroll
        for (int q = 0; q < 6; ++q) { const int t = t0 + tg * 4 + q - 1;
            if (t >= s0 && t < s1) { const u32x4 cgv = *(const u32x4*)(U + (size_t)t * D_IN + OFF_A + 256 + c8), xv = *(const u32x4*)(U + (size_t)t * D_IN + OFF_A + 512 + c8);
#pragma unroll
                for (int i = 0; i < 4; ++i) { pr[q][2 * i] = bflo(cgv[i]) * bflo(xv[i]); pr[q][2 * i + 1] = bfhi(cgv[i]) * bfhi(xv[i]); } }
            else {
#pragma unroll
                for (int i = 0; i < 8; ++i) pr[q][i] = 0.f; } }
#pragma unroll
        for (int q = 0; q < 4; ++q) { const int t = t0 + tg * 4 + q; const u32x4 bgv = *(const u32x4*)(U + (size_t)t * D_IN + OFF_A + c8);
            float r8[8];
#pragma unroll
            for (int i = 0; i < 4; ++i) { r8[2 * i] = bflo(bgv[i]) * (w0[2 * i] * pr[q][2 * i] + w1[2 * i] * pr[q + 1][2 * i] + w2[2 * i] * pr[q + 2][2 * i]);
                r8[2 * i + 1] = bfhi(bgv[i]) * (w0[2 * i + 1] * pr[q][2 * i + 1] + w1[2 * i + 1] * pr[q + 1][2 * i + 1] + w2[2 * i + 1] * pr[q + 2][2 * i + 1]); }
            u32x4 w; w.x = cvt_pk_bf16(r8[0], r8[1]); w.y = cvt_pk_bf16(r8[2], r8[3]); w.z = cvt_pk_bf16(r8[4], r8[5]); w.w = cvt_pk_bf16(r8[6], r8[7]);
            *(u32x4*)(MIX + (size_t)t * DM + c8) = w; }
    }
    LAS float* hs = (LAS float*)lds;
    {
        u32x4 av[6], gv[6];
#pragma unroll
        for (int k = 0; k < 6; ++k) { const int q = tid + k * NTHR; const int rr = q >> 5, c8 = (q & 31) * 8, t = t0 - 15 + rr;
            av[k] = (u32x4){0u, 0u, 0u, 0u}; gv[k] = (u32x4){0u, 0u, 0u, 0u};
            if (q < 94 * 32 && t >= s0 && t < s1) { av[k] = *(const u32x4*)(U + (size_t)t * D_IN + OFF_B + c8); gv[k] = *(const u32x4*)(U + (size_t)t * D_IN + OFF_B + 256 + c8); } }
#pragma unroll
        for (int k = 0; k < 6; ++k) { const int q = tid + k * NTHR; const int rr = q >> 5, c8 = (q & 31) * 8;
            if (q < 94 * 32) { f32x4 lo, hi;
                lo[0] = bflo(av[k][0]) * sigmoid_f(bflo(gv[k][0])); lo[1] = bfhi(av[k][0]) * sigmoid_f(bfhi(gv[k][0])); lo[2] = bflo(av[k][1]) * sigmoid_f(bflo(gv[k][1])); lo[3] = bfhi(av[k][1]) * sigmoid_f(bfhi(gv[k][1]));
                hi[0] = bflo(av[k][2]) * sigmoid_f(bflo(gv[k][2])); hi[1] = bfhi(av[k][2]) * sigmoid_f(bfhi(gv[k][2])); hi[2] = bflo(av[k][3]) * sigmoid_f(bflo(gv[k][3])); hi[3] = bfhi(av[k][3]) * sigmoid_f(bfhi(gv[k][3]));
                *(LAS f32x4*)(hs + rr * 256 + c8) = lo; *(LAS f32x4*)(hs + rr * 256 + c8 + 4) = hi; } }
    }
    __syncthreads();
    {
        const int c = tid & 255, half = __builtin_amdgcn_readfirstlane(tid >> 8);
        float w[31];
#pragma unroll
        for (int j = 0; j < 31; ++j) w[j] = p.w_conf_dw[((size_t)l * 31 + j) * 256 + c];
        float acc[32]; const float bd = p.b_conf_dw[l * 256 + c];
#pragma unroll
        for (int o = 0; o < 32; ++o) acc[o] = bd;
#pragma unroll
        for (int i = 0; i < 62; ++i) { const float v = hs[(32 * half + i) * 256 + c];
#pragma unroll
            for (int o = 0; o < 32; ++o) { if (i - o >= 0 && i - o <= 30) acc[o] += w[i - o] * v; } }
        __syncthreads();
#pragma unroll
        for (int o = 0; o < 32; ++o) hs[(32 * half + o) * 256 + c] = acc[o];
    }
    __syncthreads();
    {
        const int lane = tid & 63, wave = __builtin_amdgcn_readfirstlane(tid >> 6);
        const f32x4 gl = *(const f32x4*)(p.g_conf_ln + l * 256 + 4 * lane), bl = *(const f32x4*)(p.b_conf_ln + l * 256 + 4 * lane);
#pragma unroll
        for (int q = 0; q < 8; ++q) { const int tt = wave * 8 + q; f32x4 v = *(const LAS f32x4*)(hs + tt * 256 + 4 * lane);
            const float mean = wave_sum((v.x + v.y) + (v.z + v.w), lane) * (1.f / 256.f); v = v - mean;
            const float var = wave_sum((v.x * v.x + v.y * v.y) + (v.z * v.z + v.w * v.w), lane) * (1.f / 256.f);
            const float rstd = 1.f / sqrtf(var + LN_EPS); v = v * rstd * gl + bl;
            u32x2 w; w.x = cvt_pk_bf16(v.x * sigmoid_f(v.x), v.y * sigmoid_f(v.y)); w.y = cvt_pk_bf16(v.z * sigmoid_f(v.z), v.w * sigmoid_f(v.w));
            *(u32x2*)(MIX + (size_t)(t0 + tt) * DM + 256 + 4 * lane) = w; }
    }
    __syncthreads();
}
__device__ __forceinline__ void phaseC(const Params& p, int l, LAS unsigned char* lds, int bid, int G, int tid, int csel) {
    const int n_att = NB * 32 * 8, n_catt = (l == 0) ? NB * 8 * 2 : 0, n_conv = (l == 0 ? T_ALL : T_LAT) / 64;
    if (csel & 1) attn_run<false>(p, l, n_att, lds, bid, G, tid);
    if ((csel & 2) && n_catt) attn_run<true>(p, l, n_catt, lds, bid, G, tid);
    if (csel & 4) for (int it = G - 1 - bid; it < n_conv; it += G) conv_item(p, l, it, lds, tid);
}

template <bool L0> __device__ __forceinline__ void phaseE(const Params& p, int l, LAS unsigned char* lds, int bid, int G, int tid) {
    const int lane = tid & 63, gw = bid * NWAVE + __builtin_amdgcn_readfirstlane(tid >> 6), NGW = G * NWAVE;
    const int nrow = (l == 0) ? T_ALL : T_LAT;
    LAS float* wr = (LAS float*)lds;
    for (int q = tid; q < DM * 16; q += NTHR) { const int k = q >> 4, e = q & 15; const int j = k >> 8, ln = (k >> 2) & 63, i = k & 3;
        wr[((((j * 4 + i) * 4) + (e >> 2)) * 64 + ln) * 4 + (e & 3)] = p.w_router[(size_t)l * DM * 16 + q]; }
    __syncthreads();
    const float* MOD = (const float*)(p.ws + WS_MOD) + (size_t)l * 9 * 6144;
    const bf16_t* Y = (const bf16_t*)(p.ws + WS_R2); const bf16_t* XS = (const bf16_t*)(p.ws + WS_XB); bf16_t* XM = (bf16_t*)(p.ws + WS_XB + SZ_R3); bf16_t* HM = (bf16_t*)(p.ws + WS_R3); float* AFF = (float*)(p.ws + WS_AFF);
    const float* g1 = p.g_post1 + l * DM; const float* b1 = p.b_post1 + l * DM;
    f32x4 xf[2][4]; u32x2 xh[2][4], yh[2][4];
#define E_PREFETCH(R0) do { _Pragma("unroll") for (int r = 0; r < 2; ++r) { int row = (R0) + r * NGW; row = row < nrow ? row : (R0); \
        if (L0) { const float* xr = row < T_LAT ? p.x + (size_t)row * DM : p.ctx + (size_t)(row - T_LAT) * DM; _Pragma("unroll") for (int j = 0; j < 4; ++j) xf[r][j] = __builtin_nontemporal_load((const f32x4*)(xr + 256 * j + 4 * lane)); } \
        else { _Pragma("unroll") for (int j = 0; j < 4; ++j) xh[r][j] = __builtin_nontemporal_load((const u32x2*)(XS + (size_t)row * DM + 256 * j + 4 * lane)); } \
        _Pragma("unroll") for (int j = 0; j < 4; ++j) yh[r][j] = __builtin_nontemporal_load((const u32x2*)(Y + (size_t)row * DM + 256 * j + 4 * lane)); } } while (0)
    E_PREFETCH(gw);
    for (int row0 = gw; row0 < nrow; row0 += 2 * NGW) {
        int rows[2]; rows[0] = row0; rows[1] = (row0 + NGW < nrow) ? row0 + NGW : row0; asm volatile("" : "+s"(rows[1]));
        f32x4 v[2][4], y[2][4], t[2][4], u[2][4];
        const float* md[2];
#pragma unroll
        for (int r = 0; r < 2; ++r) { md[r] = MOD + (size_t)mod_row_of(rows[r]) * 6144; ld_row(t[r], md[r] + 2 * DM, lane);
#pragma unroll
            for (int j = 0; j < 4; ++j) { if (L0) v[r][j] = xf[r][j]; else v[r][j] = (f32x4){bflo(xh[r][j].x), bfhi(xh[r][j].x), bflo(xh[r][j].y), bfhi(xh[r][j].y)};
                y[r][j] = (f32x4){bflo(yh[r][j].x), bfhi(yh[r][j].x), bflo(yh[r][j].y), bfhi(yh[r][j].y)}; } }
        { const int nr0 = row0 + 2 * NGW < nrow ? row0 + 2 * NGW : row0; E_PREFETCH(nr0); }
#pragma unroll
        for (int r = 0; r < 2; ++r) {
#pragma unroll
            for (int j = 0; j < 4; ++j) v[r][j] = v[r][j] * ALPHA + (t[r][j] + 1.f) * y[r][j]; }
        ld_row(y[0], g1, lane); ld_row(y[1], b1, lane);
#pragma unroll
        for (int r = 0; r < 2; ++r) ln16(v[r], lane);
#pragma unroll
        for (int r = 0; r < 2; ++r) {
#pragma unroll
            for (int j = 0; j < 4; ++j) v[r][j] = v[r][j] * y[0][j] + y[1][j];
            st_row_bf16_nt(XM + (size_t)rows[r] * DM, v[r], lane);
            ld_row(t[r], md[r] + 3 * DM, lane); ld_row(u[r], md[r] + 4 * DM, lane); }
#pragma unroll
        for (int r = 0; r < 2; ++r) ln16(v[r], lane);
#pragma unroll
        for (int r = 0; r < 2; ++r) {
#pragma unroll
            for (int j = 0; j < 4; ++j) v[r][j] = v[r][j] * (u[r][j] + 1.f) + t[r][j];
            st_row_bf16(HM + (size_t)rows[r] * DM, v[r], lane); }
        typedef float f32x2 __attribute__((ext_vector_type(2)));
        f32x2 acc2[16];
#pragma unroll
        for (int e = 0; e < 16; ++e) acc2[e] = (f32x2){0.f, 0.f};
#pragma unroll
        for (int j = 0; j < 4; ++j) {
#pragma unroll
            for (int i = 0; i < 4; ++i) { const f32x2 hv = {v[0][j][i], v[1][j][i]};
#pragma unroll
                for (int eq = 0; eq < 4; ++eq) { const f32x4 w4 = *(const LAS f32x4*)(wr + (((j * 4 + i) * 4 + eq) * 64 + lane) * 4);
#pragma unroll
                    for (int ee = 0; ee < 4; ++ee) acc2[4 * eq + ee] += hv * (f32x2){w4[ee], w4[ee]}; } }
            __builtin_amdgcn_sched_barrier(0); }
#pragma unroll
        for (int r = 0; r < 2; ++r) {
            f32x4 a[4];
#pragma unroll
            for (int eq = 0; eq < 4; ++eq) a[eq] = (f32x4){acc2[4 * eq][r], acc2[4 * eq + 1][r], acc2[4 * eq + 2][r], acc2[4 * eq + 3][r]};
            float x8[8], x4[4], x2[2], x1;
            const bool b5 = (lane & 32) != 0, b4 = (lane & 16) != 0, b3 = (lane & 8) != 0, b2 = (lane & 4) != 0;
#pragma unroll
            for (int k = 0; k < 8; ++k) { const float lo = a[k >> 2][k & 3], hi = a[2 + (k >> 2)][k & 3]; x8[k] = (b5 ? hi : lo) + shx(b5 ? lo : hi, 32, lane); }
#pragma unroll
            for (int k = 0; k < 4; ++k) x4[k] = (b4 ? x8[4 + k] : x8[k]) + shx(b4 ? x8[k] : x8[4 + k], 16, lane);
#pragma unroll
            for (int k = 0; k < 2; ++k) x2[k] = (b3 ? x4[2 + k] : x4[k]) + shx(b3 ? x4[k] : x4[2 + k], 8, lane);
            x1 = (b2 ? x2[1] : x2[0]) + shx(b2 ? x2[0] : x2[1], 4, lane);
            x1 += shx(x1, 2, lane); x1 += shx(x1, 1, lane);
            float mx = x1;
            mx = fmaxf(mx, shx(mx, 4, lane)); mx = fmaxf(mx, shx(mx, 8, lane)); mx = fmaxf(mx, shx(mx, 16, lane)); mx = fmaxf(mx, shx(mx, 32, lane));
            const float ex = __expf(x1 - mx); float sum = ex;
            sum += shx(sum, 4, lane); sum += shx(sum, 8, lane); sum += shx(sum, 16, lane); sum += shx(sum, 32, lane);
            if ((lane & 3) == 0) AFF[(size_t)rows[r] * 16 + (lane >> 2)] = ex / sum;
        }
    }
    __syncthreads();
}

#undef E_PREFETCH
__device__ __forceinline__ void phaseF(const Params& p, int l, LAS unsigned char* lds, int bid, int G, int tid) {
    const float* AFF = (const float*)(p.ws + WS_AFF); int* SLOT = (int*)(p.ws + WS_SLOT);
    int* TOK = (int*)(p.ws + WS_TOK);
    LAS unsigned* red = (LAS unsigned*)lds;
    LAS unsigned* wtot = (LAS unsigned*)(lds + 64);
    const int n_lat = NB * NE, n_ctx = (l == 0) ? NB * NE : 0;
    const int lane = tid & 63, wave = __builtin_amdgcn_readfirstlane(tid >> 6);
    for (int it = bid; it < n_lat + n_ctx; it += G) {
        int b, e, ntok, cap, tokbase, dstbase;
        if (it < n_lat) { b = it >> 4; e = it & 15; ntok = SEQ; cap = CAP_L; tokbase = b * SEQ; dstbase = e * ROWS_E + b * CAP_L; }
        else { const int i2 = it - n_lat; b = i2 >> 4; e = i2 & 15; ntok = CTXL; cap = CAP_C; tokbase = T_LAT + b * CTXL; dstbase = e * ROWS_E + NB * CAP_L + b * CAP_C; }
        unsigned k[4];
#pragma unroll
        for (int i = 0; i < 4; ++i) { const int t = 4 * tid + i; k[i] = t < ntok ? __builtin_bit_cast(unsigned, AFF[(size_t)(tokbase + t) * 16 + e]) : 0u; }
        unsigned thr = 0u;
        for (int bit = 30; bit >= 0; --bit) {
            const unsigned cand = thr | (1u << bit); unsigned c = 0u;
#pragma unroll
            for (int i = 0; i < 4; ++i) c += (unsigned)__popcll(__ballot(k[i] >= cand));
            const int par = bit & 1;
            if (lane == 0) red[par * 8 + wave] = c;
            __syncthreads();
            unsigned tot = 0u;
#pragma unroll
            for (int w = 0; w < 8; ++w) tot += red[par * 8 + w];
            if (tot >= (unsigned)cap) thr = cand;
        }
        unsigned ng = 0u, ne = 0u;
#pragma unroll
        for (int i = 0; i < 4; ++i) { ng += (k[i] > thr) ? 1u : 0u; ne += (k[i] == thr) ? 1u : 0u; }
        const unsigned v = ng | (ne << 16); unsigned inc = v;
#pragma unroll
        for (int o = 1; o < 64; o <<= 1) { const unsigned u = (unsigned)__builtin_amdgcn_ds_bpermute((lane - o) << 2, (int)inc); if (lane >= o) inc += u; }
        if (lane == 63) wtot[wave] = inc;
        __syncthreads();
        unsigned off = 0u, total = 0u;
#pragma unroll
        for (int w = 0; w < 8; ++w) { const unsigned x = wtot[w]; if (w < wave) off += x; total += x; }
        const unsigned exc = off + inc - v;
        unsigned gb = exc & 0xFFFFu, eb = exc >> 16; const unsigned need = (unsigned)cap - (total & 0xFFFFu);
#pragma unroll
        for (int i = 0; i < 4; ++i) { const int t = 4 * tid + i;
            if (t < ntok) { const bool gt = k[i] > thr, eq = k[i] == thr; const bool sel = gt || (eq && eb < need);
                const unsigned slot = gb + (eb < need ? eb : need);
                SLOT[(size_t)(tokbase + t) * 16 + e] = sel ? (int)slot : -1;
                if (sel) TOK[dstbase + slot] = tokbase + t;
                gb += gt ? 1u : 0u; eb += eq ? 1u : 0u; } }
        __syncthreads();
    }
}

__device__ __forceinline__ void phaseI(const Params& p, int l, int bid, int G, int tid) {
    const int lane = tid & 63, gw = bid * NWAVE + __builtin_amdgcn_readfirstlane(tid >> 6), NGW = G * NWAVE;
    const bool last = (l == NL - 1); const int nrow = (l == 0) ? T_ALL : T_LAT;
    const float* MOD = (const float*)(p.ws + WS_MOD) + (size_t)l * 9 * 6144;
    const float* AFF = (const float*)(p.ws + WS_AFF); const int* SLOT = (const int*)(p.ws + WS_SLOT);
    const bf16_t* YE = (const bf16_t*)(p.ws + WS_R1); bf16_t* XS = (bf16_t*)(p.ws + WS_XB); const bf16_t* XM = (const bf16_t*)(p.ws + WS_XB + SZ_R3); bf16_t* H = (bf16_t*)(p.ws + WS_R3);
    const float* g2 = p.g_post2 + l * DM; const float* b2 = p.b_post2 + l * DM;
    for (int row0 = gw; row0 < nrow; row0 += 2 * NGW) {
        int rows[2]; rows[0] = row0; rows[1] = (row0 + NGW < nrow) ? row0 + NGW : row0; asm volatile("" : "+s"(rows[1]));
        int sl[2], rbase[2]; float af[2]; unsigned mask[2]; const float* md[2];
        f32x4 v[2][4], t[2][4], ym[2][4];
#pragma unroll
        for (int r = 0; r < 2; ++r) { const int row = rows[r];
            sl[r] = SLOT[(size_t)row * 16 + (lane & 15)]; af[r] = AFF[(size_t)row * 16 + (lane & 15)];
            rbase[r] = row < T_LAT ? (row >> 11) * CAP_L : NB * CAP_L + ((row - T_LAT) >> 8) * CAP_C;
            md[r] = MOD + (size_t)mod_row_of(row) * 6144;
            ld_row_bf16_nt(v[r], XM + (size_t)row * DM, lane); ld_row(t[r], md[r] + 5 * DM, lane);
#pragma unroll
            for (int j = 0; j < 4; ++j) ym[r][j] = (f32x4){0.f, 0.f, 0.f, 0.f}; }
#pragma unroll
        for (int r = 0; r < 2; ++r) mask[r] = (unsigned)(__ballot(sl[r] >= 0) & 0xFFFFull);
        while (mask[0] | mask[1]) {
            u32x2 w[2][3][4]; float aa[2][3];
#pragma unroll
            for (int r = 0; r < 2; ++r)
#pragma unroll
                for (int q = 0; q < 3; ++q) { int e = 0, s_ = 0; float a_ = 0.f;
                    if (mask[r]) { e = __builtin_ctz(mask[r]); mask[r] &= mask[r] - 1u; s_ = __builtin_amdgcn_readlane(sl[r], e); a_ = __builtin_bit_cast(float, __builtin_amdgcn_readlane(__builtin_bit_cast(int, af[r]), e)); }
                    aa[r][q] = a_; const bf16_t* yr = YE + ((size_t)e * ROWS_E + rbase[r] + s_) * DM + 4 * lane;
#pragma unroll
                    for (int j = 0; j < 4; ++j) w[r][q][j] = __builtin_nontemporal_load((const u32x2*)(yr + 256 * j)); }
#pragma unroll
            for (int r = 0; r < 2; ++r)
#pragma unroll
                for (int q = 0; q < 3; ++q)
#pragma unroll
                    for (int j = 0; j < 4; ++j) { const float a_ = aa[r][q]; const u32x2 ww = w[r][q][j];
                        ym[r][j].x += a_ * bflo(ww.x); ym[r][j].y += a_ * bfhi(ww.x); ym[r][j].z += a_ * bflo(ww.y); ym[r][j].w += a_ * bfhi(ww.y); }
        }
#pragma unroll
        for (int r = 0; r < 2; ++r) {
#pragma unroll
            for (int j = 0; j < 4; ++j) v[r][j] = v[r][j] * ALPHA + (t[r][j] + 1.f) * ym[r][j]; }
        f32x4 g4[4], b4[4]; ld_row(g4, g2, lane); ld_row(b4, b2, lane);
#pragma unroll
        for (int r = 0; r < 2; ++r) ln16(v[r], lane);
#pragma unroll
        for (int r = 0; r < 2; ++r) {
#pragma unroll
            for (int j = 0; j < 4; ++j) v[r][j] = v[r][j] * g4[j] + b4[j];
            if (last) st_row_nt(p.out + (size_t)rows[r] * DM, v[r], lane); else st_row_bf16_nt(XS + (size_t)rows[r] * DM, v[r], lane); }
        if (!last) {
#pragma unroll
            for (int r = 0; r < 2; ++r) { const float* md2 = md[r] + 9 * 6144; ld_row(t[r], md2, lane); ld_row(ym[r], md2 + DM, lane); }
#pragma unroll
            for (int r = 0; r < 2; ++r) ln16(v[r], lane);
#pragma unroll
            for (int r = 0; r < 2; ++r) {
#pragma unroll
                for (int j = 0; j < 4; ++j) v[r][j] = v[r][j] * (ym[r][j] + 1.f) + t[r][j];
                st_row_bf16(H + (size_t)rows[r] * DM, v[r], lane); }
        }
    }
}

#define XB_TMO      128
#define XB_XCNT(j)  (256  + 64 * (j))
#define XB_XSUB(j)  (1280 + 64 * (j))
#define XB_XGEN(j)  (2304 + 64 * (j))
#define XB_TOP      3328
#define XB_TOPGEN   3392
#define XCD_BAR_WORDS 3456
#define XB_SPIN_CAP (1u << 18)

__device__ __forceinline__ unsigned xb_ld(unsigned* p)              { return __hip_atomic_load(p, __ATOMIC_RELAXED, __HIP_MEMORY_SCOPE_AGENT); }
__device__ __forceinline__ unsigned xb_add(unsigned* p, unsigned v) { return __hip_atomic_fetch_add(p, v, __ATOMIC_RELAXED, __HIP_MEMORY_SCOPE_AGENT); }
__device__ __forceinline__ unsigned xb_xcc_id() { return (unsigned)__builtin_amdgcn_s_getreg((3 << 11) | 20) & 0xFu; }
#define XB_SPIN(cond, bar) do { unsigned _sp = 0; while (cond) { __builtin_amdgcn_s_sleep(1); \
    if ((++_sp & 255u) == 0u) { if (xb_ld(&(bar)[XB_TMO])) break; if (_sp > XB_SPIN_CAP) { atomicAdd(&(bar)[XB_TMO], 1u); break; } } } } while (0)

struct XcdBarrier {
    unsigned* bar; unsigned x;
    volatile LAS unsigned* st;
};

__device__ __forceinline__ XcdBarrier xcd_barrier_post(unsigned* bar, volatile LAS unsigned* st) {
    XcdBarrier b; b.bar = bar; b.x = xb_xcc_id(); b.st = st;
    if (threadIdx.x == 0) (void)xb_add(&bar[XB_XCNT(b.x)], 1u);
    return b;
}
__device__ __forceinline__ void xcd_barrier_complete(unsigned* bar, unsigned x, unsigned& nloc, unsigned& nx) {
    const unsigned G = gridDim.x * gridDim.y * gridDim.z;
    unsigned sum, cnt, mine, sp = 0u;
    for (;;) {
        sum = 0u; cnt = 0u; mine = 0u;
#pragma unroll
        for (unsigned j = 0; j < 16; ++j) { const unsigned c = xb_ld(&bar[XB_XCNT(j)]); sum += c; cnt += (c > 0u) ? 1u : 0u; mine = (j == x) ? c : mine; }
        if (sum == G) break;
        __builtin_amdgcn_s_sleep(1);
        if ((++sp & 255u) == 0u) { if (xb_ld(&bar[XB_TMO])) break; if (sp > XB_SPIN_CAP) { atomicAdd(&bar[XB_TMO], 1u); break; } }
    }
    nloc = mine > 0u ? mine : 1u; nx = cnt > 0u ? cnt : 1u;
}

__device__ __forceinline__ void xcd_barrier(const XcdBarrier& b) {
    asm volatile("s_waitcnt vmcnt(0)" ::: "memory");
    __syncthreads();
    if (threadIdx.x == 0) {
        unsigned* bar = b.bar;
        __builtin_amdgcn_s_waitcnt(0);
        unsigned nloc = b.st[0], nx = b.st[1];
        if (nloc == 0u) { xcd_barrier_complete(bar, b.x, nloc, nx); b.st[0] = nloc; b.st[1] = nx; }
        const unsigned old = xb_add(&bar[XB_XSUB(b.x)], 1u);
        const unsigned gen = old / nloc;
        if (old + 1u == (gen + 1u) * nloc) {
            __builtin_amdgcn_fence(__ATOMIC_RELEASE, "agent");
            asm volatile("s_waitcnt vmcnt(0)" ::: "memory");
            const unsigned og = xb_add(&bar[XB_TOP], 1u);
            const unsigned tg = og / nx;
            if (og + 1u == (tg + 1u) * nx) xb_add(&bar[XB_TOPGEN], 1u);
            else XB_SPIN(xb_ld(&bar[XB_TOPGEN]) == tg, bar);
            __builtin_amdgcn_fence(__ATOMIC_ACQUIRE, "agent");
            xb_add(&bar[XB_XGEN(b.x)], 1u);
            asm volatile("s_waitcnt vmcnt(0)" ::: "memory");
        } else {
            XB_SPIN(xb_ld(&bar[XB_XGEN(b.x)]) == gen, bar);
            __builtin_amdgcn_fence(__ATOMIC_ACQUIRE, "agent");
            asm volatile("s_waitcnt vmcnt(0)" ::: "memory");
        }
    }
    __syncthreads();
}

constexpr int N_PHASES = 2 + 8 * NL;
#ifndef PHM
#define PHM 1023
#endif
__global__ void __launch_bounds__(NTHR, 2) mega(Params p_in) {
    extern __shared__ __attribute__((aligned(16))) unsigned char lds_raw[];
    LAS unsigned char* lds = (LAS unsigned char*)lds_raw;
    cg::grid_group grid = cg::this_grid();
    const int bid0 = blockIdx.x, G = gridDim.x;
    const Params& p0 = p_in;
    volatile LAS unsigned* bst = (volatile LAS unsigned*)(lds + LDS_BYTES - 64);
    if (threadIdx.x < 2) bst[threadIdx.x] = 0u;
    __syncthreads();
    const XcdBarrier xbar = xcd_barrier_post((unsigned*)(p0.ws + WS_BAR), bst);
    if (p0.ph_lo < 0) grid.sync();
#ifdef DUP_T
    bool rep_done = false;
#endif
    for (int ph = p0.ph_lo; ph < p0.ph_hi;) {
        int tid = threadIdx.x; asm volatile("" : "+v"(tid));
        int bid = bid0; asm volatile("" : "+s"(bid));
        Params p = p0; { size_t zoff = 0; asm volatile("" : "+s"(zoff)); p.ws = p0.ws + zoff; }
        if (ph == 0) { if (PHM & 1) phase0(p, lds, bid, G, tid); }
        else if (ph == 1) { if (PHM & 2) phaseA(p, bid, G, tid); }
        else {
            const int l = (ph - 2) >> 3, s = (ph - 2) & 7;
            if (s == 0) { if (PHM & 4) {
                pg8::Gemm g{(const bf16_t*)(p.ws + WS_R3), (const bf16_t*)(p.ws + WS_WIN) + (size_t)l * D_IN * DM, DM};
                pg8::Sched S{1, l == 0 ? 72 : 64, 11, 0, 0, 64, 7, 4, l == 0 ? 0 : 32, G, bid};
                pg8::EpiBf16 E{(bf16_t*)(p.ws + WS_R1), D_IN, p.b_in + l * D_IN, 5, 7};
                pg8::gemm_phase<pg8::EpiBf16, pg8::Sched, true, true>(lds, g, S, E, tid);
                if (l == 0) convert_deferred(p, lds, 0, 792, bid, G, tid); }
            } else if (s == 1) { if (PHM & 8) {
#if defined(DUP_T) && defined(CSEL)
                phaseC(p, l, lds, bid, G, tid, rep_done ? CSEL : 7);
#else
                phaseC(p, l, lds, bid, G, tid, 7);
#endif
            } }
            else if (s == 2) { if (PHM & 16) {
                pg8::Gemm g{(const bf16_t*)(p.ws + WS_R3), (const bf16_t*)(p.ws + WS_WOUT) + (size_t)l * DM * DM, DM};
                pg8::Sched S{1, l == 0 ? 72 : 64, 4, 0, 0, 0, 0, 1, 0, G, bid};
                pg8::EpiBf16 E{(bf16_t*)(p.ws + WS_R2), DM, p.b_out + l * DM, 0, 0};
                pg8::gemm_phase<pg8::EpiBf16, pg8::Sched, true, true>(lds, g, S, E, tid);
                if (l == 0) convert_deferred(p, lds, 1, 288, bid, G, tid); }
            } else if (s == 3) { if (PHM & 32) { if (l == 0) phaseE<true>(p, l, lds, bid, G, tid); else phaseE<false>(p, l, lds, bid, G, tid); } }
            else if (s == 4) { if (PHM & 64) phaseF(p, l, lds, bid, G, tid); }
            else if (s == 5) { if (PHM & 128) {
                pg8::Gemm g{(const bf16_t*)(p.ws + WS_R3), (const bf16_t*)(p.ws + WS_WGU) + (size_t)l * NE * 2048 * DM, DM};
                pg8::Sched S{NE, l == 0 ? 9 : 8, 8, 9, 8, 0, 0, 1, 0, G, bid};
                pg8::EpiSwiglu E{(bf16_t*)(p.ws + WS_R2), DM};
                pg8::gemm_phase<pg8::EpiSwiglu, pg8::Sched, true, true, true>(lds, g, S, E, tid, (const int*)(p.ws + WS_TOK));
                if (l == 0) convert_deferred(p, lds, 2, 1152, bid, G, tid); }
            } else if (s == 6) { if (PHM & 256) {
                pg8::Gemm g{(const bf16_t*)(p.ws + WS_R2), (const bf16_t*)(p.ws + WS_WD) + (size_t)l * NE * DM * DM, DM};
                pg8::Sched S{NE, l == 0 ? 9 : 8, 4, 9, 4, 0, 0, 1, 0, G, bid};
                pg8::EpiBf16 E{(bf16_t*)(p.ws + WS_R1), DM, nullptr, 0, 0};
                pg8::gemm_phase<pg8::EpiBf16, pg8::Sched, true, true>(lds, g, S, E, tid);
                if (l == 0) convert_deferred(p, lds, 3, 576, bid, G, tid); }
            } else { if (PHM & 512) phaseI(p, l, bid, G, tid); }
        }
        bool advance = true;
#ifdef DUP_T
        { const int ty = ph < 2 ? ph : 2 + ((ph - 2) & 7), ly = ph < 2 ? 0 : (ph - 2) >> 3;
          if (ty == DUP_T && (DUP_L < 0 || ly == DUP_L) && !rep_done) { rep_done = true; advance = false; } else rep_done = false; }
#endif
        if (!advance || ph + 1 < p0.ph_hi) xcd_barrier(xbar);
#ifdef DUP_SYNC
        if (ph + 1 < p0.ph_hi) { xcd_barrier(xbar); xcd_barrier(xbar); }
#endif
        if (advance) ++ph;
    }
}

extern "C" void kernel_launch(void* const* d_in, const int* in_sizes, int n_in, void* d_out, int out_size, void* d_ws, size_t ws_size, hipStream_t stream) {
    static int grid = 0;
    if (grid == 0) {
        if (n_in != 24 || ws_size < WS_END) { fprintf(stderr, "kernel_launch: need 24 inputs and %zu bytes of workspace (got %d, %zu)\n", (size_t)WS_END, n_in, ws_size); grid = -1; return; }
        int dev = 0, cus = 0, per_cu = 0;
        hipGetDevice(&dev); hipDeviceGetAttribute(&cus, hipDeviceAttributeMultiprocessorCount, dev);
        if (hipFuncSetAttribute((const void*)mega, hipFuncAttributeMaxDynamicSharedMemorySize, LDS_BYTES) != hipSuccess) { fprintf(stderr, "kernel_launch: hipFuncSetAttribute failed\n"); grid = -1; return; }
        if (hipOccupancyMaxActiveBlocksPerMultiprocessor(&per_cu, (const void*)mega, NTHR, LDS_BYTES) != hipSuccess || per_cu < 1) { fprintf(stderr, "kernel_launch: occupancy query says %d blocks per CU\n", per_cu); per_cu = 1; }
        (void)hipGetLastError();
        grid = cus * 1;
    }
    if (grid < 0) return;
    Params p{};
    const float** f = (const float**)&p;
    for (int i = 0; i < 24; ++i) f[i] = (const float*)d_in[i];
    p.out = (float*)d_out; p.ws = (unsigned char*)d_ws;
    if (hipMemsetAsync((char*)d_ws + WS_BAR, 0, 16384, stream) != hipSuccess) { fprintf(stderr, "kernel_launch: memset of the barrier words failed\n"); return; }
#if MULTI
    for (int ph = 0; ph < N_PHASES; ++ph) { p.ph_lo = ph; p.ph_hi = ph + 1; hipLaunchKernelGGL(mega, dim3(grid), dim3(NTHR), LDS_BYTES, stream, p); }
#else
    p.ph_lo = 0; p.ph_hi = N_PHASES;
    void* args[] = {&p};
    hipError_t e = hipLaunchCooperativeKernel((const void*)mega, dim3(grid), dim3(NTHR), args, LDS_BYTES, stream);
    if (e != hipSuccess) fprintf(stderr, "cooperative launch failed: %s (grid %d)\n", hipGetErrorString(e), grid);
#endif
}
```

```cpp
#include <hip/hip_runtime.h>
#include <hip/hip_cooperative_groups.h>
#include <cstdio>
#include <cstdint>
namespace cg = cooperative_groups;

#ifndef MULTI
#define MULTI 0
#endif

#define LAS __attribute__((address_space(3)))
#define PG8_LAS __attribute__((address_space(3)))
typedef unsigned short bf16_t;
typedef short bf16x8 __attribute__((ext_vector_type(8)));
typedef short s16x4 __attribute__((ext_vector_type(4)));
typedef float f32x4 __attribute__((ext_vector_type(4)));
typedef unsigned u32x4 __attribute__((ext_vector_type(4)));
typedef unsigned u32x2 __attribute__((ext_vector_type(2)));

constexpr int DM = 1024, NB = 8, SEQ = 2048, CTXL = 256, NL = 2;
constexpr int T_LAT = NB * SEQ, T_CTX = NB * CTXL, T_ALL = T_LAT + T_CTX;
constexpr int D_IN = 2816, OFF_A = 0, OFF_B = 768, OFF_Q = 1280, OFF_K = 1792, OFF_V = 2304;
constexpr int NE = 16, CAP_L = 256, CAP_C = 32, ROWS_E = NB * CAP_L + NB * CAP_C;
constexpr float LN_EPS = 1e-5f;
constexpr float ALPHA = 1.4142135623730951f;
constexpr float LOG2E = 1.4426950408889634f;
constexpr int NTHR = 512, NWAVE = 8;
constexpr int LDS_BYTES = 147456;

constexpr size_t SZ_WIN = (size_t)NL * D_IN * DM * 2, SZ_WOUT = (size_t)NL * DM * DM * 2, SZ_WGU = (size_t)NL * NE * 2048 * DM * 2, SZ_WD = (size_t)NL * NE * DM * DM * 2;
constexpr size_t SZ_MOD = (size_t)NL * 9 * 6144 * 4, SZ_AFF = (size_t)T_ALL * 16 * 4;
constexpr size_t SZ_R3 = (size_t)T_ALL * DM * 2, SZ_R1 = (size_t)T_ALL * D_IN * 2, SZ_R2 = (size_t)T_ALL * DM * 4, SZ_XB = (size_t)T_ALL * DM * 4;
constexpr size_t WS_WIN = 0, WS_WOUT = WS_WIN + SZ_WIN, WS_WGU = WS_WOUT + SZ_WOUT, WS_WD = WS_WGU + SZ_WGU, WS_MOD = WS_WD + SZ_WD;
constexpr size_t WS_AFF = WS_MOD + SZ_MOD, WS_SLOT = WS_AFF + SZ_AFF, WS_R3 = WS_SLOT + SZ_AFF, WS_R1 = WS_R3 + SZ_R3, WS_R2 = WS_R1 + SZ_R1, WS_XB = WS_R2 + SZ_R2, WS_BAR = WS_XB + SZ_XB, WS_TOK = WS_BAR + 16384, WS_END = WS_TOK + (size_t)NE * ROWS_E * 4;
static_assert(WS_END <= (size_t)536870912, "workspace map exceeds 512 MiB");
static_assert((size_t)NE * ROWS_E * DM * 2 <= SZ_R1 && (size_t)NE * ROWS_E * DM * 2 <= SZ_R2, "MoE buffers fit their overlays");

struct Params {
    const float *x, *c, *ctx, *c_ctx, *w_mod, *b_mod, *w_in, *b_in, *w_short, *w_conf_dw, *b_conf_dw, *g_conf_ln, *b_conf_ln, *na_rpb, *w_out, *b_out,
                *g_post1, *b_post1, *w_router, *w_gate, *w_up, *w_down, *g_post2, *b_post2;
    float* out; unsigned char* ws; int ph_lo, ph_hi;
};

__device__ __forceinline__ unsigned cvt_pk_bf16(float lo, float hi) { unsigned r; asm volatile("v_cvt_pk_bf16_f32 %0, %1, %2" : "=v"(r) : "v"(lo), "v"(hi)); return r; }
__device__ __forceinline__ float bflo(unsigned u) { return __builtin_bit_cast(float, u << 16); }
__device__ __forceinline__ float bfhi(unsigned u) { return __builtin_bit_cast(float, u & 0xffff0000u); }
__device__ __forceinline__ float shx(float v, int o, int lane) { return __builtin_bit_cast(float, __builtin_amdgcn_ds_bpermute((lane ^ o) << 2, __builtin_bit_cast(int, v))); }
__device__ __forceinline__ float wave_sum(float v, int lane) {
#pragma unroll
    for (int o = 1; o < 64; o <<= 1) v += shx(v, o, lane);
    return v;
}
__device__ __forceinline__ float sigmoid_f(float x) { return __builtin_amdgcn_rcpf(1.f + __builtin_amdgcn_exp2f(-LOG2E * x)); }
__device__ __forceinline__ void ln16(f32x4 (&v)[4], int lane) {
    float s = 0.f;
#pragma unroll
    for (int j = 0; j < 4; ++j) s += (v[j].x + v[j].y) + (v[j].z + v[j].w);
    const float mean = wave_sum(s, lane) * (1.f / DM); float s2 = 0.f;
#pragma unroll
    for (int j = 0; j < 4; ++j) { v[j] = v[j] - mean; s2 += (v[j].x * v[j].x + v[j].y * v[j].y) + (v[j].z * v[j].z + v[j].w * v[j].w); }
    const float rstd = 1.f / sqrtf(wave_sum(s2, lane) * (1.f / DM) + LN_EPS);
#pragma unroll
    for (int j = 0; j < 4; ++j) v[j] = v[j] * rstd;
}
__device__ __forceinline__ void ld_row(f32x4 (&v)[4], const float* row, int lane) {
#pragma unroll
    for (int j = 0; j < 4; ++j) v[j] = *(const f32x4*)(row + 256 * j + 4 * lane);
}
__device__ __forceinline__ void ld_row_bf16(f32x4 (&v)[4], const bf16_t* row, int lane) {
#pragma unroll
    for (int j = 0; j < 4; ++j) { const u32x2 w = *(const u32x2*)(row + 256 * j + 4 * lane); v[j] = (f32x4){bflo(w.x), bfhi(w.x), bflo(w.y), bfhi(w.y)}; }
}
__device__ __forceinline__ void ld_row_nt(f32x4 (&v)[4], const float* row, int lane) {
#pragma unroll
    for (int j = 0; j < 4; ++j) v[j] = __builtin_nontemporal_load((const f32x4*)(row + 256 * j + 4 * lane));
}
__device__ __forceinline__ void ld_row_bf16_nt(f32x4 (&v)[4], const bf16_t* row, int lane) {
#pragma unroll
    for (int j = 0; j < 4; ++j) { const u32x2 w = __builtin_nontemporal_load((const u32x2*)(row + 256 * j + 4 * lane)); v[j] = (f32x4){bflo(w.x), bfhi(w.x), bflo(w.y), bfhi(w.y)}; }
}
__device__ __forceinline__ void st_row_nt(float* row, const f32x4 (&v)[4], int lane) {
#pragma unroll
    for (int j = 0; j < 4; ++j) __builtin_nontemporal_store(v[j], (f32x4*)(row + 256 * j + 4 * lane));
}
__device__ __forceinline__ void st_row_bf16_nt(bf16_t* row, const f32x4 (&v)[4], int lane) {
#pragma unroll
    for (int j = 0; j < 4; ++j) { u32x2 w; w.x = cvt_pk_bf16(v[j].x, v[j].y); w.y = cvt_pk_bf16(v[j].z, v[j].w); __builtin_nontemporal_store(w, (u32x2*)(row + 256 * j + 4 * lane)); }
}
__device__ __forceinline__ void st_row(float* row, const f32x4 (&v)[4], int lane) {
#pragma unroll
    for (int j = 0; j < 4; ++j) *(f32x4*)(row + 256 * j + 4 * lane) = v[j];
}
__device__ __forceinline__ void st_row_bf16(bf16_t* row, const f32x4 (&v)[4], int lane) {
#pragma unroll
    for (int j = 0; j < 4; ++j) { u32x2 w; w.x = cvt_pk_bf16(v[j].x, v[j].y); w.y = cvt_pk_bf16(v[j].z, v[j].w); *(u32x2*)(row + 256 * j + 4 * lane) = w; }
}
__device__ __forceinline__ int mod_row_of(int row) { return row < T_LAT ? (row >> 11) : 8; }

namespace pg8 {
constexpr int BM = 256, BK = 64, HALF = 128, HTB = HALF * BK * 2, NXCD = 8, WGM = 4;
__host__ __device__ __forceinline__ int lds_byte(int r, int c) { const int st = (r >> 4) * 2 + (c >> 5), rr = r & 15, cc = c & 31, ob = rr * 64 + cc * 2; return st * 1024 + (ob ^ (((ob >> 9) & 1) << 5)); }
__host__ __device__ __forceinline__ void stage_rc(int b, int& R, int& C) { const int st = b / 1024, sb = b % 1024, swz = sb ^ (((sb >> 9) & 1) << 5); R = (st >> 1) * 16 + swz / 64; C = (st & 1) * 32 + (swz % 64) / 2; }
__host__ __device__ __forceinline__ int perm32(int rho) { const int n = rho >> 4, i = rho & 15; return 8 * (i >> 2) + 4 * n + (i & 3); }

struct Unit { int pm, pn, ex; };
struct Gemm { const bf16_t* A; const bf16_t* Bt; int K; };

struct Sched {
    int ngrp, nM, nN, aM, aN, tailM0, tailN0, tailNn, ntail, G, c;
    __device__ __forceinline__ bool next(int i, Unit& u) const {
        const int nmain = ngrp * nM * nN; const long L = (long)i * G + c; if (L >= nmain + ntail) return false;
        if (L >= nmain) { const int t = (int)L - nmain; u.pm = tailM0 + t / tailNn; u.pn = tailN0 + t % tailNn; u.ex = u.pn; return true; }
        int wg = (int)L; { const int q = nmain / NXCD, r = nmain % NXCD, xcd = wg % NXCD, off = wg / NXCD; wg = (xcd < r ? xcd * (q + 1) : r * (q + 1) + (xcd - r) * q) + off; }
        const int per = nM * nN, grp = wg / per, w2 = wg % per;
        const int nig = WGM * nN, gid = w2 / nig, fm = gid * WGM, gsz = (nM - fm) < WGM ? (nM - fm) : WGM;
        const int pml = fm + ((w2 % nig) % gsz), pnl = (w2 % nig) / gsz;
        u.pm = grp * aM + pml; u.pn = grp * aN + pnl; u.ex = pnl; return true;
    }
    __device__ __forceinline__ void a_ready(const Unit&) const {}
    __device__ __forceinline__ void done(const Unit&) const {}
};

struct EpiBf16 {
    static constexpr bool PERM = true, AFTER_DRAIN = false;
    bf16_t* O; int ldc; const float* bias; int q_lo, q_hi;
    __device__ __forceinline__ void operator()(const f32x4 (&acc)[2][2][4][2], const Unit& u, int wr, int wc, int fr, int fq) const {
        const int row0 = u.pm * BM + wr * 64 + fr; const int col0 = u.ex * BM + wc * 32 + 8 * fq;
        const float sc = (u.ex >= q_lo && u.ex < q_hi) ? 0.125f : 1.f;
        f32x4 bv[2][2];
#pragma unroll
        for (int bj = 0; bj < 2; ++bj)
#pragma unroll
            for (int n = 0; n < 2; ++n) bv[bj][n] = bias ? *(const f32x4*)(bias + col0 + bj * HALF + 4 * n) : (f32x4){0.f, 0.f, 0.f, 0.f};
#pragma unroll
        for (int ai = 0; ai < 2; ++ai)
#pragma unroll
            for (int m = 0; m < 4; ++m) { bf16_t* rowp = O + (size_t)(row0 + ai * HALF + m * 16) * ldc + col0;
#pragma unroll
                for (int bj = 0; bj < 2; ++bj) { f32x4 v0 = (acc[ai][bj][m][0] + bv[bj][0]) * sc, v1 = (acc[ai][bj][m][1] + bv[bj][1]) * sc;
                    u32x4 w; w.x = cvt_pk_bf16(v0[0], v0[1]); w.y = cvt_pk_bf16(v0[2], v0[3]); w.z = cvt_pk_bf16(v1[0], v1[1]); w.w = cvt_pk_bf16(v1[2], v1[3]);
                    *(u32x4*)(rowp + bj * HALF) = w; } }
    }
};
struct EpiF32 {
    static constexpr bool PERM = true, AFTER_DRAIN = false;
    float* O; int ldc; const float* bias;
    __device__ __forceinline__ void operator()(const f32x4 (&acc)[2][2][4][2], const Unit& u, int wr, int wc, int fr, int fq) const {
        const int row0 = u.pm * BM + wr * 64 + fr; const int col0 = u.ex * BM + wc * 32 + 8 * fq;
        f32x4 bv[2][2];
#pragma unroll
        for (int bj = 0; bj < 2; ++bj)
#pragma unroll
            for (int n = 0; n < 2; ++n) bv[bj][n] = *(const f32x4*)(bias + col0 + bj * HALF + 4 * n);
#pragma unroll
        for (int ai = 0; ai < 2; ++ai)
#pragma unroll
            for (int m = 0; m < 4; ++m) { float* rowp = O + (size_t)(row0 + ai * HALF + m * 16) * ldc + col0;
#pragma unroll
                for (int bj = 0; bj < 2; ++bj) { *(f32x4*)(rowp + bj * HALF) = acc[ai][bj][m][0] + bv[bj][0]; *(f32x4*)(rowp + bj * HALF + 4) = acc[ai][bj][m][1] + bv[bj][1]; } }
    }
};
struct EpiSwiglu {
    static constexpr bool PERM = true, AFTER_DRAIN = false;
    bf16_t* O; int ldc;
    __device__ __forceinline__ void operator()(const f32x4 (&acc)[2][2][4][2], const Unit& u, int wr, int wc, int fr, int fq) const {
        const int row0 = u.pm * BM + wr * 64 + fr; const int col0 = u.ex * HALF + wc * 32 + 8 * fq;
#pragma unroll
        for (int ai = 0; ai < 2; ++ai)
#pragma unroll
            for (int m = 0; m < 4; ++m) { bf16_t* rowp = O + (size_t)(row0 + ai * HALF + m * 16) * ldc + col0;
                float r[8];
#pragma unroll
                for (int n = 0; n < 2; ++n)
#pragma unroll
                    for (int j = 0; j < 4; ++j) { const float a = acc[ai][0][m][n][j], b = acc[ai][1][m][n][j]; r[4 * n + j] = a * __builtin_amdgcn_rcpf(1.f + __builtin_amdgcn_exp2f(-1.4426950408889634f * a)) * b; }
                u32x4 w; w.x = cvt_pk_bf16(r[0], r[1]); w.y = cvt_pk_bf16(r[2], r[3]); w.z = cvt_pk_bf16(r[4], r[5]); w.w = cvt_pk_bf16(r[6], r[7]);
                *(u32x4*)rowp = w; }
    }
};

template <class Epi, class Sched, bool ALIGN_EPI = false, bool SP2 = false, bool GATHER = false>
__device__ __forceinline__ void gemm_phase(PG8_LAS unsigned char* lds, const Gemm g, const Sched& S, const Epi& E, const int tid, const int* __restrict__ rowlist = nullptr) {
    const int wid = __builtin_amdgcn_readfirstlane(tid >> 6), lane = tid & 63, wr = wid >> 2, wc = wid & 3, fr = lane & 15, fq = lane >> 4;
    const int K = g.K, nt = K / BK;
    unsigned voffA[2], voffB[2];
#pragma unroll
    for (int i = 0; i < 2; ++i) { int R, C; stage_rc(tid * 16 + i * 8192, R, C); const int Rb = Epi::PERM ? ((R & ~31) + perm32(R & 31)) : R;
        voffA[i] = (unsigned)(R * K + C) * 2u; voffB[i] = (unsigned)(Rb * K + C) * 2u; }
    const size_t kstep = (size_t)(BK * 2);
    const size_t hstep = (size_t)HALF * K * 2;
    const size_t tstep = 2 * hstep;
    const unsigned ldsw = (unsigned)wid * 1024u;
    const int aoff = lds_byte(wr * 64 + fr, fq * 8), boff = lds_byte(wc * 32 + fr, fq * 8);
#define PG8_SA(b, h) (((b) * 2 + (h)) * HTB)
#define PG8_SB(b, h) ((4 + (b) * 2 + (h)) * HTB)
#define PG8_STAGE(bufoff, gbase, voff) do { _Pragma("unroll") for (int _i = 0; _i < 2; ++_i) \
        __builtin_amdgcn_global_load_lds((const unsigned*)((const char*)(gbase) + (voff)[_i]), (PG8_LAS unsigned*)(lds + (bufoff) + ldsw + _i * 8192), 16, 0, 0); } while (0)
#define PG8_STAGE_G(bufoff, gbase, h, nx) do { _Pragma("unroll") for (int _i = 0; _i < 2; ++_i) \
        __builtin_amdgcn_global_load_lds((const unsigned*)((const char*)(gbase) + ((nx) ? vgn[h][_i] : vg[h][_i])), (PG8_LAS unsigned*)(lds + (bufoff) + ldsw + _i * 8192), 16, 0, 0); } while (0)
#define PG8_STA(bufoff, base, h, vsel) do { if constexpr (GATHER) { PG8_STAGE_G(bufoff, base, h, vsel); } else { PG8_STAGE(bufoff, (base) + (h) * hstep, voffA); } } while (0)
#define PG8_LOADVG(v, pm_) do { _Pragma("unroll") for (int _i = 0; _i < 2; ++_i) { int _R, _C; stage_rc(tid * 16 + _i * 8192, _R, _C); _Pragma("unroll") for (int _h = 0; _h < 2; ++_h) \
        (v)[_h][_i] = (unsigned)rowlist[(pm_) * BM + _h * HALF + _R] * (unsigned)(K * 2) + (unsigned)_C * 2u; } } while (0)
#define PG8_LDA(dst, b, h) do { _Pragma("unroll") for (int m = 0; m < 4; ++m) _Pragma("unroll") for (int k = 0; k < 2; ++k) dst[m][k] = *(const PG8_LAS bf16x8*)(lds + PG8_SA(b, h) + aoff + m * 2048 + k * 1024); } while (0)
#define PG8_LDB(dst, b, h) do { _Pragma("unroll") for (int n = 0; n < 2; ++n) _Pragma("unroll") for (int k = 0; k < 2; ++k) dst[n][k] = *(const PG8_LAS bf16x8*)(lds + PG8_SB(b, h) + boff + n * 2048 + k * 1024); } while (0)
#define PG8_MMA(ai, bj, At, Bt) do { __builtin_amdgcn_s_setprio(1); _Pragma("unroll") for (int m = 0; m < 4; ++m) _Pragma("unroll") for (int n = 0; n < 2; ++n) _Pragma("unroll") for (int k = 0; k < 2; ++k) \
        acc[ai][bj][m][n] = __builtin_amdgcn_mfma_f32_16x16x32_bf16(Bt[n][k], At[m][k], acc[ai][bj][m][n], 0, 0, 0); __builtin_amdgcn_s_setprio(0); } while (0)
#define PG8_WAIT_V(n) asm volatile("s_waitcnt vmcnt(" #n ")" ::: "memory")
#define PG8_WAIT_L(n) asm volatile("s_waitcnt lgkmcnt(" #n ")" ::: "memory")
#define PG8_BAR __builtin_amdgcn_s_barrier()
#define PG8_SCHED __builtin_amdgcn_sched_barrier(0)
    Unit cur, nxt; int ui = 0;
    if (!S.next(0, cur)) return;
    f32x4 acc[2][2][4][2];
#pragma unroll
    for (int a = 0; a < 2; ++a)
#pragma unroll
        for (int b = 0; b < 2; ++b)
#pragma unroll
            for (int m = 0; m < 4; ++m)
#pragma unroll
                for (int n = 0; n < 2; ++n) acc[a][b][m][n] = (f32x4){0.f, 0.f, 0.f, 0.f};
    bf16x8 At[4][2], B0[2][2], B1[2][2];
    const char* cA = (const char*)g.A + (GATHER ? (size_t)0 : (size_t)cur.pm * tstep);
    unsigned vg[2][2] = {{0u, 0u}, {0u, 0u}}, vgn[2][2] = {{0u, 0u}, {0u, 0u}}; if constexpr (GATHER) PG8_LOADVG(vg, cur.pm); const char* cB = (const char*)g.Bt + (size_t)cur.pn * tstep;
    S.a_ready(cur);
    if constexpr (SP2) {
        PG8_STAGE(PG8_SB(0, 0), cB, voffB); PG8_STAGE(PG8_SB(0, 1), cB + hstep, voffB); PG8_STA(PG8_SA(0, 0), cA, 0, false); PG8_STA(PG8_SA(0, 1), cA, 1, false);
        if (wr == 1) PG8_BAR;
        PG8_WAIT_V(2); PG8_BAR;
        PG8_STAGE(PG8_SB(1, 0), cB + kstep, voffB); PG8_STA(PG8_SA(1, 0), cA + kstep, 0, false); PG8_STAGE(PG8_SB(1, 1), cB + hstep + kstep, voffB);
        PG8_WAIT_V(6); PG8_BAR;
    } else {
        PG8_STAGE(PG8_SB(0, 0), cB, voffB); PG8_STA(PG8_SA(0, 0), cA, 0, false); PG8_STAGE(PG8_SB(0, 1), cB + hstep, voffB); PG8_STA(PG8_SA(0, 1), cA, 1, false);
        if (wr == 1) PG8_BAR;
        PG8_WAIT_V(4); PG8_BAR;
        PG8_STAGE(PG8_SB(1, 0), cB + kstep, voffB); PG8_STA(PG8_SA(1, 0), cA + kstep, 0, false); PG8_STAGE(PG8_SB(1, 1), cB + hstep + kstep, voffB);
        PG8_WAIT_V(6); PG8_BAR;
    }
    for (;;) {
        const bool has_next = S.next(ui + 1, nxt);
        const char* nA = (has_next && !GATHER) ? (const char*)g.A + (size_t)nxt.pm * tstep : cA;
        if constexpr (GATHER) { if (has_next) PG8_LOADVG(vgn, nxt.pm); else { _Pragma("unroll") for (int _h = 0; _h < 2; ++_h) _Pragma("unroll") for (int _i = 0; _i < 2; ++_i) vgn[_h][_i] = vg[_h][_i]; } } const char* nB = has_next ? (const char*)g.Bt + (size_t)nxt.pn * tstep : cB;
        for (int t = 0; t < nt; t += 2) {
            const bool last = (t == nt - 2);
            const char* a1 = cA + (size_t)(t + 1) * kstep;
            const char* a2 = last ? nA : cA + (size_t)(t + 2) * kstep; const char* b2 = last ? nB : cB + (size_t)(t + 2) * kstep;
            const char* a3 = a2 + kstep; const char* b3 = b2 + kstep;
            if (last && has_next) S.a_ready(nxt);
            if constexpr (SP2) {
            PG8_LDB(B0, 0, 0); PG8_LDB(B1, 0, 1); PG8_SCHED; PG8_LDA(At, 0, 0); PG8_STA(PG8_SA(1, 1), a1, 1, false);
            PG8_WAIT_V(8); PG8_WAIT_L(0); PG8_BAR; PG8_MMA(0, 0, At, B0); PG8_MMA(0, 1, At, B1); PG8_BAR; PG8_SCHED;
            PG8_LDA(At, 0, 1); PG8_STAGE(PG8_SB(0, 0), b2, voffB); PG8_STAGE(PG8_SB(0, 1), b2 + hstep, voffB); PG8_STA(PG8_SA(0, 0), a2, 0, last);
            PG8_WAIT_V(8); PG8_WAIT_L(0); PG8_BAR; PG8_MMA(1, 0, At, B0); PG8_MMA(1, 1, At, B1); PG8_BAR; PG8_SCHED;
            PG8_LDB(B0, 1, 0); PG8_LDB(B1, 1, 1); PG8_SCHED; PG8_LDA(At, 1, 0); PG8_STA(PG8_SA(0, 1), a2, 1, last);
            PG8_WAIT_V(8); PG8_WAIT_L(0); PG8_BAR; PG8_MMA(0, 0, At, B0); PG8_MMA(0, 1, At, B1); PG8_BAR; PG8_SCHED;
            PG8_LDA(At, 1, 1); PG8_STAGE(PG8_SB(1, 0), b3, voffB); PG8_STAGE(PG8_SB(1, 1), b3 + hstep, voffB); PG8_STA(PG8_SA(1, 0), a3, 0, last);
            PG8_WAIT_V(8); PG8_WAIT_L(0); PG8_BAR; PG8_MMA(1, 0, At, B0); PG8_MMA(1, 1, At, B1); PG8_BAR; PG8_SCHED;
            } else {
            PG8_LDB(B0, 0, 0); PG8_SCHED; PG8_LDA(At, 0, 0); PG8_STA(PG8_SA(1, 1), a1, 1, false);
            PG8_WAIT_L(8); PG8_BAR; PG8_WAIT_L(0); PG8_MMA(0, 0, At, B0); PG8_BAR; PG8_SCHED;
            PG8_LDB(B1, 0, 1); PG8_STAGE(PG8_SB(0, 0), b2, voffB);
            PG8_BAR; PG8_WAIT_L(0); PG8_MMA(0, 1, At, B1); PG8_BAR;
            PG8_LDA(At, 0, 1); PG8_STA(PG8_SA(0, 0), a2, 0, last);
            PG8_BAR; PG8_WAIT_L(0); PG8_MMA(1, 0, At, B0); PG8_BAR; PG8_SCHED;
            PG8_STAGE(PG8_SB(0, 1), b2 + hstep, voffB);
            PG8_WAIT_V(6); PG8_BAR; PG8_MMA(1, 1, At, B1); PG8_BAR;
            PG8_LDB(B0, 1, 0); PG8_SCHED; PG8_LDA(At, 1, 0); PG8_STA(PG8_SA(0, 1), a2, 1, last);
            PG8_WAIT_L(8); PG8_BAR; PG8_WAIT_L(0); PG8_MMA(0, 0, At, B0); PG8_BAR; PG8_SCHED;
            PG8_LDB(B1, 1, 1); PG8_STAGE(PG8_SB(1, 0), b3, voffB);
            PG8_BAR; PG8_WAIT_L(0); PG8_MMA(0, 1, At, B1); PG8_BAR;
            PG8_LDA(At, 1, 1); PG8_STA(PG8_SA(1, 0), a3, 0, last);
            PG8_BAR; PG8_WAIT_L(0); PG8_MMA(1, 0, At, B0); PG8_BAR; PG8_SCHED;
            PG8_STAGE(PG8_SB(1, 1), b3 + hstep, voffB);
            PG8_WAIT_V(6); PG8_BAR; PG8_MMA(1, 1, At, B1); PG8_BAR;
            }
        }
        if constexpr (ALIGN_EPI) { if (wr == 0) PG8_BAR; }
        if constexpr (!Epi::AFTER_DRAIN) { E(acc, cur, wr, wc, fr, fq); S.done(cur); }
        if (!has_next) break;
#pragma unroll
        for (int a = 0; a < 2; ++a)
#pragma unroll
            for (int b = 0; b < 2; ++b)
#pragma unroll
                for (int m = 0; m < 4; ++m)
#pragma unroll
                    for (int n = 0; n < 2; ++n) acc[a][b][m][n] = (f32x4){0.f, 0.f, 0.f, 0.f};
        cur = nxt; cA = nA; cB = nB; ++ui;
        _Pragma("unroll") for (int _h = 0; _h < 2; ++_h) _Pragma("unroll") for (int _i = 0; _i < 2; ++_i) vg[_h][_i] = vgn[_h][_i];
        if constexpr (ALIGN_EPI) { if (wr == 1) PG8_BAR; }
    }
    PG8_WAIT_V(0);
    if constexpr (!ALIGN_EPI) { if (wr == 0) PG8_BAR; }
    PG8_BAR;
    if constexpr (Epi::AFTER_DRAIN) { E.fused(acc, cur, wr, wc, fr, fq, lds, wid, lane); S.done(cur); }
#undef PG8_SA
#undef PG8_SB
#undef PG8_STAGE
#undef PG8_STA
#undef PG8_STAGE_G
#undef PG8_LOADVG
#undef PG8_LDA
#undef PG8_LDB
#undef PG8_MMA
#undef PG8_WAIT_V
#undef PG8_WAIT_L
#undef PG8_BAR
#undef PG8_SCHED
}
}

__device__ __forceinline__ void mod_item(const Params& p, int item, LAS float* sc, LAS float* red, int tid) {
    const int l = item / 192, n0 = (item % 192) * 32, col = tid & 31, kg = tid >> 5;
    const float* W = p.w_mod + (size_t)l * DM * 6144 + n0 + col;
    float acc[9];
#pragma unroll
    for (int r = 0; r < 9; ++r) acc[r] = 0.f;
    float w[64];
#pragma unroll
    for (int kk = 0; kk < 64; ++kk) w[kk] = __builtin_nontemporal_load(W + (size_t)(kg * 64 + kk) * 6144);
#pragma unroll
    for (int kk = 0; kk < 64; ++kk) { const int k = kg * 64 + kk;
#pragma unroll
        for (int r = 0; r < 9; ++r) acc[r] += sc[r * DM + k] * w[kk]; }
#pragma unroll
    for (int r = 0; r < 9; ++r) red[(kg * 9 + r) * 32 + col] = acc[r];
    __syncthreads();
    if (tid < 288) { const int r = tid >> 5; float s = p.b_mod[l * 6144 + n0 + col];
#pragma unroll
        for (int g = 0; g < 16; ++g) s += red[(g * 9 + r) * 32 + col];
        ((float*)(p.ws + WS_MOD))[((size_t)l * 9 + r) * 6144 + n0 + col] = s; }
    __syncthreads();
}
__device__ __forceinline__ void transpose_tile(const float* W, int N, int k0, int n0, bf16_t* dst0  , LAS float* scr, int lane) {
    const float* src = W + (size_t)k0 * N + n0 + 4 * (lane & 15);
    f32x4 v[16];
#pragma unroll
    for (int i = 0; i < 16; ++i) v[i] = __builtin_nontemporal_load((const f32x4*)(src + (size_t)(4 * i + (lane >> 4)) * N));
#pragma unroll
    for (int i = 0; i < 16; ++i) { LAS float* d = scr + (4 * i + (lane >> 4)) * 65 + 4 * (lane & 15); d[0] = v[i].x; d[1] = v[i].y; d[2] = v[i].z; d[3] = v[i].w; }
    asm volatile("s_waitcnt lgkmcnt(0)" ::: "memory");
    const int c = lane & 7;
#pragma unroll
    for (int j = 0; j < 8; ++j) { const int n = (lane >> 3) + 8 * j; const LAS float* s = scr + (8 * c) * 65 + n;
        u32x4 o; o.x = cvt_pk_bf16(s[0], s[65]); o.y = cvt_pk_bf16(s[130], s[195]); o.z = cvt_pk_bf16(s[260], s[325]); o.w = cvt_pk_bf16(s[390], s[455]);
        __builtin_nontemporal_store(o, (u32x4*)(dst0 + (size_t)n * DM + k0 + 8 * c)); }
    asm volatile("s_waitcnt lgkmcnt(0)" ::: "memory");
}
constexpr int CV_IN = 16 * 44, CV_OUT = 256, CV_E = 48 * 256, CV_IL = CV_IN + CV_OUT + CV_E;
constexpr int CV_PER = 4;
constexpr int CV_SLOTS = (256 - 792 % 256) + (256 - 288 % 256) + (256 - 1152 % 256) + (256 - 576 % 256);
static_assert(2 * (16 * 44 + 256 + 48 * 256) - CV_SLOTS * 8 * CV_PER + ((256 - 792 % 256) + (256 - 288 % 256)) * 8 * CV_PER >= (16 * 44 + 256 + 48 * 256) && 2 * (16 * 44 + 256 + 48 * 256) - CV_SLOTS * 8 * CV_PER >= 16 * 44 + 256, "deferred conversion must not postpone weights that layer 0 needs");
__host__ __device__ __forceinline__ int cv_deferred(int G) { return G == 256 ? ((256 - 792 % 256) + (256 - 288 % 256) + (256 - 1152 % 256) + (256 - 576 % 256)) * NWAVE * CV_PER : 0; }
__device__ __forceinline__ void convert_item(const Params& p, int it, LAS float* scr, int lane) {
    const int l = it / CV_IL; int r = it % CV_IL;
    if (r < CV_IN) { const int kt = r / 44, nt = r % 44;
        transpose_tile(p.w_in + (size_t)l * DM * D_IN, D_IN, kt * 64, nt * 64, (bf16_t*)(p.ws + WS_WIN) + ((size_t)l * D_IN + nt * 64) * DM, scr, lane); return; }
    r -= CV_IN;
    if (r < CV_OUT) { const int kt = r / 16, nt = r % 16;
        transpose_tile(p.w_out + (size_t)l * DM * DM, DM, kt * 64, nt * 64, (bf16_t*)(p.ws + WS_WOUT) + ((size_t)l * DM + nt * 64) * DM, scr, lane); return; }
    r -= CV_OUT;
    const int mtx = r >> 8, t = r & 255, e = mtx / 3, which = mtx % 3, kt = t >> 4, nt = t & 15, n0 = nt * 64;
    const size_t eo = ((size_t)l * NE + e) * DM * DM;
    if (which == 2) transpose_tile(p.w_down + eo, DM, kt * 64, n0, (bf16_t*)(p.ws + WS_WD) + eo + (size_t)n0 * DM, scr, lane);
    else { const int row = (n0 >> 7) * 256 + (n0 & 127) + which * 128;
        transpose_tile((which == 0 ? p.w_gate : p.w_up) + eo, DM, kt * 64, n0, (bf16_t*)(p.ws + WS_WGU) + 2 * eo + (size_t)row * DM, scr, lane); }
}
__device__ __forceinline__ void phase0(const Params& p, LAS unsigned char* lds, int bid, int G, int tid) {
    const int lane = tid & 63, wave = __builtin_amdgcn_readfirstlane(tid >> 6);
    {
        LAS float* sc = (LAS float*)lds; LAS float* red = (LAS float*)(lds + 9 * DM * 4);
        if (bid < 384) {
            for (int i = tid; i < 9 * DM; i += NTHR) { const int r = i >> 10, k = i & 1023; const float v = r < 8 ? p.c[r * DM + k] : p.c_ctx[k]; sc[i] = v / (1.f + __expf(-v)); }
            __syncthreads();
            for (int it = bid; it < 384; it += G) mod_item(p, it, sc, red, tid);
        }
        __syncthreads();
    }
    LAS float* scr = (LAS float*)(lds + wave * 16640);
    const int gw = bid * NWAVE + wave, NGW = G * NWAVE;
    const int n_now = NL * CV_IL - cv_deferred(G);
    for (int it = gw; it < n_now; it += NGW) convert_item(p, it, scr, lane);
}
__device__ __forceinline__ void convert_deferred(const Params& p, LAS unsigned char* lds, int slot, int nunits, int bid, int G, int tid) {
    if (G != 256) return;
    const int lane = tid & 63, wave = __builtin_amdgcn_readfirstlane(tid >> 6);
    const int nfull = nunits % G; if (bid < nfull) return;
    int base = NL * CV_IL - cv_deferred(G);
    if (slot >= 1) base += (G - 792 % 256) * NWAVE * CV_PER;
    if (slot >= 2) base += (G - 288 % 256) * NWAVE * CV_PER;
    if (slot >= 3) base += (G - 1152 % 256) * NWAVE * CV_PER;
    const int it0 = base + ((bid - nfull) * NWAVE + wave) * CV_PER;
    convert_item(p, it0, (LAS float*)(lds + wave * 16640), lane);
    __builtin_amdgcn_sched_barrier(0);
    convert_item(p, it0 + 1, (LAS float*)(lds + wave * 16640), lane);
    __builtin_amdgcn_sched_barrier(0);
    convert_item(p, it0 + 2, (LAS float*)(lds + wave * 16640), lane);
    __builtin_amdgcn_sched_barrier(0);
    convert_item(p, it0 + 3, (LAS float*)(lds + wave * 16640), lane);
}

__device__ __forceinline__ void phaseA(const Params& p, int bid, int G, int tid) {
    const int lane = tid & 63, gw = bid * NWAVE + __builtin_amdgcn_readfirstlane(tid >> 6), NGW = G * NWAVE;
    const float* MOD = (const float*)(p.ws + WS_MOD); bf16_t* H = (bf16_t*)(p.ws + WS_R3);
    for (int row = gw; row < T_ALL; row += NGW) {
        const float* xr = row < T_LAT ? p.x + (size_t)row * DM : p.ctx + (size_t)(row - T_LAT) * DM;
        const float* md = MOD + (size_t)mod_row_of(row) * 6144;
        f32x4 v[4], sh[4], sc[4]; ld_row_nt(v, xr, lane); ld_row(sh, md, lane); ld_row(sc, md + DM, lane);
        ln16(v, lane);
#pragma unroll
        for (int j = 0; j < 4; ++j) v[j] = v[j] * (sc[j] + 1.f) + sh[j];
        st_row_bf16(H + (size_t)row * DM, v, lane);
    }
}

constexpr int KRS = 144, VRS = 160;
constexpr int LDS_RPB = 768 * KRS, LDS_MRG = 768 * VRS;
static_assert(LDS_MRG + 4 * 64 * 18 * 4 <= LDS_BYTES && LDS_RPB + 465 * 4 <= LDS_MRG, "attention LDS map");

struct AttnGeo { int b, h, r, rs, bandbase, ctxbase; };
template <bool CTXQ> __device__ __forceinline__ AttnGeo attn_geo(int item) {
    AttnGeo q;
    if (!CTXQ) { q.b = item >> 8; q.r = (item >> 3) & 31; q.h = item & 7; int rs = q.r - 4; rs = rs < 0 ? 0 : (rs > 24 ? 24 : rs); q.rs = rs; q.bandbase = q.b * SEQ + rs * 64; q.ctxbase = T_LAT + q.b * CTXL; }
    else { q.b = item >> 4; q.h = (item >> 1) & 7; q.r = item & 1; q.rs = 0; q.bandbase = 0; q.ctxbase = T_LAT + q.b * CTXL; }
    return q;
}
template <bool CTXQ, int P0, int P1> __device__ __forceinline__ void attn_load_rows(u32x4 (&t)[P1 - P0], const bf16_t* U, const AttnGeo& q, int col, int tid) {
    const int chunk = tid & 7, r0 = tid >> 3;
#pragma unroll
    for (int ps = P0; ps < P1; ++ps) { const int row = ps * 64 + r0; const int tok = (!CTXQ && row < 512) ? q.bandbase + row : q.ctxbase + row - (CTXQ ? 0 : 512);
        t[ps - P0] = *(const u32x4*)(U + (size_t)tok * D_IN + col + q.h * 64 + chunk * 8); }
}
template <int RS, int P0, int P1> __device__ __forceinline__ void attn_store_rows(const u32x4 (&t)[P1 - P0], LAS unsigned char* lds, int tid) {
    const int chunk = tid & 7, r0 = tid >> 3;
#pragma unroll
    for (int ps = P0; ps < P1; ++ps) *(LAS u32x4*)(lds + (ps * 64 + r0) * RS + chunk * 16) = t[ps - P0];
}
template <bool CTXQ> __device__ __forceinline__ void attn_run(const Params& p, int l, int n_items, LAS unsigned char* lds, int bid, int G, int tid) {
    int it = bid; if (it >= n_items) return;
    const int wave = __builtin_amdgcn_readfirstlane(tid >> 6);
    const bf16_t* U = (const bf16_t*)(p.ws + WS_R1); bf16_t* MIX = (bf16_t*)(p.ws + WS_R3);
    const int qi = wave & 3, kh = wave >> 2;
    const bool band = (!CTXQ) && kh == 0;
    int cw = 16 * qi - 8; cw = cw < 0 ? 0 : (cw > 32 ? 32 : cw);
    const int base0 = CTXQ ? 0 : 512;
    AttnGeo cur = attn_geo<CTXQ>(it);
    constexpr int NR = CTXQ ? 4 : 12, NKP = CTXQ ? 4 : 8;
    u32x4 tk[NKP], tv[NR];
    attn_load_rows<CTXQ, 0, NKP>(tk, U, cur, OFF_K, tid);
    const int tid_outer = tid;
    for (;;) {
        int tid = tid_outer; asm volatile("" : "+v"(tid));
        const int lane = tid & 63, fr = lane & 15, g = lane >> 4, qq = fr >> 2, pp = fr & 3;
        const int qtok = CTXQ ? (cur.ctxbase + cur.r * 128 + wave * 16 + fr) : (cur.b * SEQ + cur.r * 64 + 16 * qi + fr);
        if constexpr (!CTXQ) { u32x4 tc[4]; attn_load_rows<CTXQ, 8, 12>(tc, U, cur, OFF_K, tid); attn_store_rows<KRS, 0, 8>(tk, lds, tid); attn_store_rows<KRS, 8, 12>(tc, lds, tid); }
        else attn_store_rows<KRS, 0, 4>(tk, lds, tid);
        if (!CTXQ && tid < 481) ((LAS float*)(lds + LDS_RPB))[tid < 465 ? (tid % 31) * 15 + tid / 31 : tid] = tid < 465 ? p.na_rpb[((size_t)l * 8 + cur.h) * 465 + tid] : -1e30f;
        attn_load_rows<CTXQ, 0, NR>(tv, U, cur, OFF_V, tid);
        bf16x8 qf[2];
#pragma unroll
        for (int ks = 0; ks < 2; ++ks) qf[ks] = *(const bf16x8*)(U + (size_t)qtok * D_IN + OFF_Q + cur.h * 64 + 32 * ks + 8 * g);
        __syncthreads();
        f32x4 s[16];
#pragma unroll
        for (int t = 0; t < 16; ++t) {
            const int rb = band ? ((t >> 1) * 64 + cw + 16 * (t & 1)) : (base0 + 16 * t);
            f32x4 a = {0.f, 0.f, 0.f, 0.f};
#pragma unroll
            for (int ks = 0; ks < 2; ++ks) { const bf16x8 kf = *(const LAS bf16x8*)(lds + (rb + fr) * KRS + (32 * ks + 8 * g) * 2);
                a = __builtin_amdgcn_mfma_f32_16x16x32_bf16(kf, qf[ks], a, 0, 0, 0); }
            s[t] = a;
            if ((t & 3) == 3) __builtin_amdgcn_sched_barrier(0);
        }
        if (band) {
            const LAS float* tab = (const LAS float*)(lds + LDS_RPB);
            const int qcol = 16 * qi + fr; int cs = qcol - 8; cs = cs < 0 ? 0 : (cs > 48 ? 48 : cs);
            const int drow0 = cur.rs - cur.r + 7;
#pragma unroll
            for (int tp = 0; tp < 2; ++tp)
#pragma unroll
                for (int j = 0; j < 4; ++j) { const int kcol = cw + 16 * tp + 4 * g + j; int dc = kcol - qcol + 15; dc = dc < 0 ? 0 : (dc > 30 ? 30 : dc);
                    const bool ok = kcol >= cs && kcol < cs + 16; const LAS float* bp = tab + (ok ? dc * 15 + drow0 : 465);
#pragma unroll
                    for (int w = 0; w < 8; ++w) s[2 * w + tp][j] += bp[w]; }
        }
        float m = -3e38f;
#pragma unroll
        for (int t = 0; t < 16; ++t) m = fmaxf(m, fmaxf(fmaxf(s[t][0], s[t][1]), fmaxf(s[t][2], s[t][3])));
        m = fmaxf(m, shx(m, 16, lane)); m = fmaxf(m, shx(m, 32, lane));
        float lsum = 0.f; const float mb = m * LOG2E;
        bf16x8 pf[8];
#pragma unroll
        for (int c = 0; c < 8; ++c) {
            float e[8];
#pragma unroll
            for (int j = 0; j < 4; ++j) { e[j] = __builtin_amdgcn_exp2f(s[2 * c][j] * LOG2E - mb); e[4 + j] = __builtin_amdgcn_exp2f(s[2 * c + 1][j] * LOG2E - mb); }
#pragma unroll
            for (int j = 0; j < 8; ++j) lsum += e[j];
            u32x4 w; w.x = cvt_pk_bf16(e[0], e[1]); w.y = cvt_pk_bf16(e[2], e[3]); w.z = cvt_pk_bf16(e[4], e[5]); w.w = cvt_pk_bf16(e[6], e[7]);
            pf[c] = __builtin_bit_cast(bf16x8, w);
        }
        lsum += shx(lsum, 16, lane); lsum += shx(lsum, 32, lane);
        __syncthreads();
        attn_store_rows<VRS, 0, NR>(tv, lds, tid);
        const int nit = it + G; const bool has_next = nit < n_items;
        AttnGeo nxt = cur;
        if (has_next) { nxt = attn_geo<CTXQ>(nit); attn_load_rows<CTXQ, 0, NKP>(tk, U, nxt, OFF_K, tid); }
        __syncthreads();
        f32x4 o[4];
#pragma unroll
        for (int nd = 0; nd < 4; ++nd) o[nd] = (f32x4){0.f, 0.f, 0.f, 0.f};
#pragma unroll
        for (int c = 0; c < 8; ++c) {
            const int rb0 = band ? (c * 64 + cw) : (base0 + 32 * c);
            const LAS unsigned char* a0 = lds + (rb0 + 4 * g + qq) * VRS + 8 * pp;
            const LAS unsigned char* a1 = a0 + 16 * VRS;
#pragma unroll
            for (int nd = 0; nd < 4; ++nd) {
                const s16x4 lo = __builtin_amdgcn_ds_read_tr16_b64_v4i16((LAS s16x4*)(a0 + 32 * nd));
                const s16x4 hi = __builtin_amdgcn_ds_read_tr16_b64_v4i16((LAS s16x4*)(a1 + 32 * nd));
                const bf16x8 vf = (bf16x8){lo[0], lo[1], lo[2], lo[3], hi[0], hi[1], hi[2], hi[3]};
                o[nd] = __builtin_amdgcn_mfma_f32_16x16x32_bf16(vf, pf[c], o[nd], 0, 0, 0);
            }
            if (c & 1) __builtin_amdgcn_sched_barrier(0);
        }
        bf16_t* orow = MIX + (size_t)qtok * DM + 512 + cur.h * 64 + 4 * g;
        if (CTXQ) {
            const float inv = 1.f / lsum;
#pragma unroll
            for (int nd = 0; nd < 4; ++nd) { u32x2 w; w.x = cvt_pk_bf16(o[nd][0] * inv, o[nd][1] * inv); w.y = cvt_pk_bf16(o[nd][2] * inv, o[nd][3] * inv); *(u32x2*)(orow + 16 * nd) = w; }
            __syncthreads();
        } else {
            LAS float* mg = (LAS float*)(lds + LDS_MRG) + qi * (64 * 18);
            if (kh == 1) { mg[lane] = m; mg[64 + lane] = lsum;
#pragma unroll
                for (int nd = 0; nd < 4; ++nd)
#pragma unroll
                    for (int j = 0; j < 4; ++j) mg[(2 + nd * 4 + j) * 64 + lane] = o[nd][j]; }
            __syncthreads();
            if (kh == 0) { const float m1 = mg[lane], l1 = mg[64 + lane]; const float mm = fmaxf(m, m1);
                const float a0 = __builtin_amdgcn_exp2f((m - mm) * LOG2E), a1 = __builtin_amdgcn_exp2f((m1 - mm) * LOG2E);
                const float inv = 1.f / (lsum * a0 + l1 * a1);
#pragma unroll
                for (int nd = 0; nd < 4; ++nd) { float r4[4];
#pragma unroll
                    for (int j = 0; j < 4; ++j) r4[j] = (o[nd][j] * a0 + mg[(2 + nd * 4 + j) * 64 + lane] * a1) * inv;
                    u32x2 w; w.x = cvt_pk_bf16(r4[0], r4[1]); w.y = cvt_pk_bf16(r4[2], r4[3]); *(u32x2*)(orow + 16 * nd) = w; } }
        }
        if (!has_next) break;
        cur = nxt; it = nit;
    }
    __syncthreads();
}

__device__ __forceinline__ void conv_item(const Params& p, int l, int tile, LAS unsigned char* lds, int tid) {
    const bf16_t* U = (const bf16_t*)(p.ws + WS_R1); bf16_t* MIX = (bf16_t*)(p.ws + WS_R3);
    const int t0 = tile * 64; int s0, s1;
    if (t0 < T_LAT) { s0 = t0 & ~(SEQ - 1); s1 = s0 + SEQ; } else { s0 = T_LAT + ((t0 - T_LAT) & ~(CTXL - 1)); s1 = s0 + CTXL; }
    {
        const int c8 = (tid & 31) * 8, tg = tid >> 5;
        const float* ws_ = p.w_short + (size_t)l * 3 * 256 + c8;
        float w0[8], w1[8], w2[8];
#pragma unroll
        for (int i = 0; i < 8; ++i) { w0[i] = ws_[i]; w1[i] = ws_[256 + i]; w2[i] = ws_[512 + i]; }
        float pr[6][8];
#pragma unroll
        for (int q = 0; q < 6; ++q) { const int t = t0 + tg * 4 + q - 1;
            if (t >= s0 && t < s1) { const u32x4 cgv = *(const u32x4*)(U + (size_t)t * D_IN + OFF_A + 256 + c8), xv = *(const u32x4*)(U + (size_t)t * D_IN + OFF_A + 512 + c8);
#pragma unroll
                for (int i = 0; i < 4; ++i) { pr[q][2 * i] = bflo(cgv[i]) * bflo(xv[i]); pr[q][2 * i + 1] = bfhi(cgv[i]) * bfhi(xv[i]); } }
            else {
#pragma unroll
                for (int i = 0; i < 8; ++i) pr[q][i] = 0.f; } }
#pragma unroll
        for (int q = 0; q < 4; ++q) { const int t = t0 + tg * 4 + q; const u32x4 bgv = *(const u32x4*)(U + (size_t)t * D_IN + OFF_A + c8);
            float r8[8];
#pragma unroll
            for (int i = 0; i < 4; ++i) { r8[2 * i] = bflo(bgv[i]) * (w0[2 * i] * pr[q][2 * i] + w1[2 * i] * pr[q + 1][2 * i] + w2[2 * i] * pr[q + 2][2 * i]);
                r8[2 * i + 1] = bfhi(bgv[i]) * (w0[2 * i + 1] * pr[q][2 * i + 1] + w1[2 * i + 1] * pr[q + 1][2 * i + 1] + w2[2 * i + 1] * pr[q + 2][2 * i + 1]); }
            u32x4 w; w.x = cvt_pk_bf16(r8[0], r8[1]); w.y = cvt_pk_bf16(r8[2], r8[3]); w.z = cvt_pk_bf16(r8[4], r8[5]); w.w = cvt_pk_bf16(r8[6], r8[7]);
            *(u32x4*)(MIX + (size_t)t * DM + c8) = w; }
    }
    LAS float* hs = (LAS float*)lds;
    {
        u32x4 av[6], gv[6];
#pragma unroll
        for (int k = 0; k < 6; ++k) { const int q = tid + k * NTHR; const int rr = q >> 5, c8 = (q & 31) * 8, t = t0 - 15 + rr;
            av[k] = (u32x4){0u, 0u, 0u, 0u}; gv[k] = (u32x4){0u, 0u, 0u, 0u};
            if (q < 94 * 32 && t >= s0 && t < s1) { av[k] = *(const u32x4*)(U + (size_t)t * D_IN + OFF_B + c8); gv[k] = *(const u32x4*)(U + (size_t)t * D_IN + OFF_B + 256 + c8); } }
#pragma unroll
        for (int k = 0; k < 6; ++k) { const int q = tid + k * NTHR; const int rr = q >> 5, c8 = (q & 31) * 8;
            if (q < 94 * 32) { f32x4 lo, hi;
                lo[0] = bflo(av[k][0]) * sigmoid_f(bflo(gv[k][0])); lo[1] = bfhi(av[k][0]) * sigmoid_f(bfhi(gv[k][0])); lo[2] = bflo(av[k][1]) * sigmoid_f(bflo(gv[k][1])); lo[3] = bfhi(av[k][1]) * sigmoid_f(bfhi(gv[k][1]));
                hi[0] = bflo(av[k][2]) * sigmoid_f(bflo(gv[k][2])); hi[1] = bfhi(av[k][2]) * sigmoid_f(bfhi(gv[k][2])); hi[2] = bflo(av[k][3]) * sigmoid_f(bflo(gv[k][3])); hi[3] = bfhi(av[k][3]) * sigmoid_f(bfhi(gv[k][3]));
                *(LAS f32x4*)(hs + rr * 256 + c8) = lo; *(LAS f32x4*)(hs + rr * 256 + c8 + 4) = hi; } }
    }
    __syncthreads();
    {
        const int c = tid & 255, half = __builtin_amdgcn_readfirstlane(tid >> 8);
        float w[31];
#pragma unroll
        for (int j = 0; j < 31; ++j) w[j] = p.w_conf_dw[((size_t)l * 31 + j) * 256 + c];
        float acc[32]; const float bd = p.b_conf_dw[l * 256 + c];
#pragma unroll
        for (int o = 0; o < 32; ++o) acc[o] = bd;
#pragma unroll
        for (int i = 0; i < 62; ++i) { const float v = hs[(32 * half + i) * 256 + c];
#pragma unroll
            for (int o = 0; o < 32; ++o) { if (i - o >= 0 && i - o <= 30) acc[o] += w[i - o] * v; } }
        __syncthreads();
#pragma unroll
        for (int o = 0; o < 32; ++o) hs[(32 * half + o) * 256 + c] = acc[o];
    }
    __syncthreads();
    {
        const int lane = tid & 63, wave = __builtin_amdgcn_readfirstlane(tid >> 6);
        const f32x4 gl = *(const f32x4*)(p.g_conf_ln + l * 256 + 4 * lane), bl = *(const f32x4*)(p.b_conf_ln + l * 256 + 4 * lane);
#pragma unroll
        for (int q = 0; q < 8; ++q) { const int tt = wave * 8 + q; f32x4 v = *(const LAS f32x4*)(hs + tt * 256 + 4 * lane);
            const float mean = wave_sum((v.x + v.y) + (v.z + v.w), lane) * (1.f / 256.f); v = v - mean;
            const float var = wave_sum((v.x * v.x + v.y * v.y) + (v.z * v.z + v.w * v.w), lane) * (1.f / 256.f);
            const float rstd = 1.f / sqrtf(var + LN_EPS); v = v * rstd * gl + bl;
            u32x2 w; w.x = cvt_pk_bf16(v.x * sigmoid_f(v.x), v.y * sigmoid_f(v.y)); w.y = cvt_pk_bf16(v.z * sigmoid_f(v.z), v.w * sigmoid_f(v.w));
            *(u32x2*)(MIX + (size_t)(t0 + tt) * DM + 256 + 4 * lane) = w; }
    }
    __syncthreads();
}
__device__ __forceinline__ void phaseC(const Params& p, int l, LAS unsigned char* lds, int bid, int G, int tid, int csel) {
    const int n_att = NB * 32 * 8, n_catt = (l == 0) ? NB * 8 * 2 : 0, n_conv = (l == 0 ? T_ALL : T_LAT) / 64;
    if (csel & 1) attn_run<false>(p, l, n_att, lds, bid, G, tid);
    if ((csel & 2) && n_catt) attn_run<true>(p, l, n_catt, lds, bid, G, tid);
    if (csel & 4) for (int it = G - 1 - bid; it < n_conv; it += G) conv_item(p, l, it, lds, tid);
}

template <bool L0> __device__ __forceinline__ void phaseE(const Params& p, int l, LAS unsigned char* lds, int bid, int G, int tid) {
    const int lane = tid & 63, gw = bid * NWAVE + __builtin_amdgcn_readfirstlane(tid >> 6), NGW = G * NWAVE;
    const int nrow = (l == 0) ? T_ALL : T_LAT;
    LAS float* wr = (LAS float*)lds;
    for (int q = tid; q < DM * 16; q += NTHR) { const int k = q >> 4, e = q & 15; const int j = k >> 8, ln = (k >> 2) & 63, i = k & 3;
        wr[((((j * 4 + i) * 4) + (e >> 2)) * 64 + ln) * 4 + (e & 3)] = p.w_router[(size_t)l * DM * 16 + q]; }
    __syncthreads();
    const float* MOD = (const float*)(p.ws + WS_MOD) + (size_t)l * 9 * 6144;
    const bf16_t* Y = (const bf16_t*)(p.ws + WS_R2); const bf16_t* XS = (const bf16_t*)(p.ws + WS_XB); bf16_t* XM = (bf16_t*)(p.ws + WS_XB + SZ_R3); bf16_t* HM = (bf16_t*)(p.ws + WS_R3); float* AFF = (float*)(p.ws + WS_AFF);
    const float* g1 = p.g_post1 + l * DM; const float* b1 = p.b_post1 + l * DM;
    f32x4 xf[2][4]; u32x2 xh[2][4], yh[2][4];
#define E_PREFETCH(R0) do { _Pragma("unroll") for (int r = 0; r < 2; ++r) { int row = (R0) + r * NGW; row = row < nrow ? row : (R0); \
        if (L0) { const float* xr = row < T_LAT ? p.x + (size_t)row * DM : p.ctx + (size_t)(row - T_LAT) * DM; _Pragma("unroll") for (int j = 0; j < 4; ++j) xf[r][j] = __builtin_nontemporal_load((const f32x4*)(xr + 256 * j + 4 * lane)); } \
        else { _Pragma("unroll") for (int j = 0; j < 4; ++j) xh[r][j] = __builtin_nontemporal_load((const u32x2*)(XS + (size_t)row * DM + 256 * j + 4 * lane)); } \
        _Pragma("unroll") for (int j = 0; j < 4; ++j) yh[r][j] = __builtin_nontemporal_load((const u32x2*)(Y + (size_t)row * DM + 256 * j + 4 * lane)); } } while (0)
    E_PREFETCH(gw);
    for (int row0 = gw; row0 < nrow; row0 += 2 * NGW) {
        int rows[2]; rows[0] = row0; rows[1] = (row0 + NGW < nrow) ? row0 + NGW : row0; asm volatile("" : "+s"(rows[1]));
        f32x4 v[2][4], y[2][4], t[2][4], u[2][4];
        const float* md[2];
#pragma unroll
        for (int r = 0; r < 2; ++r) { md[r] = MOD + (size_t)mod_row_of(rows[r]) * 6144; ld_row(t[r], md[r] + 2 * DM, lane);
#pragma unroll
            for (int j = 0; j < 4; ++j) { if (L0) v[r][j] = xf[r][j]; else v[r][j] = (f32x4){bflo(xh[r][j].x), bfhi(xh[r][j].x), bflo(xh[r][j].y), bfhi(xh[r][j].y)};
                y[r][j] = (f32x4){bflo(yh[r][j].x), bfhi(yh[r][j].x), bflo(yh[r][j].y), bfhi(yh[r][j].y)}; } }
        { const int nr0 = row0 + 2 * NGW < nrow ? row0 + 2 * NGW : row0; E_PREFETCH(nr0); }
#pragma unroll
        for (int r = 0; r < 2; ++r) {
#pragma unroll
            for (int j = 0; j < 4; ++j) v[r][j] = v[r][j] * ALPHA + (t[r][j] + 1.f) * y[r][j]; }
        ld_row(y[0], g1, lane); ld_row(y[1], b1, lane);
#pragma unroll
        for (int r = 0; r < 2; ++r) ln16(v[r], lane);
#pragma unroll
        for (int r = 0; r < 2; ++r) {
#pragma unroll
            for (int j = 0; j < 4; ++j) v[r][j] = v[r][j] * y[0][j] + y[1][j];
            st_row_bf16_nt(XM + (size_t)rows[r] * DM, v[r], lane);
            ld_row(t[r], md[r] + 3 * DM, lane); ld_row(u[r], md[r] + 4 * DM, lane); }
#pragma unroll
        for (int r = 0; r < 2; ++r) ln16(v[r], lane);
#pragma unroll
        for (int r = 0; r < 2; ++r) {
#pragma unroll
            for (int j = 0; j < 4; ++j) v[r][j] = v[r][j] * (u[r][j] + 1.f) + t[r][j];
            st_row_bf16(HM + (size_t)rows[r] * DM, v[r], lane); }
        typedef float f32x2 __attribute__((ext_vector_type(2)));
        f32x2 acc2[16];
#pragma unroll
        for (int e = 0; e < 16; ++e) acc2[e] = (f32x2){0.f, 0.f};
#pragma unroll
        for (int j = 0; j < 4; ++j) {
#pragma unroll
            for (int i = 0; i < 4; ++i) { const f32x2 hv = {v[0][j][i], v[1][j][i]};
#pragma unroll
                for (int eq = 0; eq < 4; ++eq) { const f32x4 w4 = *(const LAS f32x4*)(wr + (((j * 4 + i) * 4 + eq) * 64 + lane) * 4);
#pragma unroll
                    for (int ee = 0; ee < 4; ++ee) acc2[4 * eq + ee] += hv * (f32x2){w4[ee], w4[ee]}; } }
            __builtin_amdgcn_sched_barrier(0); }
#pragma unroll
        for (int r = 0; r < 2; ++r) {
            f32x4 a[4];
#pragma unroll
            for (int eq = 0; eq < 4; ++eq) a[eq] = (f32x4){acc2[4 * eq][r], acc2[4 * eq + 1][r], acc2[4 * eq + 2][r], acc2[4 * eq + 3][r]};
            float x8[8], x4[4], x2[2], x1;
            const bool b5 = (lane & 32) != 0, b4 = (lane & 16) != 0, b3 = (lane & 8) != 0, b2 = (lane & 4) != 0;
#pragma unroll
            for (int k = 0; k < 8; ++k) { const float lo = a[k >> 2][k & 3], hi = a[2 + (k >> 2)][k & 3]; x8[k] = (b5 ? hi : lo) + shx(b5 ? lo : hi, 32, lane); }
#pragma unroll
            for (int k = 0; k < 4; ++k) x4[k] = (b4 ? x8[4 + k] : x8[k]) + shx(b4 ? x8[k] : x8[4 + k], 16, lane);
#pragma unroll
            for (int k = 0; k < 2; ++k) x2[k] = (b3 ? x4[2 + k] : x4[k]) + shx(b3 ? x4[k] : x4[2 + k], 8, lane);
            x1 = (b2 ? x2[1] : x2[0]) + shx(b2 ? x2[0] : x2[1], 4, lane);
            x1 += shx(x1, 2, lane); x1 += shx(x1, 1, lane);
            float mx = x1;
            mx = fmaxf(mx, shx(mx, 4, lane)); mx = fmaxf(mx, shx(mx, 8, lane)); mx = fmaxf(mx, shx(mx, 16, lane)); mx = fmaxf(mx, shx(mx, 32, lane));
            const float ex = __expf(x1 - mx); float sum = ex;
            sum += shx(sum, 4, lane); sum += shx(sum, 8, lane); sum += shx(sum, 16, lane); sum += shx(sum, 32, lane);
            if ((lane & 3) == 0) AFF[(size_t)rows[r] * 16 + (lane >> 2)] = ex / sum;
        }
    }
    __syncthreads();
}

#undef E_PREFETCH
__device__ __forceinline__ void phaseF(const Params& p, int l, LAS unsigned char* lds, int bid, int G, int tid) {
    const float* AFF = (const float*)(p.ws + WS_AFF); int* SLOT = (int*)(p.ws + WS_SLOT);
    int* TOK = (int*)(p.ws + WS_TOK);
    LAS unsigned* red = (LAS unsigned*)lds;
    LAS unsigned* wtot = (LAS unsigned*)(lds + 64);
    const int n_lat = NB * NE, n_ctx = (l == 0) ? NB * NE : 0;
    const int lane = tid & 63, wave = __builtin_amdgcn_readfirstlane(tid >> 6);
    for (int it = bid; it < n_lat + n_ctx; it += G) {
        int b, e, ntok, cap, tokbase, dstbase;
        if (it < n_lat) { b = it >> 4; e = it & 15; ntok = SEQ; cap = CAP_L; tokbase = b * SEQ; dstbase = e * ROWS_E + b * CAP_L; }
        else { const int i2 = it - n_lat; b = i2 >> 4; e = i2 & 15; ntok = CTXL; cap = CAP_C; tokbase = T_LAT + b * CTXL; dstbase = e * ROWS_E + NB * CAP_L + b * CAP_C; }
        unsigned k[4];
#pragma unroll
        for (int i = 0; i < 4; ++i) { const int t = 4 * tid + i; k[i] = t < ntok ? __builtin_bit_cast(unsigned, AFF[(size_t)(tokbase + t) * 16 + e]) : 0u; }
        unsigned thr = 0u;
        for (int bit = 30; bit >= 0; --bit) {
            const unsigned cand = thr | (1u << bit); unsigned c = 0u;
#pragma unroll
            for (int i = 0; i < 4; ++i) c += (unsigned)__popcll(__ballot(k[i] >= cand));
            const int par = bit & 1;
            if (lane == 0) red[par * 8 + wave] = c;
            __syncthreads();
            unsigned tot = 0u;
#pragma unroll
            for (int w = 0; w < 8; ++w) tot += red[par * 8 + w];
            if (tot >= (unsigned)cap) thr = cand;
        }
        unsigned ng = 0u, ne = 0u;
#pragma unroll
        for (int i = 0; i < 4; ++i) { ng += (k[i] > thr) ? 1u : 0u; ne += (k[i] == thr) ? 1u : 0u; }
        const unsigned v = ng | (ne << 16); unsigned inc = v;
#pragma unroll
        for (int o = 1; o < 64; o <<= 1) { const unsigned u = (unsigned)__builtin_amdgcn_ds_bpermute((lane - o) << 2, (int)inc); if (lane >= o) inc += u; }
        if (lane == 63) wtot[wave] = inc;
        __syncthreads();
        unsigned off = 0u, total = 0u;
#pragma unroll
        for (int w = 0; w < 8; ++w) { const unsigned x = wtot[w]; if (w < wave) off += x; total += x; }
        const unsigned exc = off + inc - v;
        unsigned gb = exc & 0xFFFFu, eb = exc >> 16; const unsigned need = (unsigned)cap - (total & 0xFFFFu);
#pragma unroll
        for (int i = 0; i < 4; ++i) { const int t = 4 * tid + i;
            if (t < ntok) { const bool gt = k[i] > thr, eq = k[i] == thr; const bool sel = gt || (eq && eb < need);
                const unsigned slot = gb + (eb < need ? eb : need);
                SLOT[(size_t)(tokbase + t) * 16 + e] = sel ? (int)slot : -1;
                if (sel) TOK[dstbase + slot] = tokbase + t;
                gb += gt ? 1u : 0u; eb += eq ? 1u : 0u; } }
        __syncthreads();
    }
}

__device__ __forceinline__ void phaseI(const Params& p, int l, int bid, int G, int tid) {
    const int lane = tid & 63, gw = bid * NWAVE + __builtin_amdgcn_readfirstlane(tid >> 6), NGW = G * NWAVE;
    const bool last = (l == NL - 1); const int nrow = (l == 0) ? T_ALL : T_LAT;
    const float* MOD = (const float*)(p.ws + WS_MOD) + (size_t)l * 9 * 6144;
    const float* AFF = (const float*)(p.ws + WS_AFF); const int* SLOT = (const int*)(p.ws + WS_SLOT);
    const bf16_t* YE = (const bf16_t*)(p.ws + WS_R1); bf16_t* XS = (bf16_t*)(p.ws + WS_XB); const bf16_t* XM = (const bf16_t*)(p.ws + WS_XB + SZ_R3); bf16_t* H = (bf16_t*)(p.ws + WS_R3);
    const float* g2 = p.g_post2 + l * DM; const float* b2 = p.b_post2 + l * DM;
    for (int row0 = gw; row0 < nrow; row0 += 2 * NGW) {
        int rows[2]; rows[0] = row0; rows[1] = (row0 + NGW < nrow) ? row0 + NGW : row0; asm volatile("" : "+s"(rows[1]));
        int sl[2], rbase[2]; float af[2]; unsigned mask[2]; const float* md[2];
        f32x4 v[2][4], t[2][4], ym[2][4];
#pragma unroll
        for (int r = 0; r < 2; ++r) { const int row = rows[r];
            sl[r] = SLOT[(size_t)row * 16 + (lane & 15)]; af[r] = AFF[(size_t)row * 16 + (lane & 15)];
            rbase[r] = row < T_LAT ? (row >> 11) * CAP_L : NB * CAP_L + ((row - T_LAT) >> 8) * CAP_C;
            md[r] = MOD + (size_t)mod_row_of(row) * 6144;
            ld_row_bf16_nt(v[r], XM + (size_t)row * DM, lane); ld_row(t[r], md[r] + 5 * DM, lane);
#pragma unroll
            for (int j = 0; j < 4; ++j) ym[r][j] = (f32x4){0.f, 0.f, 0.f, 0.f}; }
#pragma unroll
        for (int r = 0; r < 2; ++r) mask[r] = (unsigned)(__ballot(sl[r] >= 0) & 0xFFFFull);
        while (mask[0] | mask[1]) {
            u32x2 w[2][3][4]; float aa[2][3];
#pragma unroll
            for (int r = 0; r < 2; ++r)
#pragma unroll
                for (int q = 0; q < 3; ++q) { int e = 0, s_ = 0; float a_ = 0.f;
                    if (mask[r]) { e = __builtin_ctz(mask[r]); mask[r] &= mask[r] - 1u; s_ = __builtin_amdgcn_readlane(sl[r], e); a_ = __builtin_bit_cast(float, __builtin_amdgcn_readlane(__builtin_bit_cast(int, af[r]), e)); }
                    aa[r][q] = a_; const bf16_t* yr = YE + ((size_t)e * ROWS_E + rbase[r] + s_) * DM + 4 * lane;
#pragma unroll
                    for (int j = 0; j < 4; ++j) w[r][q][j] = __builtin_nontemporal_load((const u32x2*)(yr + 256 * j)); }
#pragma unroll
            for (int r = 0; r < 2; ++r)
#pragma unroll
                for (int q = 0; q < 3; ++q)
#pragma unroll
                    for (int j = 0; j < 4; ++j) { const float a_ = aa[r][q]; const u32x2 ww = w[r][q][j];
                        ym[r][j].x += a_ * bflo(ww.x); ym[r][j].y += a_ * bfhi(ww.x); ym[r][j].z += a_ * bflo(ww.y); ym[r][j].w += a_ * bfhi(ww.y); }
        }
#pragma unroll
        for (int r = 0; r < 2; ++r) {
#pragma unroll
            for (int j = 0; j < 4; ++j) v[r][j] = v[r][j] * ALPHA + (t[r][j] + 1.f) * ym[r][j]; }
        f32x4 g4[4], b4[4]; ld_row(g4, g2, lane); ld_row(b4, b2, lane);
#pragma unroll
        for (int r = 0; r < 2; ++r) ln16(v[r], lane);
#pragma unroll
        for (int r = 0; r < 2; ++r) {
#pragma unroll
            for (int j = 0; j < 4; ++j) v[r][j] = v[r][j] * g4[j] + b4[j];
            if (last) st_row_nt(p.out + (size_t)rows[r] * DM, v[r], lane); else st_row_bf16_nt(XS + (size_t)rows[r] * DM, v[r], lane); }
        if (!last) {
#pragma unroll
            for (int r = 0; r < 2; ++r) { const float* md2 = md[r] + 9 * 6144; ld_row(t[r], md2, lane); ld_row(ym[r], md2 + DM, lane); }
#pragma unroll
            for (int r = 0; r < 2; ++r) ln16(v[r], lane);
#pragma unroll
            for (int r = 0; r < 2; ++r) {
#pragma unroll
                for (int j = 0; j < 4; ++j) v[r][j] = v[r][j] * (ym[r][j] + 1.f) + t[r][j];
                st_row_bf16(H + (size_t)rows[r] * DM, v[r], lane); }
        }
    }
}

#define XB_TMO      128
#define XB_XCNT(j)  (256  + 64 * (j))
#define XB_XSUB(j)  (1280 + 64 * (j))
#define XB_XGEN(j)  (2304 + 64 * (j))
#define XB_TOP      3328
#define XB_TOPGEN   3392
#define XCD_BAR_WORDS 3456
#define XB_SPIN_CAP (1u << 18)

__device__ __forceinline__ unsigned xb_ld(unsigned* p)              { return __hip_atomic_load(p, __ATOMIC_RELAXED, __HIP_MEMORY_SCOPE_AGENT); }
__device__ __forceinline__ unsigned xb_add(unsigned* p, unsigned v) { return __hip_atomic_fetch_add(p, v, __ATOMIC_RELAXED, __HIP_MEMORY_SCOPE_AGENT); }
__device__ __forceinline__ unsigned xb_xcc_id() { return (unsigned)__builtin_amdgcn_s_getreg((3 << 11) | 20) & 0xFu; }
#define XB_SPIN(cond, bar) do { unsigned _sp = 0; while (cond) { __builtin_amdgcn_s_sleep(1); \
    if ((++_sp & 255u) == 0u) { if (xb_ld(&(bar)[XB_TMO])) break; if (_sp > XB_SPIN_CAP) { atomicAdd(&(bar)[XB_TMO], 1u); break; } } } } while (0)

struct XcdBarrier {
    unsigned* bar; unsigned x;
    volatile LAS unsigned* st;
};

__device__ __forceinline__ XcdBarrier xcd_barrier_post(unsigned* bar, volatile LAS unsigned* st) {
    XcdBarrier b; b.bar = bar; b.x = xb_xcc_id(); b.st = st;
    if (threadIdx.x == 0) (void)xb_add(&bar[XB_XCNT(b.x)], 1u);
    return b;
}
__device__ __forceinline__ void xcd_barrier_complete(unsigned* bar, unsigned x, unsigned& nloc, unsigned& nx) {
    const unsigned G = gridDim.x * gridDim.y * gridDim.z;
    unsigned sum, cnt, mine, sp = 0u;
    for (;;) {
        sum = 0u; cnt = 0u; mine = 0u;
#pragma unroll
        for (unsigned j = 0; j < 16; ++j) { const unsigned c = xb_ld(&bar[XB_XCNT(j)]); sum += c; cnt += (c > 0u) ? 1u : 0u; mine = (j == x) ? c : mine; }
        if (sum == G) break;
        __builtin_amdgcn_s_sleep(1);
        if ((++sp & 255u) == 0u) { if (xb_ld(&bar[XB_TMO])) break; if (sp > XB_SPIN_CAP) { atomicAdd(&bar[XB_TMO], 1u); break; } }
    }
    nloc = mine > 0u ? mine : 1u; nx = cnt > 0u ? cnt : 1u;
}

__device__ __forceinline__ void xcd_barrier(const XcdBarrier& b) {
    asm volatile("s_waitcnt vmcnt(0)" ::: "memory");
    __syncthreads();
    if (threadIdx.x == 0) {
        unsigned* bar = b.bar;
        __builtin_amdgcn_s_waitcnt(0);
        unsigned nloc = b.st[0], nx = b.st[1];
        if (nloc == 0u) { xcd_barrier_complete(bar, b.x, nloc, nx); b.st[0] = nloc; b.st[1] = nx; }
        const unsigned old = xb_add(&bar[XB_XSUB(b.x)], 1u);
        const unsigned gen = old / nloc;
        if (old + 1u == (gen + 1u) * nloc) {
            __builtin_amdgcn_fence(__ATOMIC_RELEASE, "agent");
            asm volatile("s_waitcnt vmcnt(0)" ::: "memory");
            const unsigned og = xb_add(&bar[XB_TOP], 1u);
            const unsigned tg = og / nx;
            if (og + 1u == (tg + 1u) * nx) xb_add(&bar[XB_TOPGEN], 1u);
            else XB_SPIN(xb_ld(&bar[XB_TOPGEN]) == tg, bar);
            __builtin_amdgcn_fence(__ATOMIC_ACQUIRE, "agent");
            xb_add(&bar[XB_XGEN(b.x)], 1u);
            asm volatile("s_waitcnt vmcnt(0)" ::: "memory");
        } else {
            XB_SPIN(xb_ld(&bar[XB_XGEN(b.x)]) == gen, bar);
            __builtin_amdgcn_fence(__ATOMIC_ACQUIRE, "agent");
            asm volatile("s_waitcnt vmcnt(0)" ::: "memory");
        }
    }
    __syncthreads();
}

constexpr int N_PHASES = 2 + 8 * NL;
#ifndef PHM
#define PHM 1023
#endif
__global__ void __launch_bounds__(NTHR, 2) mega(Params p_in) {
    extern __shared__ __attribute__((aligned(16))) unsigned char lds_raw[];
    LAS unsigned char* lds = (LAS unsigned char*)lds_raw;
    cg::grid_group grid = cg::this_grid();
    const int bid0 = blockIdx.x, G = gridDim.x;
    const Params& p0 = p_in;
    volatile LAS unsigned* bst = (volatile LAS unsigned*)(lds + LDS_BYTES - 64);
    if (threadIdx.x < 2) bst[threadIdx.x] = 0u;
    __syncthreads();
    const XcdBarrier xbar = xcd_barrier_post((unsigned*)(p0.ws + WS_BAR), bst);
    if (p0.ph_lo < 0) grid.sync();
#ifdef DUP_T
    bool rep_done = false;
#endif
    for (int ph = p0.ph_lo; ph < p0.ph_hi;) {
        int tid = threadIdx.x; asm volatile("" : "+v"(tid));
        int bid = bid0; asm volatile("" : "+s"(bid));
        Params p = p0; { size_t zoff = 0; asm volatile("" : "+s"(zoff)); p.ws = p0.ws + zoff; }
        if (ph == 0) { if (PHM & 1) phase0(p, lds, bid, G, tid); }
        else if (ph == 1) { if (PHM & 2) phaseA(p, bid, G, tid); }
        else {
            const int l = (ph - 2) >> 3, s = (ph - 2) & 7;
            if (s == 0) { if (PHM & 4) {
                pg8::Gemm g{(const bf16_t*)(p.ws + WS_R3), (const bf16_t*)(p.ws + WS_WIN) + (size_t)l * D_IN * DM, DM};
                pg8::Sched S{1, l == 0 ? 72 : 64, 11, 0, 0, 64, 7, 4, l == 0 ? 0 : 32, G, bid};
                pg8::EpiBf16 E{(bf16_t*)(p.ws + WS_R1), D_IN, p.b_in + l * D_IN, 5, 7};
                pg8::gemm_phase<pg8::EpiBf16, pg8::Sched, true, true>(lds, g, S, E, tid);
                if (l == 0) convert_deferred(p, lds, 0, 792, bid, G, tid); }
            } else if (s == 1) { if (PHM & 8) {
#if defined(DUP_T) && defined(CSEL)
                phaseC(p, l, lds, bid, G, tid, rep_done ? CSEL : 7);
#else
                phaseC(p, l, lds, bid, G, tid, 7);
#endif
            } }
            else if (s == 2) { if (PHM & 16) {
                pg8::Gemm g{(const bf16_t*)(p.ws + WS_R3), (const bf16_t*)(p.ws + WS_WOUT) + (size_t)l * DM * DM, DM};
                pg8::Sched S{1, l == 0 ? 72 : 64, 4, 0, 0, 0, 0, 1, 0, G, bid};
                pg8::EpiBf16 E{(bf16_t*)(p.ws + WS_R2), DM, p.b_out + l * DM, 0, 0};
                pg8::gemm_phase<pg8::EpiBf16, pg8::Sched, true, true>(lds, g, S, E, tid);
                if (l == 0) convert_deferred(p, lds, 1, 288, bid, G, tid); }
            } else if (s == 3) { if (PHM & 32) { if (l == 0) phaseE<true>(p, l, lds, bid, G, tid); else phaseE<false>(p, l, lds, bid, G, tid); } }
            else if (s == 4) { if (PHM & 64) phaseF(p, l, lds, bid, G, tid); }
            else if (s == 5) { if (PHM & 128) {
                pg8::Gemm g{(const bf16_t*)(p.ws + WS_R3), (const bf16_t*)(p.ws + WS_WGU) + (size_t)l * NE * 2048 * DM, DM};
                pg8::Sched S{NE, l == 0 ? 9 : 8, 8, 9, 8, 0, 0, 1, 0, G, bid};
                pg8::EpiSwiglu E{(bf16_t*)(p.ws + WS_R2), DM};
                pg8::gemm_phase<pg8::EpiSwiglu, pg8::Sched, true, true, true>(lds, g, S, E, tid, (const int*)(p.ws + WS_TOK));
                if (l == 0) convert_deferred(p, lds, 2, 1152, bid, G, tid); }
            } else if (s == 6) { if (PHM & 256) {
                pg8::Gemm g{(const bf16_t*)(p.ws + WS_R2), (const bf16_t*)(p.ws + WS_WD) + (size_t)l * NE * DM * DM, DM};
                pg8::Sched S{NE, l == 0 ? 9 : 8, 4, 9, 4, 0, 0, 1, 0, G, bid};
                pg8::EpiBf16 E{(bf16_t*)(p.ws + WS_R1), DM, nullptr, 0, 0};
                pg8::gemm_phase<pg8::EpiBf16, pg8::Sched, true, true>(lds, g, S, E, tid);
                if (l == 0) convert_deferred(p, lds, 3, 576, bid, G, tid); }
            } else { if (PHM & 512) phaseI(p, l, bid, G, tid); }
        }
        bool advance = true;
#ifdef DUP_T
        { const int ty = ph < 2 ? ph : 2 + ((ph - 2) & 7), ly = ph < 2 ? 0 : (ph - 2) >> 3;
          if (ty == DUP_T && (DUP_L < 0 || ly == DUP_L) && !rep_done) { rep_done = true; advance = false; } else rep_done = false; }
#endif
        if (!advance || ph + 1 < p0.ph_hi) xcd_barrier(xbar);
#ifdef DUP_SYNC
        if (ph + 1 < p0.ph_hi) { xcd_barrier(xbar); xcd_barrier(xbar); }
#endif
        if (advance) ++ph;
    }
}

extern "C" void kernel_launch(void* const* d_in, const int* in_sizes, int n_in, void* d_out, int out_size, void* d_ws, size_t ws_size, hipStream_t stream) {
    static int grid = 0;
    if (grid == 0) {
        if (n_in != 24 || ws_size < WS_END) { fprintf(stderr, "kernel_launch: need 24 inputs and %zu bytes of workspace (got %d, %zu)\n", (size_t)WS_END, n_in, ws_size); grid = -1; return; }
        int dev = 0, cus = 0, per_cu = 0;
        hipGetDevice(&dev); hipDeviceGetAttribute(&cus, hipDeviceAttributeMultiprocessorCount, dev);
        if (hipFuncSetAttribute((const void*)mega, hipFuncAttributeMaxDynamicSharedMemorySize, LDS_BYTES) != hipSuccess) { fprintf(stderr, "kernel_launch: hipFuncSetAttribute failed\n"); grid = -1; return; }
        if (hipOccupancyMaxActiveBlocksPerMultiprocessor(&per_cu, (const void*)mega, NTHR, LDS_BYTES) != hipSuccess || per_cu < 1) { fprintf(stderr, "kernel_launch: occupancy query says %d blocks per CU\n", per_cu); per_cu = 1; }
        (void)hipGetLastError();
        grid = cus * 1;
    }
    if (grid < 0) return;
    Params p{};
    const float** f = (const float**)&p;
    for (int i = 0; i < 24; ++i) f[i] = (const float*)d_in[i];
    p.out = (float*)d_out; p.ws = (unsigned char*)d_ws;
    if (hipMemsetAsync((char*)d_ws + WS_BAR, 0, 16384, stream) != hipSuccess) { fprintf(stderr, "kernel_launch: memset of the barrier words failed\n"); return; }
#if MULTI
    for (int ph = 0; ph < N_PHASES; ++ph) { p.ph_lo = ph; p.ph_hi = ph + 1; hipLaunchKernelGGL(mega, dim3(grid), dim3(NTHR), LDS_BYTES, stream, p); }
#else
    p.ph_lo = 0; p.ph_hi = N_PHASES;
    void* args[] = {&p};
    hipError_t e = hipLaunchCooperativeKernel((const void*)mega, dim3(grid), dim3(NTHR), args, LDS_BYTES, stream);
    if (e != hipSuccess) fprintf(stderr, "cooperative launch failed: %s (grid %d)\n", hipGetErrorString(e), grid);
#endif
}
```

```cpp
#include <hip/hip_runtime.h>
#include <hip/hip_cooperative_groups.h>
#include <cstdio>
#include <cstdint>
namespace cg = cooperative_groups;

#ifndef MULTI
#define MULTI 0
#endif

#define LAS __attribute__((address_space(3)))
#define PG8_LAS __attribute__((address_space(3)))
typedef unsigned short bf16_t;
typedef short bf16x8 __attribute__((ext_vector_type(8)));
typedef short s16x4 __attribute__((ext_vector_type(4)));
typedef float f32x4 __attribute__((ext_vector_type(4)));
typedef unsigned u32x4 __attribute__((ext_vector_type(4)));
typedef unsigned u32x2 __attribute__((ext_vector_type(2)));

constexpr int DM = 1024, NB = 8, SEQ = 2048, CTXL = 256, NL = 2;
constexpr int T_LAT = NB * SEQ, T_CTX = NB * CTXL, T_ALL = T_LAT + T_CTX;
constexpr int D_IN = 2816, OFF_A = 0, OFF_B = 768, OFF_Q = 1280, OFF_K = 1792, OFF_V = 2304;
constexpr int NE = 16, CAP_L = 256, CAP_C = 32, ROWS_E = NB * CAP_L + NB * CAP_C;
constexpr float LN_EPS = 1e-5f;
constexpr float ALPHA = 1.4142135623730951f;
constexpr float LOG2E = 1.4426950408889634f;
constexpr int NTHR = 512, NWAVE = 8;
constexpr int LDS_BYTES = 147456;

constexpr size_t SZ_WIN = (size_t)NL * D_IN * DM * 2, SZ_WOUT = (size_t)NL * DM * DM * 2, SZ_WGU = (size_t)NL * NE * 2048 * DM * 2, SZ_WD = (size_t)NL * NE * DM * DM * 2;
constexpr size_t SZ_MOD = (size_t)NL * 9 * 6144 * 4, SZ_AFF = (size_t)T_ALL * 16 * 4;
constexpr size_t SZ_R3 = (size_t)T_ALL * DM * 2, SZ_R1 = (size_t)T_ALL * D_IN * 2, SZ_R2 = (size_t)T_ALL * DM * 4, SZ_XB = (size_t)T_ALL * DM * 4;
constexpr size_t WS_WIN = 0, WS_WOUT = WS_WIN + SZ_WIN, WS_WGU = WS_WOUT + SZ_WOUT, WS_WD = WS_WGU + SZ_WGU, WS_MOD = WS_WD + SZ_WD;
constexpr size_t WS_AFF = WS_MOD + SZ_MOD, WS_SLOT = WS_AFF + SZ_AFF, WS_R3 = WS_SLOT + SZ_AFF, WS_R1 = WS_R3 + SZ_R3, WS_R2 = WS_R1 + SZ_R1, WS_XB = WS_R2 + SZ_R2, WS_BAR = WS_XB + SZ_XB, WS_TOK = WS_BAR + 16384, WS_END = WS_TOK + (size_t)NE * ROWS_E * 4;
static_assert(WS_END <= (size_t)536870912, "workspace map exceeds 512 MiB");
static_assert((size_t)NE * ROWS_E * DM * 2 <= SZ_R1 && (size_t)NE * ROWS_E * DM * 2 <= SZ_R2, "MoE buffers fit their overlays");

struct Params {
    const float *x, *c, *ctx, *c_ctx, *w_mod, *b_mod, *w_in, *b_in, *w_short, *w_conf_dw, *b_conf_dw, *g_conf_ln, *b_conf_ln, *na_rpb, *w_out, *b_out,
                *g_post1, *b_post1, *w_router, *w_gate, *w_up, *w_down, *g_post2, *b_post2;
    float* out; unsigned char* ws; int ph_lo, ph_hi;
};

__device__ __forceinline__ unsigned cvt_pk_bf16(float lo, float hi) { unsigned r; asm volatile("v_cvt_pk_bf16_f32 %0, %1, %2" : "=v"(r) : "v"(lo), "v"(hi)); return r; }
__device__ __forceinline__ float bflo(unsigned u) { return __builtin_bit_cast(float, u << 16); }
__device__ __forceinline__ float bfhi(unsigned u) { return __builtin_bit_cast(float, u & 0xffff0000u); }
__device__ __forceinline__ float shx(float v, int o, int lane) { return __builtin_bit_cast(float, __builtin_amdgcn_ds_bpermute((lane ^ o) << 2, __builtin_bit_cast(int, v))); }
__device__ __forceinline__ float wave_sum_bp(float v, int lane) {
#pragma unroll
    for (int o = 1; o < 64; o <<= 1) v += shx(v, o, lane);
    return v;
}
__device__ __forceinline__ float wave_sum(float v, int lane) {
    (void)lane;
#define DPPF(x, ctrl, rmask) __builtin_bit_cast(float, __builtin_amdgcn_update_dpp(0, __builtin_bit_cast(int, (x)), (ctrl), (rmask), 0xf, false))
    v += DPPF(v, 0xB1, 0xf);
    v += DPPF(v, 0x4E, 0xf);
    v += DPPF(v, 0x141, 0xf);
    v += DPPF(v, 0x140, 0xf);
    v += DPPF(v, 0x142, 0xa);
    v += DPPF(v, 0x143, 0xc);
#undef DPPF
    return __builtin_bit_cast(float, __builtin_amdgcn_readlane(__builtin_bit_cast(int, v), 63));
}
__device__ __forceinline__ float sigmoid_f(float x) { return __builtin_amdgcn_rcpf(1.f + __builtin_amdgcn_exp2f(-LOG2E * x)); }
__device__ __forceinline__ void ln16(f32x4 (&v)[4], int lane) {
    float s = 0.f;
#pragma unroll
    for (int j = 0; j < 4; ++j) s += (v[j].x + v[j].y) + (v[j].z + v[j].w);
    const float mean = wave_sum(s, lane) * (1.f / DM); float s2 = 0.f;
#pragma unroll
    for (int j = 0; j < 4; ++j) { v[j] = v[j] - mean; s2 += (v[j].x * v[j].x + v[j].y * v[j].y) + (v[j].z * v[j].z + v[j].w * v[j].w); }
    const float rstd = 1.f / sqrtf(wave_sum(s2, lane) * (1.f / DM) + LN_EPS);
#pragma unroll
    for (int j = 0; j < 4; ++j) v[j] = v[j] * rstd;
}
__device__ __forceinline__ void ld_row(f32x4 (&v)[4], const float* row, int lane) {
#pragma unroll
    for (int j = 0; j < 4; ++j) v[j] = *(const f32x4*)(row + 256 * j + 4 * lane);
}
__device__ __forceinline__ void ld_row_bf16(f32x4 (&v)[4], const bf16_t* row, int lane) {
#pragma unroll
    for (int j = 0; j < 4; ++j) { const u32x2 w = *(const u32x2*)(row + 256 * j + 4 * lane); v[j] = (f32x4){bflo(w.x), bfhi(w.x), bflo(w.y), bfhi(w.y)}; }
}
__device__ __forceinline__ void ld_row_nt(f32x4 (&v)[4], const float* row, int lane) {
#pragma unroll
    for (int j = 0; j < 4; ++j) v[j] = __builtin_nontemporal_load((const f32x4*)(row + 256 * j + 4 * lane));
}
__device__ __forceinline__ void ld_row_bf16_nt(f32x4 (&v)[4], const bf16_t* row, int lane) {
#pragma unroll
    for (int j = 0; j < 4; ++j) { const u32x2 w = __builtin_nontemporal_load((const u32x2*)(row + 256 * j + 4 * lane)); v[j] = (f32x4){bflo(w.x), bfhi(w.x), bflo(w.y), bfhi(w.y)}; }
}
__device__ __forceinline__ void st_row_nt(float* row, const f32x4 (&v)[4], int lane) {
#pragma unroll
    for (int j = 0; j < 4; ++j) __builtin_nontemporal_store(v[j], (f32x4*)(row + 256 * j + 4 * lane));
}
__device__ __forceinline__ void st_row_bf16_nt(bf16_t* row, const f32x4 (&v)[4], int lane) {
#pragma unroll
    for (int j = 0; j < 4; ++j) { u32x2 w; w.x = cvt_pk_bf16(v[j].x, v[j].y); w.y = cvt_pk_bf16(v[j].z, v[j].w); __builtin_nontemporal_store(w, (u32x2*)(row + 256 * j + 4 * lane)); }
}
__device__ __forceinline__ void st_row(float* row, const f32x4 (&v)[4], int lane) {
#pragma unroll
    for (int j = 0; j < 4; ++j) *(f32x4*)(row + 256 * j + 4 * lane) = v[j];
}
__device__ __forceinline__ void st_row_bf16(bf16_t* row, const f32x4 (&v)[4], int lane) {
#pragma unroll
    for (int j = 0; j < 4; ++j) { u32x2 w; w.x = cvt_pk_bf16(v[j].x, v[j].y); w.y = cvt_pk_bf16(v[j].z, v[j].w); *(u32x2*)(row + 256 * j + 4 * lane) = w; }
}
__device__ __forceinline__ int mod_row_of(int row) { return row < T_LAT ? (row >> 11) : 8; }

namespace pg8 {
constexpr int BM = 256, BK = 64, HALF = 128, HTB = HALF * BK * 2, NXCD = 8, WGM = 4;
__host__ __device__ __forceinline__ int lds_byte(int r, int c) { const int st = (r >> 4) * 2 + (c >> 5), rr = r & 15, cc = c & 31, ob = rr * 64 + cc * 2; return st * 1024 + (ob ^ (((ob >> 9) & 1) << 5)); }
__host__ __device__ __forceinline__ void stage_rc(int b, int& R, int& C) { const int st = b / 1024, sb = b % 1024, swz = sb ^ (((sb >> 9) & 1) << 5); R = (st >> 1) * 16 + swz / 64; C = (st & 1) * 32 + (swz % 64) / 2; }
__host__ __device__ __forceinline__ int perm32(int rho) { const int n = rho >> 4, i = rho & 15; return 8 * (i >> 2) + 4 * n + (i & 3); }

struct Unit { int pm, pn, ex; };
struct Gemm { const bf16_t* A; const bf16_t* Bt; int K; };

struct Sched {
    int ngrp, nM, nN, aM, aN, tailM0, tailN0, tailNn, ntail, G, c;
    __device__ __forceinline__ bool next(int i, Unit& u) const {
        const int nmain = ngrp * nM * nN; const long L = (long)i * G + c; if (L >= nmain + ntail) return false;
        if (L >= nmain) { const int t = (int)L - nmain; u.pm = tailM0 + t / tailNn; u.pn = tailN0 + t % tailNn; u.ex = u.pn; return true; }
        int wg = (int)L; { const int q = nmain / NXCD, r = nmain % NXCD, xcd = wg % NXCD, off = wg / NXCD; wg = (xcd < r ? xcd * (q + 1) : r * (q + 1) + (xcd - r) * q) + off; }
        const int per = nM * nN, grp = wg / per, w2 = wg % per;
        const int nig = WGM * nN, gid = w2 / nig, fm = gid * WGM, gsz = (nM - fm) < WGM ? (nM - fm) : WGM;
        const int pml = fm + ((w2 % nig) % gsz), pnl = (w2 % nig) / gsz;
        u.pm = grp * aM + pml; u.pn = grp * aN + pnl; u.ex = pnl; return true;
    }
    __device__ __forceinline__ void a_ready(const Unit&) const {}
    __device__ __forceinline__ void done(const Unit&) const {}
};

struct EpiBf16 {
    static constexpr bool PERM = true, AFTER_DRAIN = false;
    bf16_t* O; int ldc; const float* bias; int q_lo, q_hi;
    __device__ __forceinline__ void operator()(const f32x4 (&acc)[2][2][4][2], const Unit& u, int wr, int wc, int fr, int fq) const {
        const int row0 = u.pm * BM + wr * 64 + fr; const int col0 = u.ex * BM + wc * 32 + 8 * fq;
        const float sc = (u.ex >= q_lo && u.ex < q_hi) ? 0.125f : 1.f;
        f32x4 bv[2][2];
#pragma unroll
        for (int bj = 0; bj < 2; ++bj)
#pragma unroll
            for (int n = 0; n < 2; ++n) bv[bj][n] = bias ? *(const f32x4*)(bias + col0 + bj * HALF + 4 * n) : (f32x4){0.f, 0.f, 0.f, 0.f};
#pragma unroll
        for (int ai = 0; ai < 2; ++ai)
#pragma unroll
            for (int m = 0; m < 4; ++m) { bf16_t* rowp = O + (size_t)(row0 + ai * HALF + m * 16) * ldc + col0;
#pragma unroll
                for (int bj = 0; bj < 2; ++bj) { f32x4 v0 = (acc[ai][bj][m][0] + bv[bj][0]) * sc, v1 = (acc[ai][bj][m][1] + bv[bj][1]) * sc;
                    u32x4 w; w.x = cvt_pk_bf16(v0[0], v0[1]); w.y = cvt_pk_bf16(v0[2], v0[3]); w.z = cvt_pk_bf16(v1[0], v1[1]); w.w = cvt_pk_bf16(v1[2], v1[3]);
                    *(u32x4*)(rowp + bj * HALF) = w; } }
    }
};
struct EpiF32 {
    static constexpr bool PERM = true, AFTER_DRAIN = false;
    float* O; int ldc; const float* bias;
    __device__ __forceinline__ void operator()(const f32x4 (&acc)[2][2][4][2], const Unit& u, int wr, int wc, int fr, int fq) const {
        const int row0 = u.pm * BM + wr * 64 + fr; const int col0 = u.ex * BM + wc * 32 + 8 * fq;
        f32x4 bv[2][2];
#pragma unroll
        for (int bj = 0; bj < 2; ++bj)
#pragma unroll
            for (int n = 0; n < 2; ++n) bv[bj][n] = *(const f32x4*)(bias + col0 + bj * HALF + 4 * n);
#pragma unroll
        for (int ai = 0; ai < 2; ++ai)
#pragma unroll
            for (int m = 0; m < 4; ++m) { float* rowp = O + (size_t)(row0 + ai * HALF + m * 16) * ldc + col0;
#pragma unroll
                for (int bj = 0; bj < 2; ++bj) { *(f32x4*)(rowp + bj * HALF) = acc[ai][bj][m][0] + bv[bj][0]; *(f32x4*)(rowp + bj * HALF + 4) = acc[ai][bj][m][1] + bv[bj][1]; } }
    }
};
struct EpiSwiglu {
    static constexpr bool PERM = true, AFTER_DRAIN = false;
    bf16_t* O; int ldc;
    __device__ __forceinline__ void operator()(const f32x4 (&acc)[2][2][4][2], const Unit& u, int wr, int wc, int fr, int fq) const {
        const int row0 = u.pm * BM + wr * 64 + fr; const int col0 = u.ex * HALF + wc * 32 + 8 * fq;
#pragma unroll
        for (int ai = 0; ai < 2; ++ai)
#pragma unroll
            for (int m = 0; m < 4; ++m) { bf16_t* rowp = O + (size_t)(row0 + ai * HALF + m * 16) * ldc + col0;
                float r[8];
#pragma unroll
                for (int n = 0; n < 2; ++n)
#pragma unroll
                    for (int j = 0; j < 4; ++j) { const float a = acc[ai][0][m][n][j], b = acc[ai][1][m][n][j]; r[4 * n + j] = a * __builtin_amdgcn_rcpf(1.f + __builtin_amdgcn_exp2f(-1.4426950408889634f * a)) * b; }
                u32x4 w; w.x = cvt_pk_bf16(r[0], r[1]); w.y = cvt_pk_bf16(r[2], r[3]); w.z = cvt_pk_bf16(r[4], r[5]); w.w = cvt_pk_bf16(r[6], r[7]);
                *(u32x4*)rowp = w; }
    }
};

template <class Epi, class Sched, bool ALIGN_EPI = false, bool SP2 = false, bool GATHER = false>
__device__ __forceinline__ void gemm_phase(PG8_LAS unsigned char* lds, const Gemm g, const Sched& S, const Epi& E, const int tid, const int* __restrict__ rowlist = nullptr) {
    const int wid = __builtin_amdgcn_readfirstlane(tid >> 6), lane = tid & 63, wr = wid >> 2, wc = wid & 3, fr = lane & 15, fq = lane >> 4;
    const int K = g.K, nt = K / BK;
    unsigned voffA[2], voffB[2];
#pragma unroll
    for (int i = 0; i < 2; ++i) { int R, C; stage_rc(tid * 16 + i * 8192, R, C); const int Rb = Epi::PERM ? ((R & ~31) + perm32(R & 31)) : R;
        voffA[i] = (unsigned)(R * K + C) * 2u; voffB[i] = (unsigned)(Rb * K + C) * 2u; }
    const size_t kstep = (size_t)(BK * 2);
    const size_t hstep = (size_t)HALF * K * 2;
    const size_t tstep = 2 * hstep;
    const unsigned ldsw = (unsigned)wid * 1024u;
    const int aoff = lds_byte(wr * 64 + fr, fq * 8), boff = lds_byte(wc * 32 + fr, fq * 8);
#define PG8_SA(b, h) (((b) * 2 + (h)) * HTB)
#define PG8_SB(b, h) ((4 + (b) * 2 + (h)) * HTB)
#define PG8_STAGE(bufoff, gbase, voff) do { _Pragma("unroll") for (int _i = 0; _i < 2; ++_i) \
        __builtin_amdgcn_global_load_lds((const unsigned*)((const char*)(gbase) + (voff)[_i]), (PG8_LAS unsigned*)(lds + (bufoff) + ldsw + _i * 8192), 16, 0, 0); } while (0)
#define PG8_STAGE_G(bufoff, gbase, h, nx) do { _Pragma("unroll") for (int _i = 0; _i < 2; ++_i) \
        __builtin_amdgcn_global_load_lds((const unsigned*)((const char*)(gbase) + ((nx) ? vgn[h][_i] : vg[h][_i])), (PG8_LAS unsigned*)(lds + (bufoff) + ldsw + _i * 8192), 16, 0, 0); } while (0)
#define PG8_STA(bufoff, base, h, vsel) do { if constexpr (GATHER) { PG8_STAGE_G(bufoff, base, h, vsel); } else { PG8_STAGE(bufoff, (base) + (h) * hstep, voffA); } } while (0)
#define PG8_LOADVG(v, pm_) do { _Pragma("unroll") for (int _i = 0; _i < 2; ++_i) { int _R, _C; stage_rc(tid * 16 + _i * 8192, _R, _C); _Pragma("unroll") for (int _h = 0; _h < 2; ++_h) \
        (v)[_h][_i] = (unsigned)rowlist[(pm_) * BM + _h * HALF + _R] * (unsigned)(K * 2) + (unsigned)_C * 2u; } } while (0)
#define PG8_LDA(dst, b, h) do { _Pragma("unroll") for (int m = 0; m < 4; ++m) _Pragma("unroll") for (int k = 0; k < 2; ++k) dst[m][k] = *(const PG8_LAS bf16x8*)(lds + PG8_SA(b, h) + aoff + m * 2048 + k * 1024); } while (0)
#define PG8_LDB(dst, b, h) do { _Pragma("unroll") for (int n = 0; n < 2; ++n) _Pragma("unroll") for (int k = 0; k < 2; ++k) dst[n][k] = *(const PG8_LAS bf16x8*)(lds + PG8_SB(b, h) + boff + n * 2048 + k * 1024); } while (0)
#define PG8_MMA(ai, bj, At, Bt) do { __builtin_amdgcn_s_setprio(1); _Pragma("unroll") for (int m = 0; m < 4; ++m) _Pragma("unroll") for (int n = 0; n < 2; ++n) _Pragma("unroll") for (int k = 0; k < 2; ++k) \
        acc[ai][bj][m][n] = __builtin_amdgcn_mfma_f32_16x16x32_bf16(Bt[n][k], At[m][k], acc[ai][bj][m][n], 0, 0, 0); __builtin_amdgcn_s_setprio(0); } while (0)
#define PG8_WAIT_V(n) asm volatile("s_waitcnt vmcnt(" #n ")" ::: "memory")
#define PG8_WAIT_L(n) asm volatile("s_waitcnt lgkmcnt(" #n ")" ::: "memory")
#define PG8_BAR __builtin_amdgcn_s_barrier()
#define PG8_SCHED __builtin_amdgcn_sched_barrier(0)
    Unit cur, nxt; int ui = 0;
    if (!S.next(0, cur)) return;
    f32x4 acc[2][2][4][2];
#pragma unroll
    for (int a = 0; a < 2; ++a)
#pragma unroll
        for (int b = 0; b < 2; ++b)
#pragma unroll
            for (int m = 0; m < 4; ++m)
#pragma unroll
                for (int n = 0; n < 2; ++n) acc[a][b][m][n] = (f32x4){0.f, 0.f, 0.f, 0.f};
    bf16x8 At[4][2], B0[2][2], B1[2][2];
    const char* cA = (const char*)g.A + (GATHER ? (size_t)0 : (size_t)cur.pm * tstep);
    unsigned vg[2][2] = {{0u, 0u}, {0u, 0u}}, vgn[2][2] = {{0u, 0u}, {0u, 0u}}; if constexpr (GATHER) PG8_LOADVG(vg, cur.pm); const char* cB = (const char*)g.Bt + (size_t)cur.pn * tstep;
    S.a_ready(cur);
    if constexpr (SP2) {
        PG8_STAGE(PG8_SB(0, 0), cB, voffB); PG8_STAGE(PG8_SB(0, 1), cB + hstep, voffB); PG8_STA(PG8_SA(0, 0), cA, 0, false); PG8_STA(PG8_SA(0, 1), cA, 1, false);
        if (wr == 1) PG8_BAR;
        PG8_WAIT_V(2); PG8_BAR;
        PG8_STAGE(PG8_SB(1, 0), cB + kstep, voffB); PG8_STA(PG8_SA(1, 0), cA + kstep, 0, false); PG8_STAGE(PG8_SB(1, 1), cB + hstep + kstep, voffB);
        PG8_WAIT_V(6); PG8_BAR;
    } else {
        PG8_STAGE(PG8_SB(0, 0), cB, voffB); PG8_STA(PG8_SA(0, 0), cA, 0, false); PG8_STAGE(PG8_SB(0, 1), cB + hstep, voffB); PG8_STA(PG8_SA(0, 1), cA, 1, false);
        if (wr == 1) PG8_BAR;
        PG8_WAIT_V(4); PG8_BAR;
        PG8_STAGE(PG8_SB(1, 0), cB + kstep, voffB); PG8_STA(PG8_SA(1, 0), cA + kstep, 0, false); PG8_STAGE(PG8_SB(1, 1), cB + hstep + kstep, voffB);
        PG8_WAIT_V(6); PG8_BAR;
    }
    for (;;) {
        const bool has_next = S.next(ui + 1, nxt);
        const char* nA = (has_next && !GATHER) ? (const char*)g.A + (size_t)nxt.pm * tstep : cA;
        if constexpr (GATHER) { if (has_next) PG8_LOADVG(vgn, nxt.pm); else { _Pragma("unroll") for (int _h = 0; _h < 2; ++_h) _Pragma("unroll") for (int _i = 0; _i < 2; ++_i) vgn[_h][_i] = vg[_h][_i]; } } const char* nB = has_next ? (const char*)g.Bt + (size_t)nxt.pn * tstep : cB;
        for (int t = 0; t < nt; t += 2) {
            const bool last = (t == nt - 2);
            const char* a1 = cA + (size_t)(t + 1) * kstep;
            const char* a2 = last ? nA : cA + (size_t)(t + 2) * kstep; const char* b2 = last ? nB : cB + (size_t)(t + 2) * kstep;
            const char* a3 = a2 + kstep; const char* b3 = b2 + kstep;
            if (last && has_next) S.a_ready(nxt);
            if constexpr (SP2) {
            PG8_LDB(B0, 0, 0); PG8_LDB(B1, 0, 1); PG8_SCHED; PG8_LDA(At, 0, 0); PG8_STA(PG8_SA(1, 1), a1, 1, false);
            PG8_WAIT_V(8); PG8_WAIT_L(0); PG8_BAR; PG8_MMA(0, 0, At, B0); PG8_MMA(0, 1, At, B1); PG8_BAR; PG8_SCHED;
            PG8_LDA(At, 0, 1); PG8_STAGE(PG8_SB(0, 0), b2, voffB); PG8_STAGE(PG8_SB(0, 1), b2 + hstep, voffB); PG8_STA(PG8_SA(0, 0), a2, 0, last);
            PG8_WAIT_V(8); PG8_WAIT_L(0); PG8_BAR; PG8_MMA(1, 0, At, B0); PG8_MMA(1, 1, At, B1); PG8_BAR; PG8_SCHED;
            PG8_LDB(B0, 1, 0); PG8_LDB(B1, 1, 1); PG8_SCHED; PG8_LDA(At, 1, 0); PG8_STA(PG8_SA(0, 1), a2, 1, last);
            PG8_WAIT_V(8); PG8_WAIT_L(0); PG8_BAR; PG8_MMA(0, 0, At, B0); PG8_MMA(0, 1, At, B1); PG8_BAR; PG8_SCHED;
            PG8_LDA(At, 1, 1); PG8_STAGE(PG8_SB(1, 0), b3, voffB); PG8_STAGE(PG8_SB(1, 1), b3 + hstep, voffB); PG8_STA(PG8_SA(1, 0), a3, 0, last);
            PG8_WAIT_V(8); PG8_WAIT_L(0); PG8_BAR; PG8_MMA(1, 0, At, B0); PG8_MMA(1, 1, At, B1); PG8_BAR; PG8_SCHED;
            } else {
            PG8_LDB(B0, 0, 0); PG8_SCHED; PG8_LDA(At, 0, 0); PG8_STA(PG8_SA(1, 1), a1, 1, false);
            PG8_WAIT_L(8); PG8_BAR; PG8_WAIT_L(0); PG8_MMA(0, 0, At, B0); PG8_BAR; PG8_SCHED;
            PG8_LDB(B1, 0, 1); PG8_STAGE(PG8_SB(0, 0), b2, voffB);
            PG8_BAR; PG8_WAIT_L(0); PG8_MMA(0, 1, At, B1); PG8_BAR;
            PG8_LDA(At, 0, 1); PG8_STA(PG8_SA(0, 0), a2, 0, last);
            PG8_BAR; PG8_WAIT_L(0); PG8_MMA(1, 0, At, B0); PG8_BAR; PG8_SCHED;
            PG8_STAGE(PG8_SB(0, 1), b2 + hstep, voffB);
            PG8_WAIT_V(6); PG8_BAR; PG8_MMA(1, 1, At, B1); PG8_BAR;
            PG8_LDB(B0, 1, 0); PG8_SCHED; PG8_LDA(At, 1, 0); PG8_STA(PG8_SA(0, 1), a2, 1, last);
            PG8_WAIT_L(8); PG8_BAR; PG8_WAIT_L(0); PG8_MMA(0, 0, At, B0); PG8_BAR; PG8_SCHED;
            PG8_LDB(B1, 1, 1); PG8_STAGE(PG8_SB(1, 0), b3, voffB);
            PG8_BAR; PG8_WAIT_L(0); PG8_MMA(0, 1, At, B1); PG8_BAR;
            PG8_LDA(At, 1, 1); PG8_STA(PG8_SA(1, 0), a3, 0, last);
            PG8_BAR; PG8_WAIT_L(0); PG8_MMA(1, 0, At, B0); PG8_BAR; PG8_SCHED;
            PG8_STAGE(PG8_SB(1, 1), b3 + hstep, voffB);
            PG8_WAIT_V(6); PG8_BAR; PG8_MMA(1, 1, At, B1); PG8_BAR;
            }
        }
        if constexpr (ALIGN_EPI) { if (wr == 0) PG8_BAR; }
        if constexpr (!Epi::AFTER_DRAIN) { E(acc, cur, wr, wc, fr, fq); S.done(cur); }
        if (!has_next) break;
#pragma unroll
        for (int a = 0; a < 2; ++a)
#pragma unroll
            for (int b = 0; b < 2; ++b)
#pragma unroll
                for (int m = 0; m < 4; ++m)
#pragma unroll
                    for (int n = 0; n < 2; ++n) acc[a][b][m][n] = (f32x4){0.f, 0.f, 0.f, 0.f};
        cur = nxt; cA = nA; cB = nB; ++ui;
        _Pragma("unroll") for (int _h = 0; _h < 2; ++_h) _Pragma("unroll") for (int _i = 0; _i < 2; ++_i) vg[_h][_i] = vgn[_h][_i];
        if constexpr (ALIGN_EPI) { if (wr == 1) PG8_BAR; }
    }
    PG8_WAIT_V(0);
    if constexpr (!ALIGN_EPI) { if (wr == 0) PG8_BAR; }
    PG8_BAR;
    if constexpr (Epi::AFTER_DRAIN) { E.fused(acc, cur, wr, wc, fr, fq, lds, wid, lane); S.done(cur); }
#undef PG8_SA
#undef PG8_SB
#undef PG8_STAGE
#undef PG8_STA
#undef PG8_STAGE_G
#undef PG8_LOADVG
#undef PG8_LDA
#undef PG8_LDB
#undef PG8_MMA
#undef PG8_WAIT_V
#undef PG8_WAIT_L
#undef PG8_BAR
#undef PG8_SCHED
}
}

__device__ __forceinline__ void mod_item(const Params& p, int item, LAS float* sc, LAS float* red, int tid) {
    const int l = item / 192, n0 = (item % 192) * 32, col = tid & 31, kg = tid >> 5;
    const float* W = p.w_mod + (size_t)l * DM * 6144 + n0 + col;
    float acc[9];
#pragma unroll
    for (int r = 0; r < 9; ++r) acc[r] = 0.f;
    float w[64];
#pragma unroll
    for (int kk = 0; kk < 64; ++kk) w[kk] = __builtin_nontemporal_load(W + (size_t)(kg * 64 + kk) * 6144);
#pragma unroll
    for (int kk = 0; kk < 64; ++kk) { const int k = kg * 64 + kk;
#pragma unroll
        for (int r = 0; r < 9; ++r) acc[r] += sc[r * DM + k] * w[kk]; }
#pragma unroll
    for (int r = 0; r < 9; ++r) red[(kg * 9 + r) * 32 + col] = acc[r];
    __syncthreads();
    if (tid < 288) { const int r = tid >> 5; float s = p.b_mod[l * 6144 + n0 + col];
#pragma unroll
        for (int g = 0; g < 16; ++g) s += red[(g * 9 + r) * 32 + col];
        ((float*)(p.ws + WS_MOD))[((size_t)l * 9 + r) * 6144 + n0 + col] = s; }
    __syncthreads();
}
__device__ __forceinline__ void transpose_tile(const float* W, int N, int k0, int n0, bf16_t* dst0  , LAS float* scr, int lane) {
    const float* src = W + (size_t)k0 * N + n0 + 4 * (lane & 15);
    f32x4 v[16];
#pragma unroll
    for (int i = 0; i < 16; ++i) v[i] = __builtin_nontemporal_load((const f32x4*)(src + (size_t)(4 * i + (lane >> 4)) * N));
#pragma unroll
    for (int i = 0; i < 16; ++i) { LAS float* d = scr + (4 * i + (lane >> 4)) * 65 + 4 * (lane & 15); d[0] = v[i].x; d[1] = v[i].y; d[2] = v[i].z; d[3] = v[i].w; }
    asm volatile("s_waitcnt lgkmcnt(0)" ::: "memory");
    const int c = lane & 7;
#pragma unroll
    for (int j = 0; j < 8; ++j) { const int n = (lane >> 3) + 8 * j; const LAS float* s = scr + (8 * c) * 65 + n;
        u32x4 o; o.x = cvt_pk_bf16(s[0], s[65]); o.y = cvt_pk_bf16(s[130], s[195]); o.z = cvt_pk_bf16(s[260], s[325]); o.w = cvt_pk_bf16(s[390], s[455]);
        __builtin_nontemporal_store(o, (u32x4*)(dst0 + (size_t)n * DM + k0 + 8 * c)); }
    asm volatile("s_waitcnt lgkmcnt(0)" ::: "memory");
}
constexpr int CV_IN = 16 * 44, CV_OUT = 256, CV_E = 48 * 256, CV_IL = CV_IN + CV_OUT + CV_E;
constexpr int CV_PER = 4;
constexpr int CV_SLOTS = (256 - 792 % 256) + (256 - 288 % 256) + (256 - 1152 % 256) + (256 - 576 % 256);
static_assert(2 * (16 * 44 + 256 + 48 * 256) - CV_SLOTS * 8 * CV_PER + ((256 - 792 % 256) + (256 - 288 % 256)) * 8 * CV_PER >= (16 * 44 + 256 + 48 * 256) && 2 * (16 * 44 + 256 + 48 * 256) - CV_SLOTS * 8 * CV_PER >= 16 * 44 + 256, "deferred conversion must not postpone weights that layer 0 needs");
__host__ __device__ __forceinline__ int cv_deferred(int G) { return G == 256 ? ((256 - 792 % 256) + (256 - 288 % 256) + (256 - 1152 % 256) + (256 - 576 % 256)) * NWAVE * CV_PER : 0; }
__device__ __forceinline__ void convert_item(const Params& p, int it, LAS float* scr, int lane) {
    const int l = it / CV_IL; int r = it % CV_IL;
    if (r < CV_IN) { const int kt = r / 44, nt = r % 44;
        transpose_tile(p.w_in + (size_t)l * DM * D_IN, D_IN, kt * 64, nt * 64, (bf16_t*)(p.ws + WS_WIN) + ((size_t)l * D_IN + nt * 64) * DM, scr, lane); return; }
    r -= CV_IN;
    if (r < CV_OUT) { const int kt = r / 16, nt = r % 16;
        transpose_tile(p.w_out + (size_t)l * DM * DM, DM, kt * 64, nt * 64, (bf16_t*)(p.ws + WS_WOUT) + ((size_t)l * DM + nt * 64) * DM, scr, lane); return; }
    r -= CV_OUT;
    const int mtx = r >> 8, t = r & 255, e = mtx / 3, which = mtx % 3, kt = t >> 4, nt = t & 15, n0 = nt * 64;
    const size_t eo = ((size_t)l * NE + e) * DM * DM;
    if (which == 2) transpose_tile(p.w_down + eo, DM, kt * 64, n0, (bf16_t*)(p.ws + WS_WD) + eo + (size_t)n0 * DM, scr, lane);
    else { const int row = (n0 >> 7) * 256 + (n0 & 127) + which * 128;
        transpose_tile((which == 0 ? p.w_gate : p.w_up) + eo, DM, kt * 64, n0, (bf16_t*)(p.ws + WS_WGU) + 2 * eo + (size_t)row * DM, scr, lane); }
}
__device__ __forceinline__ void phase0(const Params& p, LAS unsigned char* lds, int bid, int G, int tid) {
    const int lane = tid & 63, wave = __builtin_amdgcn_readfirstlane(tid >> 6);
    {
        LAS float* sc = (LAS float*)lds; LAS float* red = (LAS float*)(lds + 9 * DM * 4);
        if (bid < 384) {
            for (int i = tid; i < 9 * DM; i += NTHR) { const int r = i >> 10, k = i & 1023; const float v = r < 8 ? p.c[r * DM + k] : p.c_ctx[k]; sc[i] = v / (1.f + __expf(-v)); }
            __syncthreads();
            for (int it = bid; it < 384; it += G) mod_item(p, it, sc, red, tid);
        }
        __syncthreads();
    }
    LAS float* scr = (LAS float*)(lds + wave * 16640);
    const int gw = bid * NWAVE + wave, NGW = G * NWAVE;
    const int n_now = NL * CV_IL - cv_deferred(G);
    for (int it = gw; it < n_now; it += NGW) convert_item(p, it, scr, lane);
}
__device__ __forceinline__ void convert_deferred(const Params& p, LAS unsigned char* lds, int slot, int nunits, int bid, int G, int tid) {
    if (G != 256) return;
    const int lane = tid & 63, wave = __builtin_amdgcn_readfirstlane(tid >> 6);
    const int nfull = nunits % G; if (bid < nfull) return;
    int base = NL * CV_IL - cv_deferred(G);
    if (slot >= 1) base += (G - 792 % 256) * NWAVE * CV_PER;
    if (slot >= 2) base += (G - 288 % 256) * NWAVE * CV_PER;
    if (slot >= 3) base += (G - 1152 % 256) * NWAVE * CV_PER;
    const int it0 = base + ((bid - nfull) * NWAVE + wave) * CV_PER;
    convert_item(p, it0, (LAS float*)(lds + wave * 16640), lane);
    __builtin_amdgcn_sched_barrier(0);
    convert_item(p, it0 + 1, (LAS float*)(lds + wave * 16640), lane);
    __builtin_amdgcn_sched_barrier(0);
    convert_item(p, it0 + 2, (LAS float*)(lds + wave * 16640), lane);
    __builtin_amdgcn_sched_barrier(0);
    convert_item(p, it0 + 3, (LAS float*)(lds + wave * 16640), lane);
}

__device__ __forceinline__ void phaseA(const Params& p, int bid, int G, int tid) {
    const int lane = tid & 63, gw = bid * NWAVE + __builtin_amdgcn_readfirstlane(tid >> 6), NGW = G * NWAVE;
    const float* MOD = (const float*)(p.ws + WS_MOD); bf16_t* H = (bf16_t*)(p.ws + WS_R3);
    for (int row = gw; row < T_ALL; row += NGW) {
        const float* xr = row < T_LAT ? p.x + (size_t)row * DM : p.ctx + (size_t)(row - T_LAT) * DM;
        const float* md = MOD + (size_t)mod_row_of(row) * 6144;
        f32x4 v[4], sh[4], sc[4]; ld_row_nt(v, xr, lane); ld_row(sh, md, lane); ld_row(sc, md + DM, lane);
        ln16(v, lane);
#pragma unroll
        for (int j = 0; j < 4; ++j) v[j] = v[j] * (sc[j] + 1.f) + sh[j];
        st_row_bf16(H + (size_t)row * DM, v, lane);
    }
}

constexpr int KRS = 144, VRS = 160;
constexpr int LDS_RPB = 768 * KRS, LDS_MRG = 768 * VRS;
static_assert(LDS_MRG + 4 * 64 * 18 * 4 <= LDS_BYTES && LDS_RPB + 465 * 4 <= LDS_MRG, "attention LDS map");

struct AttnGeo { int b, h, r, rs, bandbase, ctxbase; };
template <bool CTXQ> __device__ __forceinline__ AttnGeo attn_geo(int item) {
    AttnGeo q;
    if (!CTXQ) { q.b = item >> 8; q.r = (item >> 3) & 31; q.h = item & 7; int rs = q.r - 4; rs = rs < 0 ? 0 : (rs > 24 ? 24 : rs); q.rs = rs; q.bandbase = q.b * SEQ + rs * 64; q.ctxbase = T_LAT + q.b * CTXL; }
    else { q.b = item >> 4; q.h = (item >> 1) & 7; q.r = item & 1; q.rs = 0; q.bandbase = 0; q.ctxbase = T_LAT + q.b * CTXL; }
    return q;
}
template <bool CTXQ, int P0, int P1> __device__ __forceinline__ void attn_load_rows(u32x4 (&t)[P1 - P0], const bf16_t* U, const AttnGeo& q, int col, int tid) {
    const int chunk = tid & 7, r0 = tid >> 3;
#pragma unroll
    for (int ps = P0; ps < P1; ++ps) { const int row = ps * 64 + r0; const int tok = (!CTXQ && row < 512) ? q.bandbase + row : q.ctxbase + row - (CTXQ ? 0 : 512);
        t[ps - P0] = *(const u32x4*)(U + (size_t)tok * D_IN + col + q.h * 64 + chunk * 8); }
}
template <int RS, int P0, int P1> __device__ __forceinline__ void attn_store_rows(const u32x4 (&t)[P1 - P0], LAS unsigned char* lds, int tid) {
    const int chunk = tid & 7, r0 = tid >> 3;
#pragma unroll
    for (int ps = P0; ps < P1; ++ps) *(LAS u32x4*)(lds + (ps * 64 + r0) * RS + chunk * 16) = t[ps - P0];
}
template <bool CTXQ> __device__ __forceinline__ void attn_run(const Params& p, int l, int n_items, LAS unsigned char* lds, int bid, int G, int tid) {
    int it = bid; if (it >= n_items) return;
    const int wave = __builtin_amdgcn_readfirstlane(tid >> 6);
    const bf16_t* U = (const bf16_t*)(p.ws + WS_R1); bf16_t* MIX = (bf16_t*)(p.ws + WS_R3);
    const int qi = wave & 3, kh = wave >> 2;
    const bool band = (!CTXQ) && kh == 0;
    int cw = 16 * qi - 8; cw = cw < 0 ? 0 : (cw > 32 ? 32 : cw);
    const int base0 = CTXQ ? 0 : 512;
    AttnGeo cur = attn_geo<CTXQ>(it);
    constexpr int NR = CTXQ ? 4 : 12, NKP = CTXQ ? 4 : 8;
    u32x4 tk[NKP], tv[NR];
    attn_load_rows<CTXQ, 0, NKP>(tk, U, cur, OFF_K, tid);
    const int tid_outer = tid;
    for (;;) {
        int tid = tid_outer; asm volatile("" : "+v"(tid));
        const int lane = tid & 63, fr = lane & 15, g = lane >> 4, qq = fr >> 2, pp = fr & 3;
        const int qtok = CTXQ ? (cur.ctxbase + cur.r * 128 + wave * 16 + fr) : (cur.b * SEQ + cur.r * 64 + 16 * qi + fr);
        if constexpr (!CTXQ) { u32x4 tc[4]; attn_load_rows<CTXQ, 8, 12>(tc, U, cur, OFF_K, tid); attn_store_rows<KRS, 0, 8>(tk, lds, tid); attn_store_rows<KRS, 8, 12>(tc, lds, tid); }
        else attn_store_rows<KRS, 0, 4>(tk, lds, tid);
        if (!CTXQ && tid < 481) ((LAS float*)(lds + LDS_RPB))[tid < 465 ? (tid % 31) * 15 + tid / 31 : tid] = tid < 465 ? p.na_rpb[((size_t)l * 8 + cur.h) * 465 + tid] : -1e30f;
        attn_load_rows<CTXQ, 0, NR>(tv, U, cur, OFF_V, tid);
        bf16x8 qf[2];
#pragma unroll
        for (int ks = 0; ks < 2; ++ks) qf[ks] = *(const bf16x8*)(U + (size_t)qtok * D_IN + OFF_Q + cur.h * 64 + 32 * ks + 8 * g);
        __syncthreads();
        f32x4 s[16];
#pragma unroll
        for (int t = 0; t < 16; ++t) {
            const int rb = band ? ((t >> 1) * 64 + cw + 16 * (t & 1)) : (base0 + 16 * t);
            f32x4 a = {0.f, 0.f, 0.f, 0.f};
#pragma unroll
            for (int ks = 0; ks < 2; ++ks) { const bf16x8 kf = *(const LAS bf16x8*)(lds + (rb + fr) * KRS + (32 * ks + 8 * g) * 2);
                a = __builtin_amdgcn_mfma_f32_16x16x32_bf16(kf, qf[ks], a, 0, 0, 0); }
            s[t] = a;
            if ((t & 3) == 3) __builtin_amdgcn_sched_barrier(0);
        }
        if (band) {
            const LAS float* tab = (const LAS float*)(lds + LDS_RPB);
            const int qcol = 16 * qi + fr; int cs = qcol - 8; cs = cs < 0 ? 0 : (cs > 48 ? 48 : cs);
            const int drow0 = cur.rs - cur.r + 7;
#pragma unroll
            for (int tp = 0; tp < 2; ++tp)
#pragma unroll
                for (int j = 0; j < 4; ++j) { const int kcol = cw + 16 * tp + 4 * g + j; int dc = kcol - qcol + 15; dc = dc < 0 ? 0 : (dc > 30 ? 30 : dc);
                    const bool ok = kcol >= cs && kcol < cs + 16; const LAS float* bp = tab + (ok ? dc * 15 + drow0 : 465);
#pragma unroll
                    for (int w = 0; w < 8; ++w) s[2 * w + tp][j] += bp[w]; }
        }
        float m = -3e38f;
#pragma unroll
        for (int t = 0; t < 16; ++t) m = fmaxf(m, fmaxf(fmaxf(s[t][0], s[t][1]), fmaxf(s[t][2], s[t][3])));
        m = fmaxf(m, shx(m, 16, lane)); m = fmaxf(m, shx(m, 32, lane));
        float lsum = 0.f; const float mb = m * LOG2E;
        bf16x8 pf[8];
#pragma unroll
        for (int c = 0; c < 8; ++c) {
            float e[8];
#pragma unroll
            for (int j = 0; j < 4; ++j) { e[j] = __builtin_amdgcn_exp2f(s[2 * c][j] * LOG2E - mb); e[4 + j] = __builtin_amdgcn_exp2f(s[2 * c + 1][j] * LOG2E - mb); }
#pragma unroll
            for (int j = 0; j < 8; ++j) lsum += e[j];
            u32x4 w; w.x = cvt_pk_bf16(e[0], e[1]); w.y = cvt_pk_bf16(e[2], e[3]); w.z = cvt_pk_bf16(e[4], e[5]); w.w = cvt_pk_bf16(e[6], e[7]);
            pf[c] = __builtin_bit_cast(bf16x8, w);
        }
        lsum += shx(lsum, 16, lane); lsum += shx(lsum, 32, lane);
        __syncthreads();
        attn_store_rows<VRS, 0, NR>(tv, lds, tid);
        const int nit = it + G; const bool has_next = nit < n_items;
        AttnGeo nxt = cur;
        if (has_next) { nxt = attn_geo<CTXQ>(nit); attn_load_rows<CTXQ, 0, NKP>(tk, U, nxt, OFF_K, tid); }
        __syncthreads();
        f32x4 o[4];
#pragma unroll
        for (int nd = 0; nd < 4; ++nd) o[nd] = (f32x4){0.f, 0.f, 0.f, 0.f};
#pragma unroll
        for (int c = 0; c < 8; ++c) {
            const int rb0 = band ? (c * 64 + cw) : (base0 + 32 * c);
            const LAS unsigned char* a0 = lds + (rb0 + 4 * g + qq) * VRS + 8 * pp;
            const LAS unsigned char* a1 = a0 + 16 * VRS;
#pragma unroll
            for (int nd = 0; nd < 4; ++nd) {
                const s16x4 lo = __builtin_amdgcn_ds_read_tr16_b64_v4i16((LAS s16x4*)(a0 + 32 * nd));
                const s16x4 hi = __builtin_amdgcn_ds_read_tr16_b64_v4i16((LAS s16x4*)(a1 + 32 * nd));
                const bf16x8 vf = (bf16x8){lo[0], lo[1], lo[2], lo[3], hi[0], hi[1], hi[2], hi[3]};
                o[nd] = __builtin_amdgcn_mfma_f32_16x16x32_bf16(vf, pf[c], o[nd], 0, 0, 0);
            }
            if (c & 1) __builtin_amdgcn_sched_barrier(0);
        }
        bf16_t* orow = MIX + (size_t)qtok * DM + 512 + cur.h * 64 + 4 * g;
        if (CTXQ) {
            const float inv = 1.f / lsum;
#pragma unroll
            for (int nd = 0; nd < 4; ++nd) { u32x2 w; w.x = cvt_pk_bf16(o[nd][0] * inv, o[nd][1] * inv); w.y = cvt_pk_bf16(o[nd][2] * inv, o[nd][3] * inv); *(u32x2*)(orow + 16 * nd) = w; }
            __syncthreads();
        } else {
            LAS float* mg = (LAS float*)(lds + LDS_MRG) + qi * (64 * 18);
            if (kh == 1) { mg[lane] = m; mg[64 + lane] = lsum;
#pragma unroll
                for (int nd = 0; nd < 4; ++nd)
#pragma unroll
                    for (int j = 0; j < 4; ++j) mg[(2 + nd * 4 + j) * 64 + lane] = o[nd][j]; }
            __syncthreads();
            if (kh == 0) { const float m1 = mg[lane], l1 = mg[64 + lane]; const float mm = fmaxf(m, m1);
                const float a0 = __builtin_amdgcn_exp2f((m - mm) * LOG2E), a1 = __builtin_amdgcn_exp2f((m1 - mm) * LOG2E);
                const float inv = 1.f / (lsum * a0 + l1 * a1);
#pragma unroll
                for (int nd = 0; nd < 4; ++nd) { float r4[4];
#pragma unroll
                    for (int j = 0; j < 4; ++j) r4[j] = (o[nd][j] * a0 + mg[(2 + nd * 4 + j) * 64 + lane] * a1) * inv;
                    u32x2 w; w.x = cvt_pk_bf16(r4[0], r4[1]); w.y = cvt_pk_bf16(r4[2], r4[3]); *(u32x2*)(orow + 16 * nd) = w; } }
        }
        if (!has_next) break;
        cur = nxt; it = nit;
    }
    __syncthreads();
}

__device__ __forceinline__ void conv_item(const Params& p, int l, int tile, LAS unsigned char* lds, int tid) {
    const bf16_t* U = (const bf16_t*)(p.ws + WS_R1); bf16_t* MIX = (bf16_t*)(p.ws + WS_R3);
    const int t0 = tile * 64; int s0, s1;
    if (t0 < T_LAT) { s0 = t0 & ~(SEQ - 1); s1 = s0 + SEQ; } else { s0 = T_LAT + ((t0 - T_LAT) & ~(CTXL - 1)); s1 = s0 + CTXL; }
    {
        const int c8 = (tid & 31) * 8, tg = tid >> 5;
        const float* ws_ = p.w_short + (size_t)l * 3 * 256 + c8;
        float w0[8], w1[8], w2[8];
#pragma unroll
        for (int i = 0; i < 8; ++i) { w0[i] = ws_[i]; w1[i] = ws_[256 + i]; w2[i] = ws_[512 + i]; }
        float pr[6][8];
#pragma unroll
        for (int q = 0; q < 6; ++q) { const int t = t0 + tg * 4 + q - 1;
            if (t >= s0 && t < s1) { const u32x4 cgv = *(const u32x4*)(U + (size_t)t * D_IN + OFF_A + 256 + c8), xv = *(const u32x4*)(U + (size_t)t * D_IN + OFF_A + 512 + c8);
#pragma unroll
                for (int i = 0; i < 4; ++i) { pr[q][2 * i] = bflo(cgv[i]) * bflo(xv[i]); pr[q][2 * i + 1] = bfhi(cgv[i]) * bfhi(xv[i]); } }
            else {
#pragma unroll
                for (int i = 0; i < 8; ++i) pr[q][i] = 0.f; } }
#pragma unroll
        for (int q = 0; q < 4; ++q) { const int t = t0 + tg * 4 + q; const u32x4 bgv = *(const u32x4*)(U + (size_t)t * D_IN + OFF_A + c8);
            float r8[8];
#pragma unroll
            for (int i = 0; i < 4; ++i) { r8[2 * i] = bflo(bgv[i]) * (w0[2 * i] * pr[q][2 * i] + w1[2 * i] * pr[q + 1][2 * i] + w2[2 * i] * pr[q + 2][2 * i]);
                r8[2 * i + 1] = bfhi(bgv[i]) * (w0[2 * i + 1] * pr[q][2 * i + 1] + w1[2 * i + 1] * pr[q + 1][2 * i + 1] + w2[2 * i + 1] * pr[q + 2][2 * i + 1]); }
            u32x4 w; w.x = cvt_pk_bf16(r8[0], r8[1]); w.y = cvt_pk_bf16(r8[2], r8[3]); w.z = cvt_pk_bf16(r8[4], r8[5]); w.w = cvt_pk_bf16(r8[6], r8[7]);
            *(u32x4*)(MIX + (size_t)t * DM + c8) = w; }
    }
    LAS float* hs = (LAS float*)lds;
    {
        u32x4 av[6], gv[6];
#pragma unroll
        for (int k = 0; k < 6; ++k) { const int q = tid + k * NTHR; const int rr = q >> 5, c8 = (q & 31) * 8, t = t0 - 15 + rr;
            av[k] = (u32x4){0u, 0u, 0u, 0u}; gv[k] = (u32x4){0u, 0u, 0u, 0u};
            if (q < 94 * 32 && t >= s0 && t < s1) { av[k] = *(const u32x4*)(U + (size_t)t * D_IN + OFF_B + c8); gv[k] = *(const u32x4*)(U + (size_t)t * D_IN + OFF_B + 256 + c8); } }
#pragma unroll
        for (int k = 0; k < 6; ++k) { const int q = tid + k * NTHR; const int rr = q >> 5, c8 = (q & 31) * 8;
            if (q < 94 * 32) { f32x4 lo, hi;
                lo[0] = bflo(av[k][0]) * sigmoid_f(bflo(gv[k][0])); lo[1] = bfhi(av[k][0]) * sigmoid_f(bfhi(gv[k][0])); lo[2] = bflo(av[k][1]) * sigmoid_f(bflo(gv[k][1])); lo[3] = bfhi(av[k][1]) * sigmoid_f(bfhi(gv[k][1]));
                hi[0] = bflo(av[k][2]) * sigmoid_f(bflo(gv[k][2])); hi[1] = bfhi(av[k][2]) * sigmoid_f(bfhi(gv[k][2])); hi[2] = bflo(av[k][3]) * sigmoid_f(bflo(gv[k][3])); hi[3] = bfhi(av[k][3]) * sigmoid_f(bfhi(gv[k][3]));
                *(LAS f32x4*)(hs + rr * 256 + c8) = lo; *(LAS f32x4*)(hs + rr * 256 + c8 + 4) = hi; } }
    }
    __syncthreads();
    {
        const int c = tid & 255, half = __builtin_amdgcn_readfirstlane(tid >> 8);
        float w[31];
#pragma unroll
        for (int j = 0; j < 31; ++j) w[j] = p.w_conf_dw[((size_t)l * 31 + j) * 256 + c];
        float acc[32]; const float bd = p.b_conf_dw[l * 256 + c];
#pragma unroll
        for (int o = 0; o < 32; ++o) acc[o] = bd;
#pragma unroll
        for (int i = 0; i < 62; ++i) { const float v = hs[(32 * half + i) * 256 + c];
#pragma unroll
            for (int o = 0; o < 32; ++o) { if (i - o >= 0 && i - o <= 30) acc[o] += w[i - o] * v; } }
        __syncthreads();
#pragma unroll
        for (int o = 0; o < 32; ++o) hs[(32 * half + o) * 256 + c] = acc[o];
    }
    __syncthreads();
    {
        const int lane = tid & 63, wave = __builtin_amdgcn_readfirstlane(tid >> 6);
        const f32x4 gl = *(const f32x4*)(p.g_conf_ln + l * 256 + 4 * lane), bl = *(const f32x4*)(p.b_conf_ln + l * 256 + 4 * lane);
#pragma unroll
        for (int q = 0; q < 8; ++q) { const int tt = wave * 8 + q; f32x4 v = *(const LAS f32x4*)(hs + tt * 256 + 4 * lane);
            const float mean = wave_sum_bp((v.x + v.y) + (v.z + v.w), lane) * (1.f / 256.f); v = v - mean;
            const float var = wave_sum_bp((v.x * v.x + v.y * v.y) + (v.z * v.z + v.w * v.w), lane) * (1.f / 256.f);
            const float rstd = 1.f / sqrtf(var + LN_EPS); v = v * rstd * gl + bl;
            u32x2 w; w.x = cvt_pk_bf16(v.x * sigmoid_f(v.x), v.y * sigmoid_f(v.y)); w.y = cvt_pk_bf16(v.z * sigmoid_f(v.z), v.w * sigmoid_f(v.w));
            *(u32x2*)(MIX + (size_t)(t0 + tt) * DM + 256 + 4 * lane) = w; }
    }
    __syncthreads();
}
__device__ __forceinline__ void phaseC(const Params& p, int l, LAS unsigned char* lds, int bid, int G, int tid, int csel) {
    const int n_att = NB * 32 * 8, n_catt = (l == 0) ? NB * 8 * 2 : 0, n_conv = (l == 0 ? T_ALL : T_LAT) / 64;
    if (csel & 1) attn_run<false>(p, l, n_att, lds, bid, G, tid);
    if ((csel & 2) && n_catt) attn_run<true>(p, l, n_catt, lds, bid, G, tid);
    if (csel & 4) for (int it = G - 1 - bid; it < n_conv; it += G) conv_item(p, l, it, lds, tid);
}

template <bool L0> __device__ __forceinline__ void phaseE(const Params& p, int l, LAS unsigned char* lds, int bid, int G, int tid) {
    const int lane = tid & 63, gw = bid * NWAVE + __builtin_amdgcn_readfirstlane(tid >> 6), NGW = G * NWAVE;
    const int nrow = (l == 0) ? T_ALL : T_LAT;
    LAS float* wr = (LAS float*)lds;
    for (int q = tid; q < DM * 16; q += NTHR) { const int k = q >> 4, e = q & 15; const int j = k >> 8, ln = (k >> 2) & 63, i = k & 3;
        wr[((((j * 4 + i) * 4) + (e >> 2)) * 64 + ln) * 4 + (e & 3)] = p.w_router[(size_t)l * DM * 16 + q]; }
    __syncthreads();
    const float* MOD = (const float*)(p.ws + WS_MOD) + (size_t)l * 9 * 6144;
    const bf16_t* Y = (const bf16_t*)(p.ws + WS_R2); const bf16_t* XS = (const bf16_t*)(p.ws + WS_XB); bf16_t* XM = (bf16_t*)(p.ws + WS_XB + SZ_R3); bf16_t* HM = (bf16_t*)(p.ws + WS_R3); float* AFF = (float*)(p.ws + WS_AFF);
    const float* g1 = p.g_post1 + l * DM; const float* b1 = p.b_post1 + l * DM;
    f32x4 xf[2][4]; u32x2 xh[2][4], yh[2][4];
#define E_PREFETCH(R0) do { _Pragma("unroll") for (int r = 0; r < 2; ++r) { int row = (R0) + r * NGW; row = row < nrow ? row : (R0); \
        if (L0) { const float* xr = row < T_LAT ? p.x + (size_t)row * DM : p.ctx + (size_t)(row - T_LAT) * DM; _Pragma("unroll") for (int j = 0; j < 4; ++j) xf[r][j] = __builtin_nontemporal_load((const f32x4*)(xr + 256 * j + 4 * lane)); } \
        else { _Pragma("unroll") for (int j = 0; j < 4; ++j) xh[r][j] = __builtin_nontemporal_load((const u32x2*)(XS + (size_t)row * DM + 256 * j + 4 * lane)); } \
        _Pragma("unroll") for (int j = 0; j < 4; ++j) yh[r][j] = __builtin_nontemporal_load((const u32x2*)(Y + (size_t)row * DM + 256 * j + 4 * lane)); } } while (0)
    E_PREFETCH(gw);
    for (int row0 = gw; row0 < nrow; row0 += 2 * NGW) {
        int rows[2]; rows[0] = row0; rows[1] = (row0 + NGW < nrow) ? row0 + NGW : row0; asm volatile("" : "+s"(rows[1]));
        f32x4 v[2][4], y[2][4], t[2][4], u[2][4];
        const float* md[2];
#pragma unroll
        for (int r = 0; r < 2; ++r) { md[r] = MOD + (size_t)mod_row_of(rows[r]) * 6144; ld_row(t[r], md[r] + 2 * DM, lane);
#pragma unroll
            for (int j = 0; j < 4; ++j) { if (L0) v[r][j] = xf[r][j]; else v[r][j] = (f32x4){bflo(xh[r][j].x), bfhi(xh[r][j].x), bflo(xh[r][j].y), bfhi(xh[r][j].y)};
                y[r][j] = (f32x4){bflo(yh[r][j].x), bfhi(yh[r][j].x), bflo(yh[r][j].y), bfhi(yh[r][j].y)}; } }
        { const int nr0 = row0 + 2 * NGW < nrow ? row0 + 2 * NGW : row0; E_PREFETCH(nr0); }
#pragma unroll
        for (int r = 0; r < 2; ++r) {
#pragma unroll
            for (int j = 0; j < 4; ++j) v[r][j] = v[r][j] * ALPHA + (t[r][j] + 1.f) * y[r][j]; }
        ld_row(y[0], g1, lane); ld_row(y[1], b1, lane);
#pragma unroll
        for (int r = 0; r < 2; ++r) ln16(v[r], lane);
#pragma unroll
        for (int r = 0; r < 2; ++r) {
#pragma unroll
            for (int j = 0; j < 4; ++j) v[r][j] = v[r][j] * y[0][j] + y[1][j];
            st_row_bf16_nt(XM + (size_t)rows[r] * DM, v[r], lane);
            ld_row(t[r], md[r] + 3 * DM, lane); ld_row(u[r], md[r] + 4 * DM, lane); }
#pragma unroll
        for (int r = 0; r < 2; ++r) ln16(v[r], lane);
#pragma unroll
        for (int r = 0; r < 2; ++r) {
#pragma unroll
            for (int j = 0; j < 4; ++j) v[r][j] = v[r][j] * (u[r][j] + 1.f) + t[r][j];
            st_row_bf16(HM + (size_t)rows[r] * DM, v[r], lane); }
        typedef float f32x2 __attribute__((ext_vector_type(2)));
        f32x2 acc2[16];
#pragma unroll
        for (int e = 0; e < 16; ++e) acc2[e] = (f32x2){0.f, 0.f};
#pragma unroll
        for (int j = 0; j < 4; ++j) {
#pragma unroll
            for (int i = 0; i < 4; ++i) { const f32x2 hv = {v[0][j][i], v[1][j][i]};
#pragma unroll
                for (int eq = 0; eq < 4; ++eq) { const f32x4 w4 = *(const LAS f32x4*)(wr + (((j * 4 + i) * 4 + eq) * 64 + lane) * 4);
#pragma unroll
                    for (int ee = 0; ee < 4; ++ee) acc2[4 * eq + ee] += hv * (f32x2){w4[ee], w4[ee]}; } }
            __builtin_amdgcn_sched_barrier(0); }
#pragma unroll
        for (int r = 0; r < 2; ++r) {
            f32x4 a[4];
#pragma unroll
            for (int eq = 0; eq < 4; ++eq) a[eq] = (f32x4){acc2[4 * eq][r], acc2[4 * eq + 1][r], acc2[4 * eq + 2][r], acc2[4 * eq + 3][r]};
            float x8[8], x4[4], x2[2], x1;
            const bool b5 = (lane & 32) != 0, b4 = (lane & 16) != 0, b3 = (lane & 8) != 0, b2 = (lane & 4) != 0;
#pragma unroll
            for (int k = 0; k < 8; ++k) { const float lo = a[k >> 2][k & 3], hi = a[2 + (k >> 2)][k & 3]; x8[k] = (b5 ? hi : lo) + shx(b5 ? lo : hi, 32, lane); }
#pragma unroll
            for (int k = 0; k < 4; ++k) x4[k] = (b4 ? x8[4 + k] : x8[k]) + shx(b4 ? x8[k] : x8[4 + k], 16, lane);
#pragma unroll
            for (int k = 0; k < 2; ++k) x2[k] = (b3 ? x4[2 + k] : x4[k]) + shx(b3 ? x4[k] : x4[2 + k], 8, lane);
            x1 = (b2 ? x2[1] : x2[0]) + shx(b2 ? x2[0] : x2[1], 4, lane);
            x1 += shx(x1, 2, lane); x1 += shx(x1, 1, lane);
            float mx = x1;
            mx = fmaxf(mx, shx(mx, 4, lane)); mx = fmaxf(mx, shx(mx, 8, lane)); mx = fmaxf(mx, shx(mx, 16, lane)); mx = fmaxf(mx, shx(mx, 32, lane));
            const float ex = __expf(x1 - mx); float sum = ex;
            sum += shx(sum, 4, lane); sum += shx(sum, 8, lane); sum += shx(sum, 16, lane); sum += shx(sum, 32, lane);
            if ((lane & 3) == 0) AFF[(size_t)rows[r] * 16 + (lane >> 2)] = ex / sum;
        }
    }
    __syncthreads();
}

#undef E_PREFETCH
__device__ __forceinline__ void phaseF(const Params& p, int l, LAS unsigned char* lds, int bid, int G, int tid) {
    const float* AFF = (const float*)(p.ws + WS_AFF); int* SLOT = (int*)(p.ws + WS_SLOT);
    int* TOK = (int*)(p.ws + WS_TOK);
    LAS unsigned* red = (LAS unsigned*)lds;
    LAS unsigned* wtot = (LAS unsigned*)(lds + 64);
    const int n_lat = NB * NE, n_ctx = (l == 0) ? NB * NE : 0;
    const int lane = tid & 63, wave = __builtin_amdgcn_readfirstlane(tid >> 6);
    for (int it = bid; it < n_lat + n_ctx; it += G) {
        int b, e, ntok, cap, tokbase, dstbase;
        if (it < n_lat) { b = it >> 4; e = it & 15; ntok = SEQ; cap = CAP_L; tokbase = b * SEQ; dstbase = e * ROWS_E + b * CAP_L; }
        else { const int i2 = it - n_lat; b = i2 >> 4; e = i2 & 15; ntok = CTXL; cap = CAP_C; tokbase = T_LAT + b * CTXL; dstbase = e * ROWS_E + NB * CAP_L + b * CAP_C; }
        unsigned k[4];
#pragma unroll
        for (int i = 0; i < 4; ++i) { const int t = 4 * tid + i; k[i] = t < ntok ? __builtin_bit_cast(unsigned, AFF[(size_t)(tokbase + t) * 16 + e]) : 0u; }
        unsigned thr = 0u;
        for (int bit = 30; bit >= 0; --bit) {
            const unsigned cand = thr | (1u << bit); unsigned c = 0u;
#pragma unroll
            for (int i = 0; i < 4; ++i) c += (unsigned)__popcll(__ballot(k[i] >= cand));
            const int par = bit & 1;
            if (lane == 0) red[par * 8 + wave] = c;
            __syncthreads();
            unsigned tot = 0u;
#pragma unroll
            for (int w = 0; w < 8; ++w) tot += red[par * 8 + w];
            if (tot >= (unsigned)cap) thr = cand;
        }
        unsigned ng = 0u, ne = 0u;
#pragma unroll
        for (int i = 0; i < 4; ++i) { ng += (k[i] > thr) ? 1u : 0u; ne += (k[i] == thr) ? 1u : 0u; }
        const unsigned v = ng | (ne << 16); unsigned inc = v;
#pragma unroll
        for (int o = 1; o < 64; o <<= 1) { const unsigned u = (unsigned)__builtin_amdgcn_ds_bpermute((lane - o) << 2, (int)inc); if (lane >= o) inc += u; }
        if (lane == 63) wtot[wave] = inc;
        __syncthreads();
        unsigned off = 0u, total = 0u;
#pragma unroll
        for (int w = 0; w < 8; ++w) { const unsigned x = wtot[w]; if (w < wave) off += x; total += x; }
        const unsigned exc = off + inc - v;
        unsigned gb = exc & 0xFFFFu, eb = exc >> 16; const unsigned need = (unsigned)cap - (total & 0xFFFFu);
#pragma unroll
        for (int i = 0; i < 4; ++i) { const int t = 4 * tid + i;
            if (t < ntok) { const bool gt = k[i] > thr, eq = k[i] == thr; const bool sel = gt || (eq && eb < need);
                const unsigned slot = gb + (eb < need ? eb : need);
                SLOT[(size_t)(tokbase + t) * 16 + e] = sel ? (int)slot : -1;
                if (sel) TOK[dstbase + slot] = tokbase + t;
                gb += gt ? 1u : 0u; eb += eq ? 1u : 0u; } }
        __syncthreads();
    }
}

__device__ __forceinline__ void phaseI(const Params& p, int l, int bid, int G, int tid) {
    const int lane = tid & 63, gw = bid * NWAVE + __builtin_amdgcn_readfirstlane(tid >> 6), NGW = G * NWAVE;
    const bool last = (l == NL - 1); const int nrow = (l == 0) ? T_ALL : T_LAT;
    const float* MOD = (const float*)(p.ws + WS_MOD) + (size_t)l * 9 * 6144;
    const float* AFF = (const float*)(p.ws + WS_AFF); const int* SLOT = (const int*)(p.ws + WS_SLOT);
    const bf16_t* YE = (const bf16_t*)(p.ws + WS_R1); bf16_t* XS = (bf16_t*)(p.ws + WS_XB); const bf16_t* XM = (const bf16_t*)(p.ws + WS_XB + SZ_R3); bf16_t* H = (bf16_t*)(p.ws + WS_R3);
    const float* g2 = p.g_post2 + l * DM; const float* b2 = p.b_post2 + l * DM;
    for (int row0 = gw; row0 < nrow; row0 += 2 * NGW) {
        int rows[2]; rows[0] = row0; rows[1] = (row0 + NGW < nrow) ? row0 + NGW : row0; asm volatile("" : "+s"(rows[1]));
        int sl[2], rbase[2]; float af[2]; unsigned mask[2]; const float* md[2];
        f32x4 v[2][4], t[2][4], ym[2][4];
#pragma unroll
        for (int r = 0; r < 2; ++r) { const int row = rows[r];
            sl[r] = SLOT[(size_t)row * 16 + (lane & 15)]; af[r] = AFF[(size_t)row * 16 + (lane & 15)];
            rbase[r] = row < T_LAT ? (row >> 11) * CAP_L : NB * CAP_L + ((row - T_LAT) >> 8) * CAP_C;
            md[r] = MOD + (size_t)mod_row_of(row) * 6144;
            ld_row_bf16_nt(v[r], XM + (size_t)row * DM, lane); ld_row(t[r], md[r] + 5 * DM, lane);
#pragma unroll
            for (int j = 0; j < 4; ++j) ym[r][j] = (f32x4){0.f, 0.f, 0.f, 0.f}; }
#pragma unroll
        for (int r = 0; r < 2; ++r) mask[r] = (unsigned)(__ballot(sl[r] >= 0) & 0xFFFFull);
        while (mask[0] | mask[1]) {
            u32x2 w[2][3][4]; float aa[2][3];
#pragma unroll
            for (int r = 0; r < 2; ++r)
#pragma unroll
                for (int q = 0; q < 3; ++q) { int e = 0, s_ = 0; float a_ = 0.f;
                    if (mask[r]) { e = __builtin_ctz(mask[r]); mask[r] &= mask[r] - 1u; s_ = __builtin_amdgcn_readlane(sl[r], e); a_ = __builtin_bit_cast(float, __builtin_amdgcn_readlane(__builtin_bit_cast(int, af[r]), e)); }
                    aa[r][q] = a_; const bf16_t* yr = YE + ((size_t)e * ROWS_E + rbase[r] + s_) * DM + 4 * lane;
#pragma unroll
                    for (int j = 0; j < 4; ++j) w[r][q][j] = __builtin_nontemporal_load((const u32x2*)(yr + 256 * j)); }
#pragma unroll
            for (int r = 0; r < 2; ++r)
#pragma unroll
                for (int q = 0; q < 3; ++q)
#pragma unroll
                    for (int j = 0; j < 4; ++j) { const float a_ = aa[r][q]; const u32x2 ww = w[r][q][j];
                        ym[r][j].x += a_ * bflo(ww.x); ym[r][j].y += a_ * bfhi(ww.x); ym[r][j].z += a_ * bflo(ww.y); ym[r][j].w += a_ * bfhi(ww.y); }
        }
#pragma unroll
        for (int r = 0; r < 2; ++r) {
#pragma unroll
            for (int j = 0; j < 4; ++j) v[r][j] = v[r][j] * ALPHA + (t[r][j] + 1.f) * ym[r][j]; }
        f32x4 g4[4], b4[4]; ld_row(g4, g2, lane); ld_row(b4, b2, lane);
#pragma unroll
        for (int r = 0; r < 2; ++r) ln16(v[r], lane);
#pragma unroll
        for (int r = 0; r < 2; ++r) {
#pragma unroll
            for (int j = 0; j < 4; ++j) v[r][j] = v[r][j] * g4[j] + b4[j];
            if (last) st_row_nt(p.out + (size_t)rows[r] * DM, v[r], lane); else st_row_bf16_nt(XS + (size_t)rows[r] * DM, v[r], lane); }
        if (!last) {
#pragma unroll
            for (int r = 0; r < 2; ++r) { const float* md2 = md[r] + 9 * 6144; ld_row(t[r], md2, lane); ld_row(ym[r], md2 + DM, lane); }
#pragma unroll
            for (int r = 0; r < 2; ++r) ln16(v[r], lane);
#pragma unroll
            for (int r = 0; r < 2; ++r) {
#pragma unroll
                for (int j = 0; j < 4; ++j) v[r][j] = v[r][j] * (ym[r][j] + 1.f) + t[r][j];
                st_row_bf16(H + (size_t)rows[r] * DM, v[r], lane); }
        }
    }
}

#define XB_TMO      128
#define XB_XCNT(j)  (256  + 64 * (j))
#define XB_XSUB(j)  (1280 + 64 * (j))
#define XB_XGEN(j)  (2304 + 64 * (j))
#define XB_TOP      3328
#define XB_TOPGEN   3392
#define XCD_BAR_WORDS 3456
#define XB_SPIN_CAP (1u << 18)

__device__ __forceinline__ unsigned xb_ld(unsigned* p)              { return __hip_atomic_load(p, __ATOMIC_RELAXED, __HIP_MEMORY_SCOPE_AGENT); }
__device__ __forceinline__ unsigned xb_add(unsigned* p, unsigned v) { return __hip_atomic_fetch_add(p, v, __ATOMIC_RELAXED, __HIP_MEMORY_SCOPE_AGENT); }
__device__ __forceinline__ unsigned xb_xcc_id() { return (unsigned)__builtin_amdgcn_s_getreg((3 << 11) | 20) & 0xFu; }
#define XB_SPIN(cond, bar) do { unsigned _sp = 0; while (cond) { __builtin_amdgcn_s_sleep(1); \
    if ((++_sp & 255u) == 0u) { if (xb_ld(&(bar)[XB_TMO])) break; if (_sp > XB_SPIN_CAP) { atomicAdd(&(bar)[XB_TMO], 1u); break; } } } } while (0)

struct XcdBarrier {
    unsigned* bar; unsigned x;
    volatile LAS unsigned* st;
};

__device__ __forceinline__ XcdBarrier xcd_barrier_post(unsigned* bar, volatile LAS unsigned* st) {
    XcdBarrier b; b.bar = bar; b.x = xb_xcc_id(); b.st = st;
    if (threadIdx.x == 0) (void)xb_add(&bar[XB_XCNT(b.x)], 1u);
    return b;
}
__device__ __forceinline__ void xcd_barrier_complete(unsigned* bar, unsigned x, unsigned& nloc, unsigned& nx) {
    const unsigned G = gridDim.x * gridDim.y * gridDim.z;
    unsigned sum, cnt, mine, sp = 0u;
    for (;;) {
        sum = 0u; cnt = 0u; mine = 0u;
#pragma unroll
        for (unsigned j = 0; j < 16; ++j) { const unsigned c = xb_ld(&bar[XB_XCNT(j)]); sum += c; cnt += (c > 0u) ? 1u : 0u; mine = (j == x) ? c : mine; }
        if (sum == G) break;
        __builtin_amdgcn_s_sleep(1);
        if ((++sp & 255u) == 0u) { if (xb_ld(&bar[XB_TMO])) break; if (sp > XB_SPIN_CAP) { atomicAdd(&bar[XB_TMO], 1u); break; } }
    }
    nloc = mine > 0u ? mine : 1u; nx = cnt > 0u ? cnt : 1u;
}

__device__ __forceinline__ void xcd_barrier(const XcdBarrier& b) {
    asm volatile("s_waitcnt vmcnt(0)" ::: "memory");
    __syncthreads();
    if (threadIdx.x == 0) {
        unsigned* bar = b.bar;
        __builtin_amdgcn_s_waitcnt(0);
        unsigned nloc = b.st[0], nx = b.st[1];
        if (nloc == 0u) { xcd_barrier_complete(bar, b.x, nloc, nx); b.st[0] = nloc; b.st[1] = nx; }
        const unsigned old = xb_add(&bar[XB_XSUB(b.x)], 1u);
        const unsigned gen = old / nloc;
        if (old + 1u == (gen + 1u) * nloc) {
            __builtin_amdgcn_fence(__ATOMIC_RELEASE, "agent");
            asm volatile("s_waitcnt vmcnt(0)" ::: "memory");
            const unsigned og = xb_add(&bar[XB_TOP], 1u);
            const unsigned tg = og / nx;
            if (og + 1u == (tg + 1u) * nx) xb_add(&bar[XB_TOPGEN], 1u);
            else XB_SPIN(xb_ld(&bar[XB_TOPGEN]) == tg, bar);
            __builtin_amdgcn_fence(__ATOMIC_ACQUIRE, "agent");
            xb_add(&bar[XB_XGEN(b.x)], 1u);
            asm volatile("s_waitcnt vmcnt(0)" ::: "memory");
        } else {
            XB_SPIN(xb_ld(&bar[XB_XGEN(b.x)]) == gen, bar);
            __builtin_amdgcn_fence(__ATOMIC_ACQUIRE, "agent");
            asm volatile("s_waitcnt vmcnt(0)" ::: "memory");
        }
    }
    __syncthreads();
}

constexpr int N_PHASES = 2 + 8 * NL;
#ifndef PHM
#define PHM 1023
#endif
__global__ void __launch_bounds__(NTHR, 2) mega(Params p_in) {
    extern __shared__ __attribute__((aligned(16))) unsigned char lds_raw[];
    LAS unsigned char* lds = (LAS unsigned char*)lds_raw;
    cg::grid_group grid = cg::this_grid();
    const int bid0 = blockIdx.x, G = gridDim.x;
    const Params& p0 = p_in;
    volatile LAS unsigned* bst = (volatile LAS unsigned*)(lds + LDS_BYTES - 64);
    if (threadIdx.x < 2) bst[threadIdx.x] = 0u;
    __syncthreads();
    const XcdBarrier xbar = xcd_barrier_post((unsigned*)(p0.ws + WS_BAR), bst);
    if (p0.ph_lo < 0) grid.sync();
#ifdef DUP_T
    bool rep_done = false;
#endif
    for (int ph = p0.ph_lo; ph < p0.ph_hi;) {
        int tid = threadIdx.x; asm volatile("" : "+v"(tid));
        int bid = bid0; asm volatile("" : "+s"(bid));
        Params p = p0; { size_t zoff = 0; asm volatile("" : "+s"(zoff)); p.ws = p0.ws + zoff; }
        if (ph == 0) { if (PHM & 1) phase0(p, lds, bid, G, tid); }
        else if (ph == 1) { if (PHM & 2) phaseA(p, bid, G, tid); }
        else {
            const int l = (ph - 2) >> 3, s = (ph - 2) & 7;
            if (s == 0) { if (PHM & 4) {
                pg8::Gemm g{(const bf16_t*)(p.ws + WS_R3), (const bf16_t*)(p.ws + WS_WIN) + (size_t)l * D_IN * DM, DM};
                pg8::Sched S{1, l == 0 ? 72 : 64, 11, 0, 0, 64, 7, 4, l == 0 ? 0 : 32, G, bid};
                pg8::EpiBf16 E{(bf16_t*)(p.ws + WS_R1), D_IN, p.b_in + l * D_IN, 5, 7};
                pg8::gemm_phase<pg8::EpiBf16, pg8::Sched, true, true>(lds, g, S, E, tid);
                if (l == 0) convert_deferred(p, lds, 0, 792, bid, G, tid); }
            } else if (s == 1) { if (PHM & 8) {
#if defined(DUP_T) && defined(CSEL)
                phaseC(p, l, lds, bid, G, tid, rep_done ? CSEL : 7);
#else
                phaseC(p, l, lds, bid, G, tid, 7);
#endif
            } }
            else if (s == 2) { if (PHM & 16) {
                pg8::Gemm g{(const bf16_t*)(p.ws + WS_R3), (const bf16_t*)(p.ws + WS_WOUT) + (size_t)l * DM * DM, DM};
                pg8::Sched S{1, l == 0 ? 72 : 64, 4, 0, 0, 0, 0, 1, 0, G, bid};
                pg8::EpiBf16 E{(bf16_t*)(p.ws + WS_R2), DM, p.b_out + l * DM, 0, 0};
                pg8::gemm_phase<pg8::EpiBf16, pg8::Sched, true, true>(lds, g, S, E, tid);
                if (l == 0) convert_deferred(p, lds, 1, 288, bid, G, tid); }
            } else if (s == 3) { if (PHM & 32) { if (l == 0) phaseE<true>(p, l, lds, bid, G, tid); else phaseE<false>(p, l, lds, bid, G, tid); } }
            else if (s == 4) { if (PHM & 64) phaseF(p, l, lds, bid, G, tid); }
            else if (s == 5) { if (PHM & 128) {
                pg8::Gemm g{(const bf16_t*)(p.ws + WS_R3), (const bf16_t*)(p.ws + WS_WGU) + (size_t)l * NE * 2048 * DM, DM};
                pg8::Sched S{NE, l == 0 ? 9 : 8, 8, 9, 8, 0, 0, 1, 0, G, bid};
                pg8::EpiSwiglu E{(bf16_t*)(p.ws + WS_R2), DM};
                pg8::gemm_phase<pg8::EpiSwiglu, pg8::Sched, true, true, true>(lds, g, S, E, tid, (const int*)(p.ws + WS_TOK));
                if (l == 0) convert_deferred(p, lds, 2, 1152, bid, G, tid); }
            } else if (s == 6) { if (PHM & 256) {
                pg8::Gemm g{(const bf16_t*)(p.ws + WS_R2), (const bf16_t*)(p.ws + WS_WD) + (size_t)l * NE * DM * DM, DM};
                pg8::Sched S{NE, l == 0 ? 9 : 8, 4, 9, 4, 0, 0, 1, 0, G, bid};
                pg8::EpiBf16 E{(bf16_t*)(p.ws + WS_R1), DM, nullptr, 0, 0};
                pg8::gemm_phase<pg8::EpiBf16, pg8::Sched, true, true>(lds, g, S, E, tid);
                if (l == 0) convert_deferred(p, lds, 3, 576, bid, G, tid); }
            } else { if (PHM & 512) phaseI(p, l, bid, G, tid); }
        }
        bool advance = true;
#ifdef DUP_T
        { const int ty = ph < 2 ? ph : 2 + ((ph - 2) & 7), ly = ph < 2 ? 0 : (ph - 2) >> 3;
          if (ty == DUP_T && (DUP_L < 0 || ly == DUP_L) && !rep_done) { rep_done = true; advance = false; } else rep_done = false; }
#endif
        if (!advance || ph + 1 < p0.ph_hi) { XcdBarrier xb = xbar; size_t zb = 0; asm volatile("" : "+s"(zb)); xb.bar = xbar.bar + zb; xcd_barrier(xb); }
#ifdef DUP_SYNC
        if (ph + 1 < p0.ph_hi) { xcd_barrier(xbar); xcd_barrier(xbar); }
#endif
        if (advance) ++ph;
    }
}

extern "C" void kernel_launch(void* const* d_in, const int* in_sizes, int n_in, void* d_out, int out_size, void* d_ws, size_t ws_size, hipStream_t stream) {
    static int grid = 0;
    if (grid == 0) {
        if (n_in != 24 || ws_size < WS_END) { fprintf(stderr, "kernel_launch: need 24 inputs and %zu bytes of workspace (got %d, %zu)\n", (size_t)WS_END, n_in, ws_size); grid = -1; return; }
        int dev = 0, cus = 0, per_cu = 0;
        hipGetDevice(&dev); hipDeviceGetAttribute(&cus, hipDeviceAttributeMultiprocessorCount, dev);
        if (hipFuncSetAttribute((const void*)mega, hipFuncAttributeMaxDynamicSharedMemorySize, LDS_BYTES) != hipSuccess) { fprintf(stderr, "kernel_launch: hipFuncSetAttribute failed\n"); grid = -1; return; }
        if (hipOccupancyMaxActiveBlocksPerMultiprocessor(&per_cu, (const void*)mega, NTHR, LDS_BYTES) != hipSuccess || per_cu < 1) { fprintf(stderr, "kernel_launch: occupancy query says %d blocks per CU\n", per_cu); per_cu = 1; }
        (void)hipGetLastError();
        grid = cus * 1;
    }
    if (grid < 0) return;
    Params p{};
    const float** f = (const float**)&p;
    for (int i = 0; i < 24; ++i) f[i] = (const float*)d_in[i];
    p.out = (float*)d_out; p.ws = (unsigned char*)d_ws;
    if (hipMemsetAsync((char*)d_ws + WS_BAR, 0, 16384, stream) != hipSuccess) { fprintf(stderr, "kernel_launch: memset of the barrier words failed\n"); return; }
#if MULTI
    for (int ph = 0; ph < N_PHASES; ++ph) { p.ph_lo = ph; p.ph_hi = ph + 1; hipLaunchKernelGGL(mega, dim3(grid), dim3(NTHR), LDS_BYTES, stream, p); }
#else
    p.ph_lo = 0; p.ph_hi = N_PHASES;
    void* args[] = {&p};
    hipError_t e = hipLaunchCooperativeKernel((const void*)mega, dim3(grid), dim3(NTHR), args, LDS_BYTES, stream);
    if (e != hipSuccess) fprintf(stderr, "cooperative launch failed: %s (grid %d)\n", hipGetErrorString(e), grid);
#endif
}
```

```cpp
#include <hip/hip_runtime.h>
#include <hip/hip_cooperative_groups.h>
#include <cstdio>
#include <cstdint>
namespace cg = cooperative_groups;

#ifndef MULTI
#define MULTI 0
#endif

#define LAS __attribute__((address_space(3)))
#define PG8_LAS __attribute__((address_space(3)))
typedef unsigned short bf16_t;
typedef short bf16x8 __attribute__((ext_vector_type(8)));
typedef short s16x4 __attribute__((ext_vector_type(4)));
typedef float f32x4 __attribute__((ext_vector_type(4)));
typedef unsigned u32x4 __attribute__((ext_vector_type(4)));
typedef unsigned u32x2 __attribute__((ext_vector_type(2)));

constexpr int DM = 1024, NB = 8, SEQ = 2048, CTXL = 256, NL = 2;
constexpr int T_LAT = NB * SEQ, T_CTX = NB * CTXL, T_ALL = T_LAT + T_CTX;
constexpr int D_IN = 2816, OFF_A = 0, OFF_B = 768, OFF_Q = 1280, OFF_K = 1792, OFF_V = 2304;
constexpr int NE = 16, CAP_L = 256, CAP_C = 32, ROWS_E = NB * CAP_L + NB * CAP_C;
constexpr float LN_EPS = 1e-5f;
constexpr float ALPHA = 1.4142135623730951f;
constexpr float LOG2E = 1.4426950408889634f;
constexpr int NTHR = 512, NWAVE = 8;
constexpr int LDS_BYTES = 147456;

constexpr size_t SZ_WIN = (size_t)NL * D_IN * DM * 2, SZ_WOUT = (size_t)NL * DM * DM * 2, SZ_WGU = (size_t)NL * NE * 2048 * DM * 2, SZ_WD = (size_t)NL * NE * DM * DM * 2;
constexpr size_t SZ_MOD = (size_t)NL * 9 * 6144 * 4, SZ_AFF = (size_t)T_ALL * 16 * 4;
constexpr size_t SZ_R3 = (size_t)T_ALL * DM * 2, SZ_R1 = (size_t)T_ALL * D_IN * 2, SZ_R2 = (size_t)T_ALL * DM * 4, SZ_XB = (size_t)T_ALL * DM * 4;
constexpr size_t WS_WIN = 0, WS_WOUT = WS_WIN + SZ_WIN, WS_WGU = WS_WOUT + SZ_WOUT, WS_WD = WS_WGU + SZ_WGU, WS_MOD = WS_WD + SZ_WD;
constexpr size_t WS_AFF = WS_MOD + SZ_MOD, WS_SLOT = WS_AFF + SZ_AFF, WS_R3 = WS_SLOT + SZ_AFF, WS_R1 = WS_R3 + SZ_R3, WS_R2 = WS_R1 + SZ_R1, WS_XB = WS_R2 + SZ_R2, WS_BAR = WS_XB + SZ_XB, WS_TOK = WS_BAR + 16384, WS_END = WS_TOK + (size_t)NE * ROWS_E * 4;
static_assert(WS_END <= (size_t)536870912, "workspace map exceeds 512 MiB");
static_assert((size_t)NE * ROWS_E * DM * 2 <= SZ_R1 && (size_t)NE * ROWS_E * DM * 2 <= SZ_R2, "MoE buffers fit their overlays");

struct Params {
    const float *x, *c, *ctx, *c_ctx, *w_mod, *b_mod, *w_in, *b_in, *w_short, *w_conf_dw, *b_conf_dw, *g_conf_ln, *b_conf_ln, *na_rpb, *w_out, *b_out,
                *g_post1, *b_post1, *w_router, *w_gate, *w_up, *w_down, *g_post2, *b_post2;
    float* out; unsigned char* ws; int ph_lo, ph_hi;
};

__device__ __forceinline__ unsigned cvt_pk_bf16(float lo, float hi) { unsigned r; asm volatile("v_cvt_pk_bf16_f32 %0, %1, %2" : "=v"(r) : "v"(lo), "v"(hi)); return r; }
__device__ __forceinline__ float bflo(unsigned u) { return __builtin_bit_cast(float, u << 16); }
__device__ __forceinline__ float bfhi(unsigned u) { return __builtin_bit_cast(float, u & 0xffff0000u); }
__device__ __forceinline__ float shx(float v, int o, int lane) { return __builtin_bit_cast(float, __builtin_amdgcn_ds_bpermute((lane ^ o) << 2, __builtin_bit_cast(int, v))); }
__device__ __forceinline__ float wave_sum_bp(float v, int lane) {
#pragma unroll
    for (int o = 1; o < 64; o <<= 1) v += shx(v, o, lane);
    return v;
}
__device__ __forceinline__ float wave_sum(float v, int lane) {
    (void)lane;
#define DPPF(x, ctrl, rmask) __builtin_bit_cast(float, __builtin_amdgcn_update_dpp(0, __builtin_bit_cast(int, (x)), (ctrl), (rmask), 0xf, false))
    v += DPPF(v, 0xB1, 0xf);
    v += DPPF(v, 0x4E, 0xf);
    v += DPPF(v, 0x141, 0xf);
    v += DPPF(v, 0x140, 0xf);
    v += DPPF(v, 0x142, 0xa);
    v += DPPF(v, 0x143, 0xc);
#undef DPPF
    return __builtin_bit_cast(float, __builtin_amdgcn_readlane(__builtin_bit_cast(int, v), 63));
}
__device__ __forceinline__ float sigmoid_f(float x) { return __builtin_amdgcn_rcpf(1.f + __builtin_amdgcn_exp2f(-LOG2E * x)); }
__device__ __forceinline__ void ln16(f32x4 (&v)[4], int lane) {
    float s = 0.f;
#pragma unroll
    for (int j = 0; j < 4; ++j) s += (v[j].x + v[j].y) + (v[j].z + v[j].w);
    const float mean = wave_sum(s, lane) * (1.f / DM); float s2 = 0.f;
#pragma unroll
    for (int j = 0; j < 4; ++j) { v[j] = v[j] - mean; s2 += (v[j].x * v[j].x + v[j].y * v[j].y) + (v[j].z * v[j].z + v[j].w * v[j].w); }
    const float rstd = 1.f / sqrtf(wave_sum(s2, lane) * (1.f / DM) + LN_EPS);
#pragma unroll
    for (int j = 0; j < 4; ++j) v[j] = v[j] * rstd;
}
__device__ __forceinline__ void ld_row(f32x4 (&v)[4], const float* row, int lane) {
#pragma unroll
    for (int j = 0; j < 4; ++j) v[j] = *(const f32x4*)(row + 256 * j + 4 * lane);
}
__device__ __forceinline__ void ld_row_bf16(f32x4 (&v)[4], const bf16_t* row, int lane) {
#pragma unroll
    for (int j = 0; j < 4; ++j) { const u32x2 w = *(const u32x2*)(row + 256 * j + 4 * lane); v[j] = (f32x4){bflo(w.x), bfhi(w.x), bflo(w.y), bfhi(w.y)}; }
}
__device__ __forceinline__ void ld_row_nt(f32x4 (&v)[4], const float* row, int lane) {
#pragma unroll
    for (int j = 0; j < 4; ++j) v[j] = __builtin_nontemporal_load((const f32x4*)(row + 256 * j + 4 * lane));
}
__device__ __forceinline__ void ld_row_bf16_nt(f32x4 (&v)[4], const bf16_t* row, int lane) {
#pragma unroll
    for (int j = 0; j < 4; ++j) { const u32x2 w = __builtin_nontemporal_load((const u32x2*)(row + 256 * j + 4 * lane)); v[j] = (f32x4){bflo(w.x), bfhi(w.x), bflo(w.y), bfhi(w.y)}; }
}
__device__ __forceinline__ void st_row_nt(float* row, const f32x4 (&v)[4], int lane) {
#pragma unroll
    for (int j = 0; j < 4; ++j) __builtin_nontemporal_store(v[j], (f32x4*)(row + 256 * j + 4 * lane));
}
__device__ __forceinline__ void st_row_bf16_nt(bf16_t* row, const f32x4 (&v)[4], int lane) {
#pragma unroll
    for (int j = 0; j < 4; ++j) { u32x2 w; w.x = cvt_pk_bf16(v[j].x, v[j].y); w.y = cvt_pk_bf16(v[j].z, v[j].w); __builtin_nontemporal_store(w, (u32x2*)(row + 256 * j + 4 * lane)); }
}
__device__ __forceinline__ void st_row(float* row, const f32x4 (&v)[4], int lane) {
#pragma unroll
    for (int j = 0; j < 4; ++j) *(f32x4*)(row + 256 * j + 4 * lane) = v[j];
}
__device__ __forceinline__ void st_row_bf16(bf16_t* row, const f32x4 (&v)[4], int lane) {
#pragma unroll
    for (int j = 0; j < 4; ++j) { u32x2 w; w.x = cvt_pk_bf16(v[j].x, v[j].y); w.y = cvt_pk_bf16(v[j].z, v[j].w); *(u32x2*)(row + 256 * j + 4 * lane) = w; }
}
__device__ __forceinline__ int mod_row_of(int row) { return row < T_LAT ? (row >> 11) : 8; }

namespace pg8 {
constexpr int BM = 256, BK = 64, HALF = 128, HTB = HALF * BK * 2, NXCD = 8, WGM = 4;
__host__ __device__ __forceinline__ int lds_byte(int r, int c) { const int st = (r >> 4) * 2 + (c >> 5), rr = r & 15, cc = c & 31, ob = rr * 64 + cc * 2; return st * 1024 + (ob ^ (((ob >> 9) & 1) << 5)); }
__host__ __device__ __forceinline__ void stage_rc(int b, int& R, int& C) { const int st = b / 1024, sb = b % 1024, swz = sb ^ (((sb >> 9) & 1) << 5); R = (st >> 1) * 16 + swz / 64; C = (st & 1) * 32 + (swz % 64) / 2; }
__host__ __device__ __forceinline__ int perm32(int rho) { const int n = rho >> 4, i = rho & 15; return 8 * (i >> 2) + 4 * n + (i & 3); }

struct Unit { int pm, pn, ex; };
struct Gemm { const bf16_t* A; const bf16_t* Bt; int K; };

struct Sched {
    int ngrp, nM, nN, aM, aN, tailM0, tailN0, tailNn, ntail, G, c;
    __device__ __forceinline__ bool next(int i, Unit& u) const {
        const int nmain = ngrp * nM * nN; const long L = (long)i * G + c; if (L >= nmain + ntail) return false;
        if (L >= nmain) { const int t = (int)L - nmain; u.pm = tailM0 + t / tailNn; u.pn = tailN0 + t % tailNn; u.ex = u.pn; return true; }
        int wg = (int)L; { const int q = nmain / NXCD, r = nmain % NXCD, xcd = wg % NXCD, off = wg / NXCD; wg = (xcd < r ? xcd * (q + 1) : r * (q + 1) + (xcd - r) * q) + off; }
        const int per = nM * nN, grp = wg / per, w2 = wg % per;
        const int nig = WGM * nN, gid = w2 / nig, fm = gid * WGM, gsz = (nM - fm) < WGM ? (nM - fm) : WGM;
        const int pml = fm + ((w2 % nig) % gsz), pnl = (w2 % nig) / gsz;
        u.pm = grp * aM + pml; u.pn = grp * aN + pnl; u.ex = pnl; return true;
    }
    __device__ __forceinline__ void a_ready(const Unit&) const {}
    __device__ __forceinline__ void done(const Unit&) const {}
};

struct EpiBf16 {
    static constexpr bool PERM = true, AFTER_DRAIN = false;
    bf16_t* O; int ldc; const float* bias; int q_lo, q_hi;
    __device__ __forceinline__ void operator()(const f32x4 (&acc)[2][2][4][2], const Unit& u, int wr, int wc, int fr, int fq) const {
        const int row0 = u.pm * BM + wr * 64 + fr; const int col0 = u.ex * BM + wc * 32 + 8 * fq;
        const float sc = (u.ex >= q_lo && u.ex < q_hi) ? 0.125f : 1.f;
        f32x4 bv[2][2];
#pragma unroll
        for (int bj = 0; bj < 2; ++bj)
#pragma unroll
            for (int n = 0; n < 2; ++n) bv[bj][n] = bias ? *(const f32x4*)(bias + col0 + bj * HALF + 4 * n) : (f32x4){0.f, 0.f, 0.f, 0.f};
#pragma unroll
        for (int ai = 0; ai < 2; ++ai)
#pragma unroll
            for (int m = 0; m < 4; ++m) { bf16_t* rowp = O + (size_t)(row0 + ai * HALF + m * 16) * ldc + col0;
#pragma unroll
                for (int bj = 0; bj < 2; ++bj) { f32x4 v0 = (acc[ai][bj][m][0] + bv[bj][0]) * sc, v1 = (acc[ai][bj][m][1] + bv[bj][1]) * sc;
                    u32x4 w; w.x = cvt_pk_bf16(v0[0], v0[1]); w.y = cvt_pk_bf16(v0[2], v0[3]); w.z = cvt_pk_bf16(v1[0], v1[1]); w.w = cvt_pk_bf16(v1[2], v1[3]);
                    *(u32x4*)(rowp + bj * HALF) = w; } }
    }
};
struct EpiF32 {
    static constexpr bool PERM = true, AFTER_DRAIN = false;
    float* O; int ldc; const float* bias;
    __device__ __forceinline__ void operator()(const f32x4 (&acc)[2][2][4][2], const Unit& u, int wr, int wc, int fr, int fq) const {
        const int row0 = u.pm * BM + wr * 64 + fr; const int col0 = u.ex * BM + wc * 32 + 8 * fq;
        f32x4 bv[2][2];
#pragma unroll
        for (int bj = 0; bj < 2; ++bj)
#pragma unroll
            for (int n = 0; n < 2; ++n) bv[bj][n] = *(const f32x4*)(bias + col0 + bj * HALF + 4 * n);
#pragma unroll
        for (int ai = 0; ai < 2; ++ai)
#pragma unroll
            for (int m = 0; m < 4; ++m) { float* rowp = O + (size_t)(row0 + ai * HALF + m * 16) * ldc + col0;
#pragma unroll
                for (int bj = 0; bj < 2; ++bj) { *(f32x4*)(rowp + bj * HALF) = acc[ai][bj][m][0] + bv[bj][0]; *(f32x4*)(rowp + bj * HALF + 4) = acc[ai][bj][m][1] + bv[bj][1]; } }
    }
};
struct EpiSwiglu {
    static constexpr bool PERM = true, AFTER_DRAIN = false;
    bf16_t* O; int ldc;
    __device__ __forceinline__ void operator()(const f32x4 (&acc)[2][2][4][2], const Unit& u, int wr, int wc, int fr, int fq) const {
        const int row0 = u.pm * BM + wr * 64 + fr; const int col0 = u.ex * HALF + wc * 32 + 8 * fq;
#pragma unroll
        for (int ai = 0; ai < 2; ++ai)
#pragma unroll
            for (int m = 0; m < 4; ++m) { bf16_t* rowp = O + (size_t)(row0 + ai * HALF + m * 16) * ldc + col0;
                float r[8];
#pragma unroll
                for (int n = 0; n < 2; ++n)
#pragma unroll
                    for (int j = 0; j < 4; ++j) { const float a = acc[ai][0][m][n][j], b = acc[ai][1][m][n][j]; r[4 * n + j] = a * __builtin_amdgcn_rcpf(1.f + __builtin_amdgcn_exp2f(-1.4426950408889634f * a)) * b; }
                u32x4 w; w.x = cvt_pk_bf16(r[0], r[1]); w.y = cvt_pk_bf16(r[2], r[3]); w.z = cvt_pk_bf16(r[4], r[5]); w.w = cvt_pk_bf16(r[6], r[7]);
                *(u32x4*)rowp = w; }
    }
};

template <class Epi, class Sched, bool ALIGN_EPI = false, bool SP2 = false, bool GATHER = false>
__device__ __forceinline__ void gemm_phase(PG8_LAS unsigned char* lds, const Gemm g, const Sched& S, const Epi& E, const int tid, const int* __restrict__ rowlist = nullptr) {
    const int wid = __builtin_amdgcn_readfirstlane(tid >> 6), lane = tid & 63, wr = wid >> 2, wc = wid & 3, fr = lane & 15, fq = lane >> 4;
    const int K = g.K, nt = K / BK;
    unsigned voffA[2], voffB[2];
#pragma unroll
    for (int i = 0; i < 2; ++i) { int R, C; stage_rc(tid * 16 + i * 8192, R, C); const int Rb = Epi::PERM ? ((R & ~31) + perm32(R & 31)) : R;
        voffA[i] = (unsigned)(R * K + C) * 2u; voffB[i] = (unsigned)(Rb * K + C) * 2u; }
    const size_t kstep = (size_t)(BK * 2);
    const size_t hstep = (size_t)HALF * K * 2;
    const size_t tstep = 2 * hstep;
    const unsigned ldsw = (unsigned)wid * 1024u;
    const int aoff = lds_byte(wr * 64 + fr, fq * 8), boff = lds_byte(wc * 32 + fr, fq * 8);
#define PG8_SA(b, h) (((b) * 2 + (h)) * HTB)
#define PG8_SB(b, h) ((4 + (b) * 2 + (h)) * HTB)
#define PG8_STAGE(bufoff, gbase, voff) do { _Pragma("unroll") for (int _i = 0; _i < 2; ++_i) \
        __builtin_amdgcn_global_load_lds((const unsigned*)((const char*)(gbase) + (voff)[_i]), (PG8_LAS unsigned*)(lds + (bufoff) + ldsw + _i * 8192), 16, 0, 0); } while (0)
#define PG8_STAGE_G(bufoff, gbase, h, nx) do { _Pragma("unroll") for (int _i = 0; _i < 2; ++_i) \
        __builtin_amdgcn_global_load_lds((const unsigned*)((const char*)(gbase) + ((nx) ? vgn[h][_i] : vg[h][_i])), (PG8_LAS unsigned*)(lds + (bufoff) + ldsw + _i * 8192), 16, 0, 0); } while (0)
#define PG8_STA(bufoff, base, h, vsel) do { if constexpr (GATHER) { PG8_STAGE_G(bufoff, base, h, vsel); } else { PG8_STAGE(bufoff, (base) + (h) * hstep, voffA); } } while (0)
#define PG8_LOADVG(v, pm_) do { _Pragma("unroll") for (int _i = 0; _i < 2; ++_i) { int _R, _C; stage_rc(tid * 16 + _i * 8192, _R, _C); _Pragma("unroll") for (int _h = 0; _h < 2; ++_h) \
        (v)[_h][_i] = (unsigned)rowlist[(pm_) * BM + _h * HALF + _R] * (unsigned)(K * 2) + (unsigned)_C * 2u; } } while (0)
#define PG8_LDA(dst, b, h) do { _Pragma("unroll") for (int m = 0; m < 4; ++m) _Pragma("unroll") for (int k = 0; k < 2; ++k) dst[m][k] = *(const PG8_LAS bf16x8*)(lds + PG8_SA(b, h) + aoff + m * 2048 + k * 1024); } while (0)
#define PG8_LDB(dst, b, h) do { _Pragma("unroll") for (int n = 0; n < 2; ++n) _Pragma("unroll") for (int k = 0; k < 2; ++k) dst[n][k] = *(const PG8_LAS bf16x8*)(lds + PG8_SB(b, h) + boff + n * 2048 + k * 1024); } while (0)
#define PG8_MMA(ai, bj, At, Bt) do { __builtin_amdgcn_s_setprio(1); _Pragma("unroll") for (int m = 0; m < 4; ++m) _Pragma("unroll") for (int n = 0; n < 2; ++n) _Pragma("unroll") for (int k = 0; k < 2; ++k) \
        acc[ai][bj][m][n] = __builtin_amdgcn_mfma_f32_16x16x32_bf16(Bt[n][k], At[m][k], acc[ai][bj][m][n], 0, 0, 0); __builtin_amdgcn_s_setprio(0); } while (0)
#define PG8_WAIT_V(n) asm volatile("s_waitcnt vmcnt(" #n ")" ::: "memory")
#define PG8_WAIT_L(n) asm volatile("s_waitcnt lgkmcnt(" #n ")" ::: "memory")
#define PG8_BAR __builtin_amdgcn_s_barrier()
#define PG8_SCHED __builtin_amdgcn_sched_barrier(0)
    Unit cur, nxt; int ui = 0;
    if (!S.next(0, cur)) return;
    f32x4 acc[2][2][4][2];
#pragma unroll
    for (int a = 0; a < 2; ++a)
#pragma unroll
        for (int b = 0; b < 2; ++b)
#pragma unroll
            for (int m = 0; m < 4; ++m)
#pragma unroll
                for (int n = 0; n < 2; ++n) acc[a][b][m][n] = (f32x4){0.f, 0.f, 0.f, 0.f};
    bf16x8 At[4][2], B0[2][2], B1[2][2];
    const char* cA = (const char*)g.A + (GATHER ? (size_t)0 : (size_t)cur.pm * tstep);
    unsigned vg[2][2] = {{0u, 0u}, {0u, 0u}}, vgn[2][2] = {{0u, 0u}, {0u, 0u}}; if constexpr (GATHER) PG8_LOADVG(vg, cur.pm); const char* cB = (const char*)g.Bt + (size_t)cur.pn * tstep;
    S.a_ready(cur);
    if constexpr (SP2) {
        PG8_STAGE(PG8_SB(0, 0), cB, voffB); PG8_STAGE(PG8_SB(0, 1), cB + hstep, voffB); PG8_STA(PG8_SA(0, 0), cA, 0, false); PG8_STA(PG8_SA(0, 1), cA, 1, false);
        if (wr == 1) PG8_BAR;
        PG8_WAIT_V(2); PG8_BAR;
        PG8_STAGE(PG8_SB(1, 0), cB + kstep, voffB); PG8_STA(PG8_SA(1, 0), cA + kstep, 0, false); PG8_STAGE(PG8_SB(1, 1), cB + hstep + kstep, voffB);
        PG8_WAIT_V(6); PG8_BAR;
    } else {
        PG8_STAGE(PG8_SB(0, 0), cB, voffB); PG8_STA(PG8_SA(0, 0), cA, 0, false); PG8_STAGE(PG8_SB(0, 1), cB + hstep, voffB); PG8_STA(PG8_SA(0, 1), cA, 1, false);
        if (wr == 1) PG8_BAR;
        PG8_WAIT_V(4); PG8_BAR;
        PG8_STAGE(PG8_SB(1, 0), cB + kstep, voffB); PG8_STA(PG8_SA(1, 0), cA + kstep, 0, false); PG8_STAGE(PG8_SB(1, 1), cB + hstep + kstep, voffB);
        PG8_WAIT_V(6); PG8_BAR;
    }
    for (;;) {
        const bool has_next = S.next(ui + 1, nxt);
        const char* nA = (has_next && !GATHER) ? (const char*)g.A + (size_t)nxt.pm * tstep : cA;
        if constexpr (GATHER) { if (has_next) PG8_LOADVG(vgn, nxt.pm); else { _Pragma("unroll") for (int _h = 0; _h < 2; ++_h) _Pragma("unroll") for (int _i = 0; _i < 2; ++_i) vgn[_h][_i] = vg[_h][_i]; } } const char* nB = has_next ? (const char*)g.Bt + (size_t)nxt.pn * tstep : cB;
        for (int t = 0; t < nt; t += 2) {
            const bool last = (t == nt - 2);
            const char* a1 = cA + (size_t)(t + 1) * kstep;
            const char* a2 = last ? nA : cA + (size_t)(t + 2) * kstep; const char* b2 = last ? nB : cB + (size_t)(t + 2) * kstep;
            const char* a3 = a2 + kstep; const char* b3 = b2 + kstep;
            if (last && has_next) S.a_ready(nxt);
            if constexpr (SP2) {
            PG8_LDB(B0, 0, 0); PG8_LDB(B1, 0, 1); PG8_SCHED; PG8_LDA(At, 0, 0); PG8_STA(PG8_SA(1, 1), a1, 1, false);
            PG8_WAIT_V(8); PG8_WAIT_L(0); PG8_BAR; PG8_MMA(0, 0, At, B0); PG8_MMA(0, 1, At, B1); PG8_BAR; PG8_SCHED;
            PG8_LDA(At, 0, 1); PG8_STAGE(PG8_SB(0, 0), b2, voffB); PG8_STAGE(PG8_SB(0, 1), b2 + hstep, voffB); PG8_STA(PG8_SA(0, 0), a2, 0, last);
            PG8_WAIT_V(8); PG8_WAIT_L(0); PG8_BAR; PG8_MMA(1, 0, At, B0); PG8_MMA(1, 1, At, B1); PG8_BAR; PG8_SCHED;
            PG8_LDB(B0, 1, 0); PG8_LDB(B1, 1, 1); PG8_SCHED; PG8_LDA(At, 1, 0); PG8_STA(PG8_SA(0, 1), a2, 1, last);
            PG8_WAIT_V(8); PG8_WAIT_L(0); PG8_BAR; PG8_MMA(0, 0, At, B0); PG8_MMA(0, 1, At, B1); PG8_BAR; PG8_SCHED;
            PG8_LDA(At, 1, 1); PG8_STAGE(PG8_SB(1, 0), b3, voffB); PG8_STAGE(PG8_SB(1, 1), b3 + hstep, voffB); PG8_STA(PG8_SA(1, 0), a3, 0, last);
            PG8_WAIT_V(8); PG8_WAIT_L(0); PG8_BAR; PG8_MMA(1, 0, At, B0); PG8_MMA(1, 1, At, B1); PG8_BAR; PG8_SCHED;
            } else {
            PG8_LDB(B0, 0, 0); PG8_SCHED; PG8_LDA(At, 0, 0); PG8_STA(PG8_SA(1, 1), a1, 1, false);
            PG8_WAIT_L(8); PG8_BAR; PG8_WAIT_L(0); PG8_MMA(0, 0, At, B0); PG8_BAR; PG8_SCHED;
            PG8_LDB(B1, 0, 1); PG8_STAGE(PG8_SB(0, 0), b2, voffB);
            PG8_BAR; PG8_WAIT_L(0); PG8_MMA(0, 1, At, B1); PG8_BAR;
            PG8_LDA(At, 0, 1); PG8_STA(PG8_SA(0, 0), a2, 0, last);
            PG8_BAR; PG8_WAIT_L(0); PG8_MMA(1, 0, At, B0); PG8_BAR; PG8_SCHED;
            PG8_STAGE(PG8_SB(0, 1), b2 + hstep, voffB);
            PG8_WAIT_V(6); PG8_BAR; PG8_MMA(1, 1, At, B1); PG8_BAR;
            PG8_LDB(B0, 1, 0); PG8_SCHED; PG8_LDA(At, 1, 0); PG8_STA(PG8_SA(0, 1), a2, 1, last);
            PG8_WAIT_L(8); PG8_BAR; PG8_WAIT_L(0); PG8_MMA(0, 0, At, B0); PG8_BAR; PG8_SCHED;
            PG8_LDB(B1, 1, 1); PG8_STAGE(PG8_SB(1, 0), b3, voffB);
            PG8_BAR; PG8_WAIT_L(0); PG8_MMA(0, 1, At, B1); PG8_BAR;
            PG8_LDA(At, 1, 1); PG8_STA(PG8_SA(1, 0), a3, 0, last);
            PG8_BAR; PG8_WAIT_L(0); PG8_MMA(1, 0, At, B0); PG8_BAR; PG8_SCHED;
            PG8_STAGE(PG8_SB(1, 1), b3 + hstep, voffB);
            PG8_WAIT_V(6); PG8_BAR; PG8_MMA(1, 1, At, B1); PG8_BAR;
            }
        }
        if constexpr (ALIGN_EPI) { if (wr == 0) PG8_BAR; }
        if constexpr (!Epi::AFTER_DRAIN) { E(acc, cur, wr, wc, fr, fq); S.done(cur); }
        if (!has_next) break;
#pragma unroll
        for (int a = 0; a < 2; ++a)
#pragma unroll
            for (int b = 0; b < 2; ++b)
#pragma unroll
                for (int m = 0; m < 4; ++m)
#pragma unroll
                    for (int n = 0; n < 2; ++n) acc[a][b][m][n] = (f32x4){0.f, 0.f, 0.f, 0.f};
        cur = nxt; cA = nA; cB = nB; ++ui;
        _Pragma("unroll") for (int _h = 0; _h < 2; ++_h) _Pragma("unroll") for (int _i = 0; _i < 2; ++_i) vg[_h][_i] = vgn[_h][_i];
        if constexpr (ALIGN_EPI) { if (wr == 1) PG8_BAR; }
    }
    PG8_WAIT_V(0);
    if constexpr (!ALIGN_EPI) { if (wr == 0) PG8_BAR; }
    PG8_BAR;
    if constexpr (Epi::AFTER_DRAIN) { E.fused(acc, cur, wr, wc, fr, fq, lds, wid, lane); S.done(cur); }
#undef PG8_SA
#undef PG8_SB
#undef PG8_STAGE
#undef PG8_STA
#undef PG8_STAGE_G
#undef PG8_LOADVG
#undef PG8_LDA
#undef PG8_LDB
#undef PG8_MMA
#undef PG8_WAIT_V
#undef PG8_WAIT_L
#undef PG8_BAR
#undef PG8_SCHED
}
}

__device__ __forceinline__ void mod_item(const Params& p, int item, LAS float* sc, LAS float* red, int tid) {
    const int l = item / 192, n0 = (item % 192) * 32, col = tid & 31, kg = tid >> 5;
    const float* W = p.w_mod + (size_t)l * DM * 6144 + n0 + col;
    float acc[9];
#pragma unroll
    for (int r = 0; r < 9; ++r) acc[r] = 0.f;
    float w[64];
#pragma unroll
    for (int kk = 0; kk < 64; ++kk) w[kk] = __builtin_nontemporal_load(W + (size_t)(kg * 64 + kk) * 6144);
#pragma unroll
    for (int kk = 0; kk < 64; ++kk) { const int k = kg * 64 + kk;
#pragma unroll
        for (int r = 0; r < 9; ++r) acc[r] += sc[r * DM + k] * w[kk]; }
#pragma unroll
    for (int r = 0; r < 9; ++r) red[(kg * 9 + r) * 32 + col] = acc[r];
    __syncthreads();
    if (tid < 288) { const int r = tid >> 5; float s = p.b_mod[l * 6144 + n0 + col];
#pragma unroll
        for (int g = 0; g < 16; ++g) s += red[(g * 9 + r) * 32 + col];
        ((float*)(p.ws + WS_MOD))[((size_t)l * 9 + r) * 6144 + n0 + col] = s; }
    __syncthreads();
}
__device__ __forceinline__ void transpose_tile(const float* W, int N, int k0, int n0, bf16_t* dst0  , LAS float* scr, int lane) {
    const float* src = W + (size_t)k0 * N + n0 + 4 * (lane & 15);
    f32x4 v[16];
#pragma unroll
    for (int i = 0; i < 16; ++i) v[i] = __builtin_nontemporal_load((const f32x4*)(src + (size_t)(4 * i + (lane >> 4)) * N));
#pragma unroll
    for (int i = 0; i < 16; ++i) { LAS float* d = scr + (4 * i + (lane >> 4)) * 65 + 4 * (lane & 15); d[0] = v[i].x; d[1] = v[i].y; d[2] = v[i].z; d[3] = v[i].w; }
    asm volatile("s_waitcnt lgkmcnt(0)" ::: "memory");
    const int c = lane & 7;
#pragma unroll
    for (int j = 0; j < 8; ++j) { const int n = (lane >> 3) + 8 * j; const LAS float* s = scr + (8 * c) * 65 + n;
        u32x4 o; o.x = cvt_pk_bf16(s[0], s[65]); o.y = cvt_pk_bf16(s[130], s[195]); o.z = cvt_pk_bf16(s[260], s[325]); o.w = cvt_pk_bf16(s[390], s[455]);
        __builtin_nontemporal_store(o, (u32x4*)(dst0 + (size_t)n * DM + k0 + 8 * c)); }
    asm volatile("s_waitcnt lgkmcnt(0)" ::: "memory");
}
constexpr int CV_IN = 16 * 44, CV_OUT = 256, CV_E = 48 * 256, CV_IL = CV_IN + CV_OUT + CV_E;
constexpr int CV_PER = 4;
constexpr int CV_SLOTS = (256 - 792 % 256) + (256 - 288 % 256) + (256 - 1152 % 256) + (256 - 576 % 256);
static_assert(2 * (16 * 44 + 256 + 48 * 256) - CV_SLOTS * 8 * CV_PER + ((256 - 792 % 256) + (256 - 288 % 256)) * 8 * CV_PER >= (16 * 44 + 256 + 48 * 256) && 2 * (16 * 44 + 256 + 48 * 256) - CV_SLOTS * 8 * CV_PER >= 16 * 44 + 256, "deferred conversion must not postpone weights that layer 0 needs");
__host__ __device__ __forceinline__ int cv_deferred(int G) { return G == 256 ? ((256 - 792 % 256) + (256 - 288 % 256) + (256 - 1152 % 256) + (256 - 576 % 256)) * NWAVE * CV_PER : 0; }
__device__ __forceinline__ void convert_item(const Params& p, int it, LAS float* scr, int lane) {
    const int l = it / CV_IL; int r = it % CV_IL;
    if (r < CV_IN) { const int kt = r / 44, nt = r % 44;
        transpose_tile(p.w_in + (size_t)l * DM * D_IN, D_IN, kt * 64, nt * 64, (bf16_t*)(p.ws + WS_WIN) + ((size_t)l * D_IN + nt * 64) * DM, scr, lane); return; }
    r -= CV_IN;
    if (r < CV_OUT) { const int kt = r / 16, nt = r % 16;
        transpose_tile(p.w_out + (size_t)l * DM * DM, DM, kt * 64, nt * 64, (bf16_t*)(p.ws + WS_WOUT) + ((size_t)l * DM + nt * 64) * DM, scr, lane); return; }
    r -= CV_OUT;
    const int mtx = r >> 8, t = r & 255, e = mtx / 3, which = mtx % 3, kt = t >> 4, nt = t & 15, n0 = nt * 64;
    const size_t eo = ((size_t)l * NE + e) * DM * DM;
    if (which == 2) transpose_tile(p.w_down + eo, DM, kt * 64, n0, (bf16_t*)(p.ws + WS_WD) + eo + (size_t)n0 * DM, scr, lane);
    else { const int row = (n0 >> 7) * 256 + (n0 & 127) + which * 128;
        transpose_tile((which == 0 ? p.w_gate : p.w_up) + eo, DM, kt * 64, n0, (bf16_t*)(p.ws + WS_WGU) + 2 * eo + (size_t)row * DM, scr, lane); }
}
__device__ __forceinline__ void phase0(const Params& p, LAS unsigned char* lds, int bid, int G, int tid) {
    const int lane = tid & 63, wave = __builtin_amdgcn_readfirstlane(tid >> 6);
    {
        LAS float* sc = (LAS float*)lds; LAS float* red = (LAS float*)(lds + 9 * DM * 4);
        if (bid < 384) {
            { float cv[18];
#pragma unroll
                for (int it = 0; it < 18; ++it) { const int i = tid + it * NTHR; const int r = i >> 10, k = i & 1023; cv[it] = r < 8 ? p.c[r * DM + k] : p.c_ctx[k]; }
#pragma unroll
                for (int it = 0; it < 18; ++it) sc[tid + it * NTHR] = cv[it] * sigmoid_f(cv[it]); }
            __syncthreads();
            for (int it = bid; it < 384; it += G) mod_item(p, it, sc, red, tid);
        }
        __syncthreads();
    }
    LAS float* scr = (LAS float*)(lds + wave * 16640);
    const int gw = bid * NWAVE + wave, NGW = G * NWAVE;
    const int n_now = NL * CV_IL - cv_deferred(G);
    for (int it = gw; it < n_now; it += NGW) convert_item(p, it, scr, lane);
}
__device__ __forceinline__ void convert_deferred(const Params& p, LAS unsigned char* lds, int slot, int nunits, int bid, int G, int tid) {
    if (G != 256) return;
    const int lane = tid & 63, wave = __builtin_amdgcn_readfirstlane(tid >> 6);
    const int nfull = nunits % G; if (bid < nfull) return;
    int base = NL * CV_IL - cv_deferred(G);
    if (slot >= 1) base += (G - 792 % 256) * NWAVE * CV_PER;
    if (slot >= 2) base += (G - 288 % 256) * NWAVE * CV_PER;
    if (slot >= 3) base += (G - 1152 % 256) * NWAVE * CV_PER;
    const int it0 = base + ((bid - nfull) * NWAVE + wave) * CV_PER;
    convert_item(p, it0, (LAS float*)(lds + wave * 16640), lane);
    __builtin_amdgcn_sched_barrier(0);
    convert_item(p, it0 + 1, (LAS float*)(lds + wave * 16640), lane);
    __builtin_amdgcn_sched_barrier(0);
    convert_item(p, it0 + 2, (LAS float*)(lds + wave * 16640), lane);
    __builtin_amdgcn_sched_barrier(0);
    convert_item(p, it0 + 3, (LAS float*)(lds + wave * 16640), lane);
}

__device__ __forceinline__ void phaseA(const Params& p, int bid, int G, int tid) {
    const int lane = tid & 63, gw = bid * NWAVE + __builtin_amdgcn_readfirstlane(tid >> 6), NGW = G * NWAVE;
    const float* MOD = (const float*)(p.ws + WS_MOD); bf16_t* H = (bf16_t*)(p.ws + WS_R3);
    for (int row = gw; row < T_ALL; row += NGW) {
        const float* xr = row < T_LAT ? p.x + (size_t)row * DM : p.ctx + (size_t)(row - T_LAT) * DM;
        const float* md = MOD + (size_t)mod_row_of(row) * 6144;
        f32x4 v[4], sh[4], sc[4]; ld_row_nt(v, xr, lane); ld_row(sh, md, lane); ld_row(sc, md + DM, lane);
        ln16(v, lane);
#pragma unroll
        for (int j = 0; j < 4; ++j) v[j] = v[j] * (sc[j] + 1.f) + sh[j];
        st_row_bf16(H + (size_t)row * DM, v, lane);
    }
}

constexpr int KRS = 144, VRS = 160;
constexpr int LDS_RPB = 768 * KRS, LDS_MRG = 768 * VRS;
static_assert(LDS_MRG + 4 * 64 * 18 * 4 <= LDS_BYTES && LDS_RPB + 465 * 4 <= LDS_MRG, "attention LDS map");

struct AttnGeo { int b, h, r, rs, bandbase, ctxbase; };
template <bool CTXQ> __device__ __forceinline__ AttnGeo attn_geo(int item) {
    AttnGeo q;
    if (!CTXQ) { q.b = item >> 8; q.r = (item >> 3) & 31; q.h = item & 7; int rs = q.r - 4; rs = rs < 0 ? 0 : (rs > 24 ? 24 : rs); q.rs = rs; q.bandbase = q.b * SEQ + rs * 64; q.ctxbase = T_LAT + q.b * CTXL; }
    else { q.b = item >> 4; q.h = (item >> 1) & 7; q.r = item & 1; q.rs = 0; q.bandbase = 0; q.ctxbase = T_LAT + q.b * CTXL; }
    return q;
}
template <bool CTXQ, int P0, int P1> __device__ __forceinline__ void attn_load_rows(u32x4 (&t)[P1 - P0], const bf16_t* U, const AttnGeo& q, int col, int tid) {
    const int chunk = tid & 7, r0 = tid >> 3;
#pragma unroll
    for (int ps = P0; ps < P1; ++ps) { const int row = ps * 64 + r0; const int tok = (!CTXQ && row < 512) ? q.bandbase + row : q.ctxbase + row - (CTXQ ? 0 : 512);
        t[ps - P0] = *(const u32x4*)(U + (size_t)tok * D_IN + col + q.h * 64 + chunk * 8); }
}
template <int RS, int P0, int P1> __device__ __forceinline__ void attn_store_rows(const u32x4 (&t)[P1 - P0], LAS unsigned char* lds, int tid) {
    const int chunk = tid & 7, r0 = tid >> 3;
#pragma unroll
    for (int ps = P0; ps < P1; ++ps) *(LAS u32x4*)(lds + (ps * 64 + r0) * RS + chunk * 16) = t[ps - P0];
}
template <bool CTXQ> __device__ __forceinline__ void attn_run(const Params& p, int l, int n_items, LAS unsigned char* lds, int bid, int G, int tid) {
    int it = bid; if (it >= n_items) return;
    const int wave = __builtin_amdgcn_readfirstlane(tid >> 6);
    const bf16_t* U = (const bf16_t*)(p.ws + WS_R1); bf16_t* MIX = (bf16_t*)(p.ws + WS_R3);
    const int qi = wave & 3, kh = wave >> 2;
    const bool band = (!CTXQ) && kh == 0;
    int cw = 16 * qi - 8; cw = cw < 0 ? 0 : (cw > 32 ? 32 : cw);
    const int base0 = CTXQ ? 0 : 512;
    AttnGeo cur = attn_geo<CTXQ>(it);
    constexpr int NR = CTXQ ? 4 : 12, NKP = CTXQ ? 4 : 8;
    u32x4 tk[NKP], tv[NR];
    attn_load_rows<CTXQ, 0, NKP>(tk, U, cur, OFF_K, tid);
    const int tid_outer = tid;
    for (;;) {
        int tid = tid_outer; asm volatile("" : "+v"(tid));
        const int lane = tid & 63, fr = lane & 15, g = lane >> 4, qq = fr >> 2, pp = fr & 3;
        const int qtok = CTXQ ? (cur.ctxbase + cur.r * 128 + wave * 16 + fr) : (cur.b * SEQ + cur.r * 64 + 16 * qi + fr);
        if constexpr (!CTXQ) { u32x4 tc[4]; attn_load_rows<CTXQ, 8, 12>(tc, U, cur, OFF_K, tid); attn_store_rows<KRS, 0, 8>(tk, lds, tid); attn_store_rows<KRS, 8, 12>(tc, lds, tid); }
        else attn_store_rows<KRS, 0, 4>(tk, lds, tid);
        if (!CTXQ && tid < 481) ((LAS float*)(lds + LDS_RPB))[tid < 465 ? (tid % 31) * 15 + tid / 31 : tid] = tid < 465 ? p.na_rpb[((size_t)l * 8 + cur.h) * 465 + tid] : -1e30f;
        attn_load_rows<CTXQ, 0, NR>(tv, U, cur, OFF_V, tid);
        bf16x8 qf[2];
#pragma unroll
        for (int ks = 0; ks < 2; ++ks) qf[ks] = *(const bf16x8*)(U + (size_t)qtok * D_IN + OFF_Q + cur.h * 64 + 32 * ks + 8 * g);
        __syncthreads();
        f32x4 s[16];
#pragma unroll
        for (int t = 0; t < 16; ++t) {
            const int rb = band ? ((t >> 1) * 64 + cw + 16 * (t & 1)) : (base0 + 16 * t);
            f32x4 a = {0.f, 0.f, 0.f, 0.f};
#pragma unroll
            for (int ks = 0; ks < 2; ++ks) { const bf16x8 kf = *(const LAS bf16x8*)(lds + (rb + fr) * KRS + (32 * ks + 8 * g) * 2);
                a = __builtin_amdgcn_mfma_f32_16x16x32_bf16(kf, qf[ks], a, 0, 0, 0); }
            s[t] = a;
            if ((t & 3) == 3) __builtin_amdgcn_sched_barrier(0);
        }
        if (band) {
            const LAS float* tab = (const LAS float*)(lds + LDS_RPB);
            const int qcol = 16 * qi + fr; int cs = qcol - 8; cs = cs < 0 ? 0 : (cs > 48 ? 48 : cs);
            const int drow0 = cur.rs - cur.r + 7;
#pragma unroll
            for (int tp = 0; tp < 2; ++tp)
#pragma unroll
                for (int j = 0; j < 4; ++j) { const int kcol = cw + 16 * tp + 4 * g + j; int dc = kcol - qcol + 15; dc = dc < 0 ? 0 : (dc > 30 ? 30 : dc);
                    const bool ok = kcol >= cs && kcol < cs + 16; const LAS float* bp = tab + (ok ? dc * 15 + drow0 : 465);
#pragma unroll
                    for (int w = 0; w < 8; ++w) s[2 * w + tp][j] += bp[w]; }
        }
        float m = -3e38f;
#pragma unroll
        for (int t = 0; t < 16; ++t) m = fmaxf(m, fmaxf(fmaxf(s[t][0], s[t][1]), fmaxf(s[t][2], s[t][3])));
        m = fmaxf(m, shx(m, 16, lane)); m = fmaxf(m, shx(m, 32, lane));
        float lsum = 0.f; const float mb = m * LOG2E;
        bf16x8 pf[8];
#pragma unroll
        for (int c = 0; c < 8; ++c) {
            float e[8];
#pragma unroll
            for (int j = 0; j < 4; ++j) { e[j] = __builtin_amdgcn_exp2f(s[2 * c][j] * LOG2E - mb); e[4 + j] = __builtin_amdgcn_exp2f(s[2 * c + 1][j] * LOG2E - mb); }
#pragma unroll
            for (int j = 0; j < 8; ++j) lsum += e[j];
            u32x4 w; w.x = cvt_pk_bf16(e[0], e[1]); w.y = cvt_pk_bf16(e[2], e[3]); w.z = cvt_pk_bf16(e[4], e[5]); w.w = cvt_pk_bf16(e[6], e[7]);
            pf[c] = __builtin_bit_cast(bf16x8, w);
        }
        lsum += shx(lsum, 16, lane); lsum += shx(lsum, 32, lane);
        __syncthreads();
        attn_store_rows<VRS, 0, NR>(tv, lds, tid);
        const int nit = it + G; const bool has_next = nit < n_items;
        AttnGeo nxt = cur;
        if (has_next) { nxt = attn_geo<CTXQ>(nit); attn_load_rows<CTXQ, 0, NKP>(tk, U, nxt, OFF_K, tid); }
        __syncthreads();
        f32x4 o[4];
#pragma unroll
        for (int nd = 0; nd < 4; ++nd) o[nd] = (f32x4){0.f, 0.f, 0.f, 0.f};
#pragma unroll
        for (int c = 0; c < 8; ++c) {
            const int rb0 = band ? (c * 64 + cw) : (base0 + 32 * c);
            const LAS unsigned char* a0 = lds + (rb0 + 4 * g + qq) * VRS + 8 * pp;
            const LAS unsigned char* a1 = a0 + 16 * VRS;
#pragma unroll
            for (int nd = 0; nd < 4; ++nd) {
                const s16x4 lo = __builtin_amdgcn_ds_read_tr16_b64_v4i16((LAS s16x4*)(a0 + 32 * nd));
                const s16x4 hi = __builtin_amdgcn_ds_read_tr16_b64_v4i16((LAS s16x4*)(a1 + 32 * nd));
                const bf16x8 vf = (bf16x8){lo[0], lo[1], lo[2], lo[3], hi[0], hi[1], hi[2], hi[3]};
                o[nd] = __builtin_amdgcn_mfma_f32_16x16x32_bf16(vf, pf[c], o[nd], 0, 0, 0);
            }
            if (c & 1) __builtin_amdgcn_sched_barrier(0);
        }
        bf16_t* orow = MIX + (size_t)qtok * DM + 512 + cur.h * 64 + 4 * g;
        if (CTXQ) {
            const float inv = 1.f / lsum;
#pragma unroll
            for (int nd = 0; nd < 4; ++nd) { u32x2 w; w.x = cvt_pk_bf16(o[nd][0] * inv, o[nd][1] * inv); w.y = cvt_pk_bf16(o[nd][2] * inv, o[nd][3] * inv); *(u32x2*)(orow + 16 * nd) = w; }
            __syncthreads();
        } else {
            LAS float* mg = (LAS float*)(lds + LDS_MRG) + qi * (64 * 18);
            if (kh == 1) { mg[lane] = m; mg[64 + lane] = lsum;
#pragma unroll
                for (int nd = 0; nd < 4; ++nd)
#pragma unroll
                    for (int j = 0; j < 4; ++j) mg[(2 + nd * 4 + j) * 64 + lane] = o[nd][j]; }
            __syncthreads();
            if (kh == 0) { const float m1 = mg[lane], l1 = mg[64 + lane]; const float mm = fmaxf(m, m1);
                const float a0 = __builtin_amdgcn_exp2f((m - mm) * LOG2E), a1 = __builtin_amdgcn_exp2f((m1 - mm) * LOG2E);
                const float inv = 1.f / (lsum * a0 + l1 * a1);
#pragma unroll
                for (int nd = 0; nd < 4; ++nd) { float r4[4];
#pragma unroll
                    for (int j = 0; j < 4; ++j) r4[j] = (o[nd][j] * a0 + mg[(2 + nd * 4 + j) * 64 + lane] * a1) * inv;
                    u32x2 w; w.x = cvt_pk_bf16(r4[0], r4[1]); w.y = cvt_pk_bf16(r4[2], r4[3]); *(u32x2*)(orow + 16 * nd) = w; } }
        }
        if (!has_next) break;
        cur = nxt; it = nit;
    }
    __syncthreads();
}

__device__ __forceinline__ void conv_item(const Params& p, int l, int tile, LAS unsigned char* lds, int tid) {
    const bf16_t* U = (const bf16_t*)(p.ws + WS_R1); bf16_t* MIX = (bf16_t*)(p.ws + WS_R3);
    const int t0 = tile * 64; int s0, s1;
    if (t0 < T_LAT) { s0 = t0 & ~(SEQ - 1); s1 = s0 + SEQ; } else { s0 = T_LAT + ((t0 - T_LAT) & ~(CTXL - 1)); s1 = s0 + CTXL; }
    {
        const int c8 = (tid & 31) * 8, tg = tid >> 5;
        const float* ws_ = p.w_short + (size_t)l * 3 * 256 + c8;
        float w0[8], w1[8], w2[8];
#pragma unroll
        for (int i = 0; i < 8; ++i) { w0[i] = ws_[i]; w1[i] = ws_[256 + i]; w2[i] = ws_[512 + i]; }
        float pr[6][8];
#pragma unroll
        for (int q = 0; q < 6; ++q) { const int t = t0 + tg * 4 + q - 1;
            if (t >= s0 && t < s1) { const u32x4 cgv = *(const u32x4*)(U + (size_t)t * D_IN + OFF_A + 256 + c8), xv = *(const u32x4*)(U + (size_t)t * D_IN + OFF_A + 512 + c8);
#pragma unroll
                for (int i = 0; i < 4; ++i) { pr[q][2 * i] = bflo(cgv[i]) * bflo(xv[i]); pr[q][2 * i + 1] = bfhi(cgv[i]) * bfhi(xv[i]); } }
            else {
#pragma unroll
                for (int i = 0; i < 8; ++i) pr[q][i] = 0.f; } }
#pragma unroll
        for (int q = 0; q < 4; ++q) { const int t = t0 + tg * 4 + q; const u32x4 bgv = *(const u32x4*)(U + (size_t)t * D_IN + OFF_A + c8);
            float r8[8];
#pragma unroll
            for (int i = 0; i < 4; ++i) { r8[2 * i] = bflo(bgv[i]) * (w0[2 * i] * pr[q][2 * i] + w1[2 * i] * pr[q + 1][2 * i] + w2[2 * i] * pr[q + 2][2 * i]);
                r8[2 * i + 1] = bfhi(bgv[i]) * (w0[2 * i + 1] * pr[q][2 * i + 1] + w1[2 * i + 1] * pr[q + 1][2 * i + 1] + w2[2 * i + 1] * pr[q + 2][2 * i + 1]); }
            u32x4 w; w.x = cvt_pk_bf16(r8[0], r8[1]); w.y = cvt_pk_bf16(r8[2], r8[3]); w.z = cvt_pk_bf16(r8[4], r8[5]); w.w = cvt_pk_bf16(r8[6], r8[7]);
            *(u32x4*)(MIX + (size_t)t * DM + c8) = w; }
    }
    LAS float* hs = (LAS float*)lds;
    {
        u32x4 av[6], gv[6];
#pragma unroll
        for (int k = 0; k < 6; ++k) { const int q = tid + k * NTHR; const int rr = q >> 5, c8 = (q & 31) * 8, t = t0 - 15 + rr;
            av[k] = (u32x4){0u, 0u, 0u, 0u}; gv[k] = (u32x4){0u, 0u, 0u, 0u};
            if (q < 94 * 32 && t >= s0 && t < s1) { av[k] = *(const u32x4*)(U + (size_t)t * D_IN + OFF_B + c8); gv[k] = *(const u32x4*)(U + (size_t)t * D_IN + OFF_B + 256 + c8); } }
#pragma unroll
        for (int k = 0; k < 6; ++k) { const int q = tid + k * NTHR; const int rr = q >> 5, c8 = (q & 31) * 8;
            if (q < 94 * 32) { f32x4 lo, hi;
                lo[0] = bflo(av[k][0]) * sigmoid_f(bflo(gv[k][0])); lo[1] = bfhi(av[k][0]) * sigmoid_f(bfhi(gv[k][0])); lo[2] = bflo(av[k][1]) * sigmoid_f(bflo(gv[k][1])); lo[3] = bfhi(av[k][1]) * sigmoid_f(bfhi(gv[k][1]));
                hi[0] = bflo(av[k][2]) * sigmoid_f(bflo(gv[k][2])); hi[1] = bfhi(av[k][2]) * sigmoid_f(bfhi(gv[k][2])); hi[2] = bflo(av[k][3]) * sigmoid_f(bflo(gv[k][3])); hi[3] = bfhi(av[k][3]) * sigmoid_f(bfhi(gv[k][3]));
                *(LAS f32x4*)(hs + rr * 256 + c8) = lo; *(LAS f32x4*)(hs + rr * 256 + c8 + 4) = hi; } }
    }
    __syncthreads();
    {
        const int c = tid & 255, half = __builtin_amdgcn_readfirstlane(tid >> 8);
        float w[31];
#pragma unroll
        for (int j = 0; j < 31; ++j) w[j] = p.w_conf_dw[((size_t)l * 31 + j) * 256 + c];
        float acc[32]; const float bd = p.b_conf_dw[l * 256 + c];
#pragma unroll
        for (int o = 0; o < 32; ++o) acc[o] = bd;
#pragma unroll
        for (int i = 0; i < 62; ++i) { const float v = hs[(32 * half + i) * 256 + c];
#pragma unroll
            for (int o = 0; o < 32; ++o) { if (i - o >= 0 && i - o <= 30) acc[o] += w[i - o] * v; } }
        __syncthreads();
#pragma unroll
        for (int o = 0; o < 32; ++o) hs[(32 * half + o) * 256 + c] = acc[o];
    }
    __syncthreads();
    {
        const int lane = tid & 63, wave = __builtin_amdgcn_readfirstlane(tid >> 6);
        const f32x4 gl = *(const f32x4*)(p.g_conf_ln + l * 256 + 4 * lane), bl = *(const f32x4*)(p.b_conf_ln + l * 256 + 4 * lane);
#pragma unroll
        for (int q = 0; q < 8; ++q) { const int tt = wave * 8 + q; f32x4 v = *(const LAS f32x4*)(hs + tt * 256 + 4 * lane);
            const float mean = wave_sum_bp((v.x + v.y) + (v.z + v.w), lane) * (1.f / 256.f); v = v - mean;
            const float var = wave_sum_bp((v.x * v.x + v.y * v.y) + (v.z * v.z + v.w * v.w), lane) * (1.f / 256.f);
            const float rstd = 1.f / sqrtf(var + LN_EPS); v = v * rstd * gl + bl;
            u32x2 w; w.x = cvt_pk_bf16(v.x * sigmoid_f(v.x), v.y * sigmoid_f(v.y)); w.y = cvt_pk_bf16(v.z * sigmoid_f(v.z), v.w * sigmoid_f(v.w));
            *(u32x2*)(MIX + (size_t)(t0 + tt) * DM + 256 + 4 * lane) = w; }
    }
    __syncthreads();
}
__device__ __forceinline__ void phaseC(const Params& p, int l, LAS unsigned char* lds, int bid, int G, int tid, int csel) {
    const int n_att = NB * 32 * 8, n_catt = (l == 0) ? NB * 8 * 2 : 0, n_conv = (l == 0 ? T_ALL : T_LAT) / 64;
    if (csel & 1) attn_run<false>(p, l, n_att, lds, bid, G, tid);
    if ((csel & 2) && n_catt) attn_run<true>(p, l, n_catt, lds, bid, G, tid);
    if (csel & 4) for (int it = G - 1 - bid; it < n_conv; it += G) conv_item(p, l, it, lds, tid);
}

template <bool L0> __device__ __forceinline__ void phaseE(const Params& p, int l, LAS unsigned char* lds, int bid, int G, int tid) {
    const int lane = tid & 63, gw = bid * NWAVE + __builtin_amdgcn_readfirstlane(tid >> 6), NGW = G * NWAVE;
    const int nrow = (l == 0) ? T_ALL : T_LAT;
    LAS float* wr = (LAS float*)lds;
    {
        float wv[32];
#pragma unroll
        for (int it = 0; it < 32; ++it) wv[it] = p.w_router[(size_t)l * DM * 16 + tid + it * NTHR];
#pragma unroll
        for (int it = 0; it < 32; ++it) { const int q = tid + it * NTHR; const int k = q >> 4, e = q & 15; const int j = k >> 8, ln = (k >> 2) & 63, i = k & 3;
            wr[((((j * 4 + i) * 4) + (e >> 2)) * 64 + ln) * 4 + (e & 3)] = wv[it]; }
    }
    __syncthreads();
    const float* MOD = (const float*)(p.ws + WS_MOD) + (size_t)l * 9 * 6144;
    const bf16_t* Y = (const bf16_t*)(p.ws + WS_R2); const bf16_t* XS = (const bf16_t*)(p.ws + WS_XB); bf16_t* XM = (bf16_t*)(p.ws + WS_XB + SZ_R3); bf16_t* HM = (bf16_t*)(p.ws + WS_R3); float* AFF = (float*)(p.ws + WS_AFF);
    const float* g1 = p.g_post1 + l * DM; const float* b1 = p.b_post1 + l * DM;
    f32x4 xf[2][4]; u32x2 xh[2][4], yh[2][4];
#define E_PREFETCH(R0) do { _Pragma("unroll") for (int r = 0; r < 2; ++r) { int row = (R0) + r * NGW; row = row < nrow ? row : (R0); \
        if (L0) { const float* xr = row < T_LAT ? p.x + (size_t)row * DM : p.ctx + (size_t)(row - T_LAT) * DM; _Pragma("unroll") for (int j = 0; j < 4; ++j) xf[r][j] = __builtin_nontemporal_load((const f32x4*)(xr + 256 * j + 4 * lane)); } \
        else { _Pragma("unroll") for (int j = 0; j < 4; ++j) xh[r][j] = __builtin_nontemporal_load((const u32x2*)(XS + (size_t)row * DM + 256 * j + 4 * lane)); } \
        _Pragma("unroll") for (int j = 0; j < 4; ++j) yh[r][j] = __builtin_nontemporal_load((const u32x2*)(Y + (size_t)row * DM + 256 * j + 4 * lane)); } } while (0)
    E_PREFETCH(gw);
    for (int row0 = gw; row0 < nrow; row0 += 2 * NGW) {
        int rows[2]; rows[0] = row0; rows[1] = (row0 + NGW < nrow) ? row0 + NGW : row0; asm volatile("" : "+s"(rows[1]));
        f32x4 v[2][4], y[2][4], t[2][4], u[2][4];
        const float* md[2];
#pragma unroll
        for (int r = 0; r < 2; ++r) { md[r] = MOD + (size_t)mod_row_of(rows[r]) * 6144; ld_row(t[r], md[r] + 2 * DM, lane);
#pragma unroll
            for (int j = 0; j < 4; ++j) { if (L0) v[r][j] = xf[r][j]; else v[r][j] = (f32x4){bflo(xh[r][j].x), bfhi(xh[r][j].x), bflo(xh[r][j].y), bfhi(xh[r][j].y)};
                y[r][j] = (f32x4){bflo(yh[r][j].x), bfhi(yh[r][j].x), bflo(yh[r][j].y), bfhi(yh[r][j].y)}; } }
        { const int nr0 = row0 + 2 * NGW < nrow ? row0 + 2 * NGW : row0; E_PREFETCH(nr0); }
#pragma unroll
        for (int r = 0; r < 2; ++r) {
#pragma unroll
            for (int j = 0; j < 4; ++j) v[r][j] = v[r][j] * ALPHA + (t[r][j] + 1.f) * y[r][j]; }
        ld_row(y[0], g1, lane); ld_row(y[1], b1, lane);
#pragma unroll
        for (int r = 0; r < 2; ++r) ln16(v[r], lane);
#pragma unroll
        for (int r = 0; r < 2; ++r) {
#pragma unroll
            for (int j = 0; j < 4; ++j) v[r][j] = v[r][j] * y[0][j] + y[1][j];
            st_row_bf16_nt(XM + (size_t)rows[r] * DM, v[r], lane);
            ld_row(t[r], md[r] + 3 * DM, lane); ld_row(u[r], md[r] + 4 * DM, lane); }
#pragma unroll
        for (int r = 0; r < 2; ++r) ln16(v[r], lane);
#pragma unroll
        for (int r = 0; r < 2; ++r) {
#pragma unroll
            for (int j = 0; j < 4; ++j) v[r][j] = v[r][j] * (u[r][j] + 1.f) + t[r][j];
            st_row_bf16(HM + (size_t)rows[r] * DM, v[r], lane); }
        typedef float f32x2 __attribute__((ext_vector_type(2)));
        f32x2 acc2[16];
#pragma unroll
        for (int e = 0; e < 16; ++e) acc2[e] = (f32x2){0.f, 0.f};
#pragma unroll
        for (int j = 0; j < 4; ++j) {
#pragma unroll
            for (int i = 0; i < 4; ++i) { const f32x2 hv = {v[0][j][i], v[1][j][i]};
#pragma unroll
                for (int eq = 0; eq < 4; ++eq) { const f32x4 w4 = *(const LAS f32x4*)(wr + (((j * 4 + i) * 4 + eq) * 64 + lane) * 4);
#pragma unroll
                    for (int ee = 0; ee < 4; ++ee) acc2[4 * eq + ee] += hv * (f32x2){w4[ee], w4[ee]}; } }
            __builtin_amdgcn_sched_barrier(0); }
#pragma unroll
        for (int r = 0; r < 2; ++r) {
            f32x4 a[4];
#pragma unroll
            for (int eq = 0; eq < 4; ++eq) a[eq] = (f32x4){acc2[4 * eq][r], acc2[4 * eq + 1][r], acc2[4 * eq + 2][r], acc2[4 * eq + 3][r]};
            float x8[8], x4[4], x2[2], x1;
            const bool b5 = (lane & 32) != 0, b4 = (lane & 16) != 0, b3 = (lane & 8) != 0, b2 = (lane & 4) != 0;
#pragma unroll
            for (int k = 0; k < 8; ++k) { const float lo = a[k >> 2][k & 3], hi = a[2 + (k >> 2)][k & 3]; x8[k] = (b5 ? hi : lo) + shx(b5 ? lo : hi, 32, lane); }
#pragma unroll
            for (int k = 0; k < 4; ++k) x4[k] = (b4 ? x8[4 + k] : x8[k]) + shx(b4 ? x8[k] : x8[4 + k], 16, lane);
#pragma unroll
            for (int k = 0; k < 2; ++k) x2[k] = (b3 ? x4[2 + k] : x4[k]) + shx(b3 ? x4[k] : x4[2 + k], 8, lane);
            x1 = (b2 ? x2[1] : x2[0]) + shx(b2 ? x2[0] : x2[1], 4, lane);
            x1 += shx(x1, 2, lane); x1 += shx(x1, 1, lane);
            float mx = x1;
            mx = fmaxf(mx, shx(mx, 4, lane)); mx = fmaxf(mx, shx(mx, 8, lane)); mx = fmaxf(mx, shx(mx, 16, lane)); mx = fmaxf(mx, shx(mx, 32, lane));
            const float ex = __expf(x1 - mx); float sum = ex;
            sum += shx(sum, 4, lane); sum += shx(sum, 8, lane); sum += shx(sum, 16, lane); sum += shx(sum, 32, lane);
            if ((lane & 3) == 0) AFF[(size_t)rows[r] * 16 + (lane >> 2)] = ex / sum;
        }
    }
    __syncthreads();
}

#undef E_PREFETCH
__device__ __forceinline__ void phaseF(const Params& p, int l, LAS unsigned char* lds, int bid, int G, int tid) {
    const float* AFF = (const float*)(p.ws + WS_AFF); int* SLOT = (int*)(p.ws + WS_SLOT);
    int* TOK = (int*)(p.ws + WS_TOK);
    LAS unsigned* red = (LAS unsigned*)lds;
    LAS unsigned* wtot = (LAS unsigned*)(lds + 64);
    const int n_lat = NB * NE, n_ctx = (l == 0) ? NB * NE : 0;
    const int lane = tid & 63, wave = __builtin_amdgcn_readfirstlane(tid >> 6);
    for (int it = bid; it < n_lat + n_ctx; it += G) {
        int b, e, ntok, cap, tokbase, dstbase;
        if (it < n_lat) { b = it >> 4; e = it & 15; ntok = SEQ; cap = CAP_L; tokbase = b * SEQ; dstbase = e * ROWS_E + b * CAP_L; }
        else { const int i2 = it - n_lat; b = i2 >> 4; e = i2 & 15; ntok = CTXL; cap = CAP_C; tokbase = T_LAT + b * CTXL; dstbase = e * ROWS_E + NB * CAP_L + b * CAP_C; }
        unsigned k[4];
#pragma unroll
        for (int i = 0; i < 4; ++i) { const int t = 4 * tid + i; k[i] = t < ntok ? __builtin_bit_cast(unsigned, AFF[(size_t)(tokbase + t) * 16 + e]) : 0u; }
        unsigned thr = 0u;
        for (int bit = 30; bit >= 0; --bit) {
            const unsigned cand = thr | (1u << bit); unsigned c = 0u;
#pragma unroll
            for (int i = 0; i < 4; ++i) c += (unsigned)__popcll(__ballot(k[i] >= cand));
            const int par = bit & 1;
            if (lane == 0) red[par * 8 + wave] = c;
            __syncthreads();
            unsigned tot = 0u;
#pragma unroll
            for (int w = 0; w < 8; ++w) tot += red[par * 8 + w];
            if (tot >= (unsigned)cap) thr = cand;
        }
        unsigned ng = 0u, ne = 0u;
#pragma unroll
        for (int i = 0; i < 4; ++i) { ng += (k[i] > thr) ? 1u : 0u; ne += (k[i] == thr) ? 1u : 0u; }
        const unsigned v = ng | (ne << 16); unsigned inc = v;
#pragma unroll
        for (int o = 1; o < 64; o <<= 1) { const unsigned u = (unsigned)__builtin_amdgcn_ds_bpermute((lane - o) << 2, (int)inc); if (lane >= o) inc += u; }
        if (lane == 63) wtot[wave] = inc;
        __syncthreads();
        unsigned off = 0u, total = 0u;
#pragma unroll
        for (int w = 0; w < 8; ++w) { const unsigned x = wtot[w]; if (w < wave) off += x; total += x; }
        const unsigned exc = off + inc - v;
        unsigned gb = exc & 0xFFFFu, eb = exc >> 16; const unsigned need = (unsigned)cap - (total & 0xFFFFu);
#pragma unroll
        for (int i = 0; i < 4; ++i) { const int t = 4 * tid + i;
            if (t < ntok) { const bool gt = k[i] > thr, eq = k[i] == thr; const bool sel = gt || (eq && eb < need);
                const unsigned slot = gb + (eb < need ? eb : need);
                SLOT[(size_t)(tokbase + t) * 16 + e] = sel ? (int)slot : -1;
                if (sel) TOK[dstbase + slot] = tokbase + t;
                gb += gt ? 1u : 0u; eb += eq ? 1u : 0u; } }
        __syncthreads();
    }
}

__device__ __forceinline__ void phaseI(const Params& p, int l, int bid, int G, int tid) {
    const int lane = tid & 63, gw = bid * NWAVE + __builtin_amdgcn_readfirstlane(tid >> 6), NGW = G * NWAVE;
    const bool last = (l == NL - 1); const int nrow = (l == 0) ? T_ALL : T_LAT;
    const float* MOD = (const float*)(p.ws + WS_MOD) + (size_t)l * 9 * 6144;
    const float* AFF = (const float*)(p.ws + WS_AFF); const int* SLOT = (const int*)(p.ws + WS_SLOT);
    const bf16_t* YE = (const bf16_t*)(p.ws + WS_R1); bf16_t* XS = (bf16_t*)(p.ws + WS_XB); const bf16_t* XM = (const bf16_t*)(p.ws + WS_XB + SZ_R3); bf16_t* H = (bf16_t*)(p.ws + WS_R3);
    const float* g2 = p.g_post2 + l * DM; const float* b2 = p.b_post2 + l * DM;
    for (int row0 = gw; row0 < nrow; row0 += 2 * NGW) {
        int rows[2]; rows[0] = row0; rows[1] = (row0 + NGW < nrow) ? row0 + NGW : row0; asm volatile("" : "+s"(rows[1]));
        int sl[2], rbase[2]; float af[2]; unsigned mask[2]; const float* md[2];
        f32x4 v[2][4], t[2][4], ym[2][4];
#pragma unroll
        for (int r = 0; r < 2; ++r) { const int row = rows[r];
            sl[r] = SLOT[(size_t)row * 16 + (lane & 15)]; af[r] = AFF[(size_t)row * 16 + (lane & 15)];
            rbase[r] = row < T_LAT ? (row >> 11) * CAP_L : NB * CAP_L + ((row - T_LAT) >> 8) * CAP_C;
            md[r] = MOD + (size_t)mod_row_of(row) * 6144;
            ld_row_bf16_nt(v[r], XM + (size_t)row * DM, lane); ld_row(t[r], md[r] + 5 * DM, lane);
#pragma unroll
            for (int j = 0; j < 4; ++j) ym[r][j] = (f32x4){0.f, 0.f, 0.f, 0.f}; }
#pragma unroll
        for (int r = 0; r < 2; ++r) mask[r] = (unsigned)(__ballot(sl[r] >= 0) & 0xFFFFull);
        while (mask[0] | mask[1]) {
            u32x2 w[2][3][4]; float aa[2][3];
#pragma unroll
            for (int r = 0; r < 2; ++r)
#pragma unroll
                for (int q = 0; q < 3; ++q) { int e = 0, s_ = 0; float a_ = 0.f;
                    if (mask[r]) { e = __builtin_ctz(mask[r]); mask[r] &= mask[r] - 1u; s_ = __builtin_amdgcn_readlane(sl[r], e); a_ = __builtin_bit_cast(float, __builtin_amdgcn_readlane(__builtin_bit_cast(int, af[r]), e)); }
                    aa[r][q] = a_; const bf16_t* yr = YE + ((size_t)e * ROWS_E + rbase[r] + s_) * DM + 4 * lane;
#pragma unroll
                    for (int j = 0; j < 4; ++j) w[r][q][j] = __builtin_nontemporal_load((const u32x2*)(yr + 256 * j)); }
#pragma unroll
            for (int r = 0; r < 2; ++r)
#pragma unroll
                for (int q = 0; q < 3; ++q)
#pragma unroll
                    for (int j = 0; j < 4; ++j) { const float a_ = aa[r][q]; const u32x2 ww = w[r][q][j];
                        ym[r][j].x += a_ * bflo(ww.x); ym[r][j].y += a_ * bfhi(ww.x); ym[r][j].z += a_ * bflo(ww.y); ym[r][j].w += a_ * bfhi(ww.y); }
        }
#pragma unroll
        for (int r = 0; r < 2; ++r) {
#pragma unroll
            for (int j = 0; j < 4; ++j) v[r][j] = v[r][j] * ALPHA + (t[r][j] + 1.f) * ym[r][j]; }
        f32x4 g4[4], b4[4]; ld_row(g4, g2, lane); ld_row(b4, b2, lane);
#pragma unroll
        for (int r = 0; r < 2; ++r) ln16(v[r], lane);
#pragma unroll
        for (int r = 0; r < 2; ++r) {
#pragma unroll
            for (int j = 0; j < 4; ++j) v[r][j] = v[r][j] * g4[j] + b4[j];
            if (last) st_row_nt(p.out + (size_t)rows[r] * DM, v[r], lane); else st_row_bf16_nt(XS + (size_t)rows[r] * DM, v[r], lane); }
        if (!last) {
#pragma unroll
            for (int r = 0; r < 2; ++r) { const float* md2 = md[r] + 9 * 6144; ld_row(t[r], md2, lane); ld_row(ym[r], md2 + DM, lane); }
#pragma unroll
            for (int r = 0; r < 2; ++r) ln16(v[r], lane);
#pragma unroll
            for (int r = 0; r < 2; ++r) {
#pragma unroll
                for (int j = 0; j < 4; ++j) v[r][j] = v[r][j] * (ym[r][j] + 1.f) + t[r][j];
                st_row_bf16(H + (size_t)rows[r] * DM, v[r], lane); }
        }
    }
}

#define XB_TMO      128
#define XB_XCNT(j)  (256  + 64 * (j))
#define XB_XSUB(j)  (1280 + 64 * (j))
#define XB_XGEN(j)  (2304 + 64 * (j))
#define XB_TOP      3328
#define XB_TOPGEN   3392
#define XCD_BAR_WORDS 3456
#define XB_SPIN_CAP (1u << 18)

__device__ __forceinline__ unsigned xb_ld(unsigned* p)              { return __hip_atomic_load(p, __ATOMIC_RELAXED, __HIP_MEMORY_SCOPE_AGENT); }
__device__ __forceinline__ unsigned xb_add(unsigned* p, unsigned v) { return __hip_atomic_fetch_add(p, v, __ATOMIC_RELAXED, __HIP_MEMORY_SCOPE_AGENT); }
__device__ __forceinline__ unsigned xb_xcc_id() { return (unsigned)__builtin_amdgcn_s_getreg((3 << 11) | 20) & 0xFu; }
#define XB_SPIN(cond, bar) do { unsigned _sp = 0; while (cond) { __builtin_amdgcn_s_sleep(1); \
    if ((++_sp & 255u) == 0u) { if (xb_ld(&(bar)[XB_TMO])) break; if (_sp > XB_SPIN_CAP) { atomicAdd(&(bar)[XB_TMO], 1u); break; } } } } while (0)

struct XcdBarrier {
    unsigned* bar; unsigned x;
    volatile LAS unsigned* st;
};

__device__ __forceinline__ XcdBarrier xcd_barrier_post(unsigned* bar, volatile LAS unsigned* st) {
    XcdBarrier b; b.bar = bar; b.x = xb_xcc_id(); b.st = st;
    if (threadIdx.x == 0) (void)xb_add(&bar[XB_XCNT(b.x)], 1u);
    return b;
}
__device__ __forceinline__ void xcd_barrier_complete(unsigned* bar, unsigned x, unsigned& nloc, unsigned& nx) {
    const unsigned G = gridDim.x * gridDim.y * gridDim.z;
    unsigned sum, cnt, mine, sp = 0u;
    for (;;) {
        sum = 0u; cnt = 0u; mine = 0u;
#pragma unroll
        for (unsigned j = 0; j < 16; ++j) { const unsigned c = xb_ld(&bar[XB_XCNT(j)]); sum += c; cnt += (c > 0u) ? 1u : 0u; mine = (j == x) ? c : mine; }
        if (sum == G) break;
        __builtin_amdgcn_s_sleep(1);
        if ((++sp & 255u) == 0u) { if (xb_ld(&bar[XB_TMO])) break; if (sp > XB_SPIN_CAP) { atomicAdd(&bar[XB_TMO], 1u); break; } }
    }
    nloc = mine > 0u ? mine : 1u; nx = cnt > 0u ? cnt : 1u;
}

__device__ __forceinline__ void xcd_barrier(const XcdBarrier& b) {
    asm volatile("s_waitcnt vmcnt(0)" ::: "memory");
    __syncthreads();
    if (threadIdx.x == 0) {
        unsigned* bar = b.bar;
        __builtin_amdgcn_s_waitcnt(0);
        unsigned nloc = b.st[0], nx = b.st[1];
        if (nloc == 0u) { xcd_barrier_complete(bar, b.x, nloc, nx); b.st[0] = nloc; b.st[1] = nx; }
        const unsigned old = xb_add(&bar[XB_XSUB(b.x)], 1u);
        const unsigned gen = old / nloc;
        if (old + 1u == (gen + 1u) * nloc) {
            __builtin_amdgcn_fence(__ATOMIC_RELEASE, "agent");
            asm volatile("s_waitcnt vmcnt(0)" ::: "memory");
            const unsigned og = xb_add(&bar[XB_TOP], 1u);
            const unsigned tg = og / nx;
            if (og + 1u == (tg + 1u) * nx) xb_add(&bar[XB_TOPGEN], 1u);
            else XB_SPIN(xb_ld(&bar[XB_TOPGEN]) == tg, bar);
            __builtin_amdgcn_fence(__ATOMIC_ACQUIRE, "agent");
            xb_add(&bar[XB_XGEN(b.x)], 1u);
            asm volatile("s_waitcnt vmcnt(0)" ::: "memory");
        } else {
            XB_SPIN(xb_ld(&bar[XB_XGEN(b.x)]) == gen, bar);
            __builtin_amdgcn_fence(__ATOMIC_ACQUIRE, "agent");
            asm volatile("s_waitcnt vmcnt(0)" ::: "memory");
        }
    }
    __syncthreads();
}

constexpr int N_PHASES = 2 + 8 * NL;
#ifndef PHM
#define PHM 1023
#endif
__global__ void __launch_bounds__(NTHR, 2) mega(Params p_in) {
    extern __shared__ __attribute__((aligned(16))) unsigned char lds_raw[];
    LAS unsigned char* lds = (LAS unsigned char*)lds_raw;
    cg::grid_group grid = cg::this_grid();
    const int bid0 = blockIdx.x, G = gridDim.x;
    const Params& p0 = p_in;
    volatile LAS unsigned* bst = (volatile LAS unsigned*)(lds + LDS_BYTES - 64);
    if (threadIdx.x < 2) bst[threadIdx.x] = 0u;
    __syncthreads();
    const XcdBarrier xbar = xcd_barrier_post((unsigned*)(p0.ws + WS_BAR), bst);
    if (p0.ph_lo < 0) grid.sync();
#ifdef DUP_T
    bool rep_done = false;
#endif
    for (int ph = p0.ph_lo; ph < p0.ph_hi;) {
        int tid = threadIdx.x; asm volatile("" : "+v"(tid));
        int bid = bid0; asm volatile("" : "+s"(bid));
        Params p = p0; { size_t zoff = 0; asm volatile("" : "+s"(zoff)); p.ws = p0.ws + zoff; }
        if (ph == 0) { if (PHM & 1) phase0(p, lds, bid, G, tid); }
        else if (ph == 1) { if (PHM & 2) phaseA(p, bid, G, tid); }
        else {
            const int l = (ph - 2) >> 3, s = (ph - 2) & 7;
            if (s == 0) { if (PHM & 4) {
                pg8::Gemm g{(const bf16_t*)(p.ws + WS_R3), (const bf16_t*)(p.ws + WS_WIN) + (size_t)l * D_IN * DM, DM};
                pg8::Sched S{1, l == 0 ? 72 : 64, 11, 0, 0, 64, 7, 4, l == 0 ? 0 : 32, G, bid};
                pg8::EpiBf16 E{(bf16_t*)(p.ws + WS_R1), D_IN, p.b_in + l * D_IN, 5, 7};
                pg8::gemm_phase<pg8::EpiBf16, pg8::Sched, true, true>(lds, g, S, E, tid);
                if (l == 0) convert_deferred(p, lds, 0, 792, bid, G, tid); }
            } else if (s == 1) { if (PHM & 8) {
#if defined(DUP_T) && defined(CSEL)
                phaseC(p, l, lds, bid, G, tid, rep_done ? CSEL : 7);
#else
                phaseC(p, l, lds, bid, G, tid, 7);
#endif
            } }
            else if (s == 2) { if (PHM & 16) {
                pg8::Gemm g{(const bf16_t*)(p.ws + WS_R3), (const bf16_t*)(p.ws + WS_WOUT) + (size_t)l * DM * DM, DM};
                pg8::Sched S{1, l == 0 ? 72 : 64, 4, 0, 0, 0, 0, 1, 0, G, bid};
                pg8::EpiBf16 E{(bf16_t*)(p.ws + WS_R2), DM, p.b_out + l * DM, 0, 0};
                pg8::gemm_phase<pg8::EpiBf16, pg8::Sched, true, true>(lds, g, S, E, tid);
                if (l == 0) convert_deferred(p, lds, 1, 288, bid, G, tid); }
            } else if (s == 3) { if (PHM & 32) { if (l == 0) phaseE<true>(p, l, lds, bid, G, tid); else phaseE<false>(p, l, lds, bid, G, tid); } }
            else if (s == 4) { if (PHM & 64) phaseF(p, l, lds, bid, G, tid); }
            else if (s == 5) { if (PHM & 128) {
                pg8::Gemm g{(const bf16_t*)(p.ws + WS_R3), (const bf16_t*)(p.ws + WS_WGU) + (size_t)l * NE * 2048 * DM, DM};
                pg8::Sched S{NE, l == 0 ? 9 : 8, 8, 9, 8, 0, 0, 1, 0, G, bid};
                pg8::EpiSwiglu E{(bf16_t*)(p.ws + WS_R2), DM};
                pg8::gemm_phase<pg8::EpiSwiglu, pg8::Sched, true, true, true>(lds, g, S, E, tid, (const int*)(p.ws + WS_TOK));
                if (l == 0) convert_deferred(p, lds, 2, 1152, bid, G, tid); }
            } else if (s == 6) { if (PHM & 256) {
                pg8::Gemm g{(const bf16_t*)(p.ws + WS_R2), (const bf16_t*)(p.ws + WS_WD) + (size_t)l * NE * DM * DM, DM};
                pg8::Sched S{NE, l == 0 ? 9 : 8, 4, 9, 4, 0, 0, 1, 0, G, bid};
                pg8::EpiBf16 E{(bf16_t*)(p.ws + WS_R1), DM, nullptr, 0, 0};
                pg8::gemm_phase<pg8::EpiBf16, pg8::Sched, true, true>(lds, g, S, E, tid);
                if (l == 0) convert_deferred(p, lds, 3, 576, bid, G, tid); }
            } else { if (PHM & 512) phaseI(p, l, bid, G, tid); }
        }
        bool advance = true;
#ifdef DUP_T
        { const int ty = ph < 2 ? ph : 2 + ((ph - 2) & 7), ly = ph < 2 ? 0 : (ph - 2) >> 3;
          if (ty == DUP_T && (DUP_L < 0 || ly == DUP_L) && !rep_done) { rep_done = true; advance = false; } else rep_done = false; }
#endif
        if (!advance || ph + 1 < p0.ph_hi) { XcdBarrier xb = xbar; size_t zb = 0; asm volatile("" : "+s"(zb)); xb.bar = xbar.bar + zb; xcd_barrier(xb); }
#ifdef DUP_SYNC
        if (ph + 1 < p0.ph_hi) { xcd_barrier(xbar); xcd_barrier(xbar); }
#endif
        if (advance) ++ph;
    }
}

extern "C" void kernel_launch(void* const* d_in, const int* in_sizes, int n_in, void* d_out, int out_size, void* d_ws, size_t ws_size, hipStream_t stream) {
    static int grid = 0;
    if (grid == 0) {
        if (n_in != 24 || ws_size < WS_END) { fprintf(stderr, "kernel_launch: need 24 inputs and %zu bytes of workspace (got %d, %zu)\n", (size_t)WS_END, n_in, ws_size); grid = -1; return; }
        int dev = 0, cus = 0, per_cu = 0;
        hipGetDevice(&dev); hipDeviceGetAttribute(&cus, hipDeviceAttributeMultiprocessorCount, dev);
        if (hipFuncSetAttribute((const void*)mega, hipFuncAttributeMaxDynamicSharedMemorySize, LDS_BYTES) != hipSuccess) { fprintf(stderr, "kernel_launch: hipFuncSetAttribute failed\n"); grid = -1; return; }
        if (hipOccupancyMaxActiveBlocksPerMultiprocessor(&per_cu, (const void*)mega, NTHR, LDS_BYTES) != hipSuccess || per_cu < 1) { fprintf(stderr, "kernel_launch: occupancy query says %d blocks per CU\n", per_cu); per_cu = 1; }
        (void)hipGetLastError();
        grid = cus * 1;
    }
    if (grid < 0) return;
    Params p{};
    const float** f = (const float**)&p;
    for (int i = 0; i < 24; ++i) f[i] = (const float*)d_in[i];
    p.out = (float*)d_out; p.ws = (unsigned char*)d_ws;
    if (hipMemsetAsync((char*)d_ws + WS_BAR, 0, 16384, stream) != hipSuccess) { fprintf(stderr, "kernel_launch: memset of the barrier words failed\n"); return; }
#if MULTI
    for (int ph = 0; ph < N_PHASES; ++ph) { p.ph_lo = ph; p.ph_hi = ph + 1; hipLaunchKernelGGL(mega, dim3(grid), dim3(NTHR), LDS_BYTES, stream, p); }
#else
    p.ph_lo = 0; p.ph_hi = N_PHASES;
    void* args[] = {&p};
    hipError_t e = hipLaunchCooperativeKernel((const void*)mega, dim3(grid), dim3(NTHR), args, LDS_BYTES, stream);
    if (e != hipSuccess) fprintf(stderr, "cooperative launch failed: %s (grid %d)\n", hipGetErrorString(e), grid);
#endif
}
```
